# Optimizing an MI355X kernel written in HIP

```python
import math
import jax, jax.numpy as jnp
from jax import lax
import numpy as np

D_MODEL = 1024
BATCH = 8
SEQ = 4096
DEPTH = 1

MIX_WIDTH = D_MODEL
ATTN_WIDTH = MIX_WIDTH // 2
SSM_WIDTH = MIX_WIDTH - ATTN_WIDTH
HEAD_DIM = 64
N_HEADS = ATTN_WIDTH // HEAD_DIM
N_KV = 2
GQA_R = N_HEADS // N_KV
CMP_LEN = 32
CMP_STRIDE = 16
CMP_HIDDEN = 256
SEL_BLOCK = 64
SEL_TOPK = 16
WINDOW = 512
Q_BLOCK = 128
SSM_GROUP = 16
SSM_GROUPS = SSM_WIDTH // SSM_GROUP
SSM_STATE = 64
D_FF = 2816
EPS = 1e-6

Q_COLS = N_HEADS * HEAD_DIM
KV_COLS = N_KV * HEAD_DIM
GATE_COLS = N_HEADS * 3
IN_SIZES = [Q_COLS] + [KV_COLS] * 6 + [GATE_COLS, SSM_WIDTH]
IN_COLS = sum(IN_SIZES)

kernel_name = "hymba_nsa_s5_macaron"


def rmsnorm(x, g):
    xf = x.astype(jnp.float32)
    r = lax.rsqrt(jnp.mean(xf * xf, axis=-1, keepdims=True) + EPS)
    return (xf * r).astype(x.dtype) * g


def swiglu(x, w_gate, w_up, w_down):
    return (jax.nn.silu(x @ w_gate) * (x @ w_up)) @ w_down


def masked_softmax(s, mask):
    s = jnp.where(mask, s.astype(jnp.float32), -jnp.inf)
    m = jnp.max(s, axis=-1, keepdims=True)
    m = jnp.where(jnp.isfinite(m), m, 0.0)
    e = jnp.where(mask, jnp.exp(s - m), 0.0)
    return e / jnp.maximum(jnp.sum(e, axis=-1, keepdims=True), 1e-30)


def compress_blocks(kv, pos, w1, b1, w2):
    b, t, g, d = kv.shape
    n_half = CMP_LEN // CMP_STRIDE
    nc = t // CMP_STRIDE - n_half + 1
    halves = kv.reshape(b, t // CMP_STRIDE, CMP_STRIDE, g, d)
    blocks = jnp.concatenate([halves[:, j:j + nc] for j in range(n_half)], axis=2)
    blocks = blocks + pos[:, None, :]
    blocks = blocks.transpose(0, 3, 1, 2, 4).reshape(b, g, nc, CMP_LEN * d)
    return jax.nn.gelu(blocks @ w1 + b1) @ w2


def nsa_attention(q, kc, vc, ks, vs, kw, vw, gates):
    b, t = q.shape[:2]
    d = HEAD_DIM
    nq = t // Q_BLOCK
    nb = t // SEL_BLOCK
    nc = kc.shape[2]
    topk = min(SEL_TOPK, nb)
    scale = HEAD_DIM ** -0.5

    q_blocks = q.reshape(b, nq, Q_BLOCK, N_KV, GQA_R, d).transpose(1, 0, 3, 4, 2, 5)
    g_blocks = gates.reshape(b, nq, Q_BLOCK, N_KV, GQA_R, 3).transpose(1, 0, 3, 4, 2, 5)
    ks_blocks = ks.reshape(b, nb, SEL_BLOCK, N_KV, d).transpose(0, 3, 1, 2, 4)
    vs_blocks = vs.reshape(b, nb, SEL_BLOCK, N_KV, d).transpose(0, 3, 1, 2, 4)
    pad = ((0, 0), (0, 0), (WINDOW, 0), (0, 0))
    kw_pad = jnp.pad(kw.transpose(0, 2, 1, 3), pad)
    vw_pad = jnp.pad(vw.transpose(0, 2, 1, 3), pad)

    cmp_start = jnp.arange(nc) * CMP_STRIDE
    cmp_end = cmp_start + CMP_LEN - 1
    sel_start = jnp.arange(nb) * SEL_BLOCK
    overlap = ((cmp_start[:, None] < sel_start[None, :] + SEL_BLOCK)
               & (cmp_start[:, None] + CMP_LEN > sel_start[None, :])).astype(jnp.float32)
    blk = jnp.arange(nb)
    b_idx = jnp.arange(b)[:, None, None, None]
    g_idx = jnp.arange(N_KV)[None, :, None, None]

    def one_block(args):
        c, qb, gb = args
        tq = c * Q_BLOCK + jnp.arange(Q_BLOCK)
        s_c = jnp.einsum('bgrqd,bgnd->bgrqn', qb, kc) * scale
        p_c = masked_softmax(s_c, cmp_end[None, :] <= tq[:, None])
        o_cmp = jnp.einsum('bgrqn,bgnd->bgrqd', p_c.astype(vc.dtype), vc)
        imp = jnp.einsum('bgrqn,nj->bgqj', p_c, overlap)
        cur = tq // SEL_BLOCK
        forced = (blk[None, :] == 0) | (blk[None, :] == cur[:, None]) | (blk[None, :] == cur[:, None] - 1)
        valid = sel_start[None, :] <= tq[:, None]
        score = jnp.where(forced, jnp.inf, jnp.where(valid, imp, -jnp.inf))
        _, idx = lax.top_k(score, topk)
        k_sel = ks_blocks[b_idx, g_idx, idx]
        v_sel = vs_blocks[b_idx, g_idx, idx]
        kpos = idx[..., None] * SEL_BLOCK + jnp.arange(SEL_BLOCK)
        sel_mask = (kpos <= tq[None, None, :, None, None]).reshape(b, N_KV, 1, Q_BLOCK, topk * SEL_BLOCK)
        s_s = jnp.einsum('bgrqd,bgqksd->bgrqks', qb, k_sel) * scale
        p_s = masked_softmax(s_s.reshape(b, N_KV, GQA_R, Q_BLOCK, topk * SEL_BLOCK), sel_mask)
        o_slc = jnp.einsum('bgrqn,bgqnd->bgrqd', p_s.astype(v_sel.dtype),
                           v_sel.reshape(b, N_KV, Q_BLOCK, topk * SEL_BLOCK, d))
        kw_b = lax.dynamic_slice_in_dim(kw_pad, c * Q_BLOCK, WINDOW + Q_BLOCK, axis=2)
        vw_b = lax.dynamic_slice_in_dim(vw_pad, c * Q_BLOCK, WINDOW + Q_BLOCK, axis=2)
        wpos = c * Q_BLOCK - WINDOW + jnp.arange(WINDOW + Q_BLOCK)
        w_mask = ((wpos[None, :] <= tq[:, None]) & (wpos[None, :] > tq[:, None] - WINDOW)
                  & (wpos[None, :] >= 0))
        s_w = jnp.einsum('bgrqd,bgkd->bgrqk', qb, kw_b) * scale
        p_w = masked_softmax(s_w, w_mask)
        o_win = jnp.einsum('bgrqk,bgkd->bgrqd', p_w.astype(vw_b.dtype), vw_b)
        return gb[..., 0:1] * o_cmp + gb[..., 1:2] * o_slc + gb[..., 2:3] * o_win

    out = lax.map(one_block, (jnp.arange(nq), q_blocks, g_blocks))
    return out.transpose(1, 0, 4, 2, 3, 5).reshape(b, t, N_HEADS * d)


def s5_mixer(u, lam_re, lam_im, log_dt, b_re, b_im, c_re, c_im, d_skip, w_glu, b_glu):
    bsz, t, _ = u.shape
    uf = u.astype(jnp.float32).reshape(bsz, t, SSM_GROUPS, SSM_GROUP)
    lr = lam_re.astype(jnp.float32)
    li = lam_im.astype(jnp.float32)
    dt = jnp.exp(log_dt.astype(jnp.float32))[:, None]
    mag = jnp.exp(lr * dt)
    ab_re = mag * jnp.cos(li * dt)
    ab_im = mag * jnp.sin(li * dt)
    nr = ab_re - 1.0
    den = lr * lr + li * li
    f_re = (nr * lr + ab_im * li) / den
    f_im = (ab_im * lr - nr * li) / den
    br = b_re.astype(jnp.float32)
    bi = b_im.astype(jnp.float32)
    bb_re = f_re[..., None] * br - f_im[..., None] * bi
    bb_im = f_re[..., None] * bi + f_im[..., None] * br
    bu_re = jnp.einsum('btgh,gph->btgp', uf, bb_re)
    bu_im = jnp.einsum('btgh,gph->btgp', uf, bb_im)
    a_re = jnp.broadcast_to(ab_re, (1, t, SSM_GROUPS, SSM_STATE))
    a_im = jnp.broadcast_to(ab_im, (1, t, SSM_GROUPS, SSM_STATE))

    def combine(e1, e2):
        a1r, a1i, b1r, b1i = e1
        a2r, a2i, b2r, b2i = e2
        return (a2r * a1r - a2i * a1i, a2r * a1i + a2i * a1r,
                a2r * b1r - a2i * b1i + b2r, a2r * b1i + a2i * b1r + b2i)

    _, _, xr, xi = lax.associative_scan(combine, (a_re, a_im, bu_re, bu_im), axis=1)
    y = (jnp.einsum('btgp,ghp->btgh', xr, c_re.astype(jnp.float32))
         - jnp.einsum('btgp,ghp->btgh', xi, c_im.astype(jnp.float32))
         + d_skip.astype(jnp.float32) * uf)
    y = jax.nn.gelu(y.reshape(bsz, t, SSM_WIDTH).astype(u.dtype))
    return y * jax.nn.sigmoid(y @ w_glu + b_glu)


def setup_inputs(seed: int = 0) -> dict:
    key = jax.random.key(seed)
    ks = jax.random.split(key, 40)
    L = DEPTH

    def nrm(k, shape, scale):
        return jax.random.normal(k, shape, jnp.float32) * scale

    def gain(k, shape):
        return 1.0 + 0.01 * jax.random.normal(k, shape, jnp.float32)

    n_idx = jnp.arange(SSM_STATE, dtype=jnp.float32)
    lam_re = -0.5 + 0.01 * jax.random.normal(ks[17], (L, SSM_GROUPS, SSM_STATE), jnp.float32)
    lam_im = math.pi * n_idx + 0.01 * jax.random.normal(ks[18], (L, SSM_GROUPS, SSM_STATE), jnp.float32)
    log_dt = jax.random.uniform(ks[19], (L, SSM_GROUPS), jnp.float32, math.log(1e-3), math.log(1e-1))
    return {
        "x": nrm(ks[0], (BATCH, SEQ, D_MODEL), 1.0),
        "ffn1_norm": gain(ks[1], (L, D_MODEL)),
        "ffn1_w_gate": nrm(ks[2], (L, D_MODEL, D_FF), D_MODEL ** -0.5),
        "ffn1_w_up": nrm(ks[3], (L, D_MODEL, D_FF), D_MODEL ** -0.5),
        "ffn1_w_down": nrm(ks[4], (L, D_FF, D_MODEL), D_FF ** -0.5),
        "mix_norm": gain(ks[5], (L, D_MODEL)),
        "w_in": nrm(ks[6], (L, D_MODEL, IN_COLS), D_MODEL ** -0.5),
        "gate_bias": nrm(ks[7], (L, N_HEADS, 3), 0.01),
        "cmp_pos_k": nrm(ks[8], (L, CMP_LEN, HEAD_DIM), 0.02),
        "cmp_pos_v": nrm(ks[9], (L, CMP_LEN, HEAD_DIM), 0.02),
        "cmp_k_w1": nrm(ks[10], (L, CMP_LEN * HEAD_DIM, CMP_HIDDEN), (CMP_LEN * HEAD_DIM) ** -0.5),
        "cmp_k_b1": nrm(ks[11], (L, CMP_HIDDEN), 0.01),
        "cmp_k_w2": nrm(ks[12], (L, CMP_HIDDEN, HEAD_DIM), CMP_HIDDEN ** -0.5),
        "cmp_v_w1": nrm(ks[13], (L, CMP_LEN * HEAD_DIM, CMP_HIDDEN), (CMP_LEN * HEAD_DIM) ** -0.5),
        "cmp_v_b1": nrm(ks[14], (L, CMP_HIDDEN), 0.01),
        "cmp_v_w2": nrm(ks[15], (L, CMP_HIDDEN, HEAD_DIM), CMP_HIDDEN ** -0.5),
        "s5_lambda_re": lam_re,
        "s5_lambda_im": lam_im,
        "s5_log_dt": log_dt,
        "s5_b_re": nrm(ks[20], (L, SSM_GROUPS, SSM_STATE, SSM_GROUP), (2 * SSM_GROUP) ** -0.5),
        "s5_b_im": nrm(ks[21], (L, SSM_GROUPS, SSM_STATE, SSM_GROUP), (2 * SSM_GROUP) ** -0.5),
        "s5_c_re": nrm(ks[22], (L, SSM_GROUPS, SSM_GROUP, SSM_STATE), (2 * SSM_STATE) ** -0.5),
        "s5_c_im": nrm(ks[23], (L, SSM_GROUPS, SSM_GROUP, SSM_STATE), (2 * SSM_STATE) ** -0.5),
        "s5_d": nrm(ks[24], (L, SSM_GROUPS, SSM_GROUP), 1.0),
        "s5_w_glu": nrm(ks[25], (L, SSM_WIDTH, SSM_WIDTH), SSM_WIDTH ** -0.5),
        "s5_b_glu": nrm(ks[26], (L, SSM_WIDTH), 0.01),
        "attn_out_norm": gain(ks[27], (L, ATTN_WIDTH)),
        "ssm_out_norm": gain(ks[28], (L, SSM_WIDTH)),
        "w_out": nrm(ks[29], (L, MIX_WIDTH, D_MODEL), MIX_WIDTH ** -0.5),
        "ffn2_norm": gain(ks[30], (L, D_MODEL)),
        "ffn2_w_gate": nrm(ks[31], (L, D_MODEL, D_FF), D_MODEL ** -0.5),
        "ffn2_w_up": nrm(ks[32], (L, D_MODEL, D_FF), D_MODEL ** -0.5),
        "ffn2_w_down": nrm(ks[33], (L, D_FF, D_MODEL), D_FF ** -0.5),
        "final_norm": gain(ks[34], (D_MODEL,)),
    }


def reference(x, ffn1_norm, ffn1_w_gate, ffn1_w_up, ffn1_w_down, mix_norm, w_in, gate_bias,
              cmp_pos_k, cmp_pos_v, cmp_k_w1, cmp_k_b1, cmp_k_w2, cmp_v_w1, cmp_v_b1, cmp_v_w2,
              s5_lambda_re, s5_lambda_im, s5_log_dt, s5_b_re, s5_b_im, s5_c_re, s5_c_im, s5_d,
              s5_w_glu, s5_b_glu, attn_out_norm, ssm_out_norm, w_out,
              ffn2_norm, ffn2_w_gate, ffn2_w_up, ffn2_w_down, final_norm):
    b, t, _ = x.shape
    split_at = [int(v) for v in np.cumsum(IN_SIZES)[:-1]]
    for l in range(DEPTH):
        x = x + 0.5 * swiglu(rmsnorm(x, ffn1_norm[l]), ffn1_w_gate[l], ffn1_w_up[l], ffn1_w_down[l])
        h = rmsnorm(x, mix_norm[l])
        proj = h @ w_in[l]
        pq, pkc, pvc, pks, pvs, pkw, pvw, pg, pu = jnp.split(proj, split_at, axis=-1)
        q = pq.reshape(b, t, N_HEADS, HEAD_DIM)
        kv_shape = (b, t, N_KV, HEAD_DIM)
        kc = compress_blocks(pkc.reshape(kv_shape), cmp_pos_k[l], cmp_k_w1[l], cmp_k_b1[l], cmp_k_w2[l])
        vc = compress_blocks(pvc.reshape(kv_shape), cmp_pos_v[l], cmp_v_w1[l], cmp_v_b1[l], cmp_v_w2[l])
        gates = jax.nn.sigmoid(pg.reshape(b, t, N_HEADS, 3) + gate_bias[l])
        attn = nsa_attention(q, kc, vc, pks.reshape(kv_shape), pvs.reshape(kv_shape),
                             pkw.reshape(kv_shape), pvw.reshape(kv_shape), gates)
        ssm = s5_mixer(pu, s5_lambda_re[l], s5_lambda_im[l], s5_log_dt[l], s5_b_re[l], s5_b_im[l],
                       s5_c_re[l], s5_c_im[l], s5_d[l], s5_w_glu[l], s5_b_glu[l])
        mixed = jnp.concatenate([rmsnorm(attn, attn_out_norm[l]), rmsnorm(ssm, ssm_out_norm[l])], axis=-1)
        x = x + mixed @ w_out[l]
        x = x + 0.5 * swiglu(rmsnorm(x, ffn2_norm[l]), ffn2_w_gate[l], ffn2_w_up[l], ffn2_w_down[l])
    return rmsnorm(x, final_norm)
```

```cpp
#include <hip/hip_runtime.h>
#include <cstdio>
#include <cstdint>
#include <cmath>

namespace cfg {
constexpr int BATCH = 8, T = 4096, D = 1024, M = BATCH * T, FF = 2816, INC = 1816, INC_PAD = 2048;
constexpr int NH = 8, NKV = 2, HD = 64, NC = 255, NB = 64, SEL_TOPK = 16, WINDOW = 512, CMP_LEN = 32;
constexpr int SGRP = 32, SCH = 16, SST = 64;
constexpr int LCH = 16, NCHUNK = T / LCH;
constexpr float EPS = 1e-6f;
constexpr float C2 = 0.125f * 1.4426950408889634f;
constexpr size_t KVPART = (size_t)BATCH * NKV * T * HD;
}
typedef unsigned short bf16_t;

__device__ __forceinline__ float bf2f(bf16_t v) { return __uint_as_float(((unsigned)v) << 16); }
__device__ __forceinline__ unsigned f2bf_u(float f) { unsigned u = __float_as_uint(f); return (u + 0x7fffu + ((u >> 16) & 1u)) >> 16; }
__device__ __forceinline__ bf16_t f2bf(float f) { return (bf16_t)f2bf_u(f); }
__device__ __forceinline__ unsigned pk2(float lo, float hi) { return f2bf_u(lo) | (f2bf_u(hi) << 16); }
__device__ __forceinline__ float gelu_tanh(float x) { const float u = 0.7978845608028654f * (x + 0.044715f * x * x * x); return 0.5f * x * (1.f + tanhf(u)); }

struct MixBufs { bf16_t* Q; bf16_t* KV; float* GATES; bf16_t* UX; const float* gate_bias; };
__device__ __forceinline__ void win_store1(const MixBufs& mb, int row, int col, float v) {
    using namespace cfg;
    const int b = row >> 12, t = row & (T - 1);
    if (col < 512) { const int h = col >> 6, d = col & 63; mb.Q[(((size_t)(b * NH + h)) * T + t) * 64 + d] = f2bf(v * C2); }
    else if (col < 1280) { const int c = col - 512, part = c >> 7, g = (c >> 6) & 1, d = c & 63; mb.KV[(size_t)part * KVPART + (((size_t)(b * 2 + g)) * T + t) * 64 + d] = f2bf(v); }
    else if (col < 1304) { const int c = col - 1280; mb.GATES[(size_t)row * 24 + c] = 1.f / (1.f + expf(-(v + mb.gate_bias[c]))); }
    else { const int c = col - 1304, g = c >> 4, h = c & 15; mb.UX[((size_t)(g * 2048 + b * 256 + (t >> 4))) * 384 + (t & 15) * 16 + h] = f2bf(v); }
}
namespace wsl {
constexpr size_t MiB = 1u << 20;
constexpr size_t CTL = 0, CTL_BYTES = 1 * MiB;
constexpr size_t W1A = 1 * MiB;
constexpr size_t W1D = 12 * MiB;
constexpr size_t W2A = 18 * MiB;
constexpr size_t W2D = 29 * MiB;
constexpr size_t WIN = 35 * MiB;
constexpr size_t WOUT = 39 * MiB;
constexpr size_t CW1K = 41 * MiB;
constexpr size_t CW1V = 42 * MiB;
constexpr size_t GLUW = 43 * MiB;
constexpr size_t CW2K = 43 * MiB + 512 * 1024;
constexpr size_t CW2V = CW2K + 64 * 1024;
constexpr size_t CB1K = CW2V + 64 * 1024;
constexpr size_t CB1V = CB1K + 4096;
constexpr size_t BTS = 44 * MiB;
constexpr size_t BTY = 48 * MiB;
constexpr size_t S5A = 54 * MiB;
constexpr size_t XB = 56 * MiB;
constexpr size_t H = 120 * MiB;
constexpr size_t Q = 120 * MiB;
constexpr size_t KV = 152 * MiB;
constexpr size_t UX = 200 * MiB;
constexpr size_t S = 248 * MiB;
constexpr size_t HIDK = 280 * MiB, HIDV = 282 * MiB;
constexpr size_t KC = 284 * MiB, VC = 284 * MiB + 512 * 1024;
constexpr size_t YG = 296 * MiB;
constexpr size_t SSM = 328 * MiB;
constexpr size_t ATT = 360 * MiB;
constexpr size_t GATES = 392 * MiB;
constexpr size_t SSQ1 = 395 * MiB, SSQ2 = 397 * MiB, SSQ3 = 399 * MiB;
constexpr size_t SSQS = 401 * MiB;
constexpr size_t SSQA = 402 * MiB;
constexpr size_t END = 403 * MiB;
}
namespace nv {
using namespace cfg;

__device__ __forceinline__ float wsum(float v) {
#pragma unroll
    for (int o = 1; o < 64; o <<= 1) v += __shfl_xor(v, o);
    return v;
}
__device__ __forceinline__ float wmax(float v) {
#pragma unroll
    for (int o = 1; o < 64; o <<= 1) v = fmaxf(v, __shfl_xor(v, o));
    return v;
}

__global__ __launch_bounds__(256) void rownorm_x(const float* __restrict__ x, bf16_t* __restrict__ XB) {
    const int row = blockIdx.x * 4 + (threadIdx.x >> 6), lane = threadIdx.x & 63;
    const float4* xr = (const float4*)(x + (size_t)row * D) + lane;
    float4 v[4]; float s = 0.f;
#pragma unroll
    for (int j = 0; j < 4; ++j) { v[j] = xr[64 * j]; s += v[j].x * v[j].x + v[j].y * v[j].y + v[j].z * v[j].z + v[j].w * v[j].w; }
    s = wsum(s);
    const float r = rsqrtf(s * (1.f / D) + EPS);
    uint2* o = (uint2*)(XB + (size_t)row * D) + lane;
#pragma unroll
    for (int j = 0; j < 4; ++j) { uint2 w; w.x = pk2(v[j].x * r, v[j].y * r); w.y = pk2(v[j].z * r, v[j].w * r); o[64 * j] = w; }
}
__global__ __launch_bounds__(256) void rowstat(const float* __restrict__ X, bf16_t* __restrict__ AB, float* __restrict__ SSQ, int nslots) {
    const int row = blockIdx.x * 4 + (threadIdx.x >> 6), lane = threadIdx.x & 63;
    const float4* xr = (const float4*)(X + (size_t)row * D) + lane;
    float4 v[4]; float s = 0.f;
#pragma unroll
    for (int j = 0; j < 4; ++j) { v[j] = xr[64 * j]; s += v[j].x * v[j].x + v[j].y * v[j].y + v[j].z * v[j].z + v[j].w * v[j].w; }
    s = wsum(s);
    uint2* o = (uint2*)(AB + (size_t)row * D) + lane;
#pragma unroll
    for (int j = 0; j < 4; ++j) { uint2 w; w.x = pk2(v[j].x, v[j].y); w.y = pk2(v[j].z, v[j].w); o[64 * j] = w; }
    if (lane < nslots) SSQ[(size_t)row * nslots + lane] = lane == 0 ? s : 0.f;
}
__global__ __launch_bounds__(256) void rowssq_bf16(const bf16_t* __restrict__ X, int ncol, float* __restrict__ SSQ, int nslots) {
    const int row = blockIdx.x * 4 + (threadIdx.x >> 6), lane = threadIdx.x & 63;
    float s = 0.f;
    for (int c = lane; c < ncol; c += 64) { const float v = bf2f(X[(size_t)row * ncol + c]); s += v * v; }
    s = wsum(s);
    if (lane < nslots) SSQ[(size_t)row * nslots + lane] = lane == 0 ? s : 0.f;
}
__device__ __forceinline__ float slot_sum(const float* p, int n) { float s = 0.f; for (int i = 0; i < n; ++i) s += p[i]; return s; }

__global__ __launch_bounds__(256) void gateup(const bf16_t* __restrict__ A, const float* __restrict__ gain, const float* __restrict__ ssq, int nslots,
                                              const float* __restrict__ Wg, const float* __restrict__ Wu, bf16_t* __restrict__ Hh) {
    const int j = blockIdx.x * 256 + threadIdx.x, row0 = blockIdx.y * 8;
    float ag[8], au[8];
#pragma unroll
    for (int r = 0; r < 8; ++r) { ag[r] = 0.f; au[r] = 0.f; }
    for (int k = 0; k < D; ++k) {
        const float gk = gain[k], wg = Wg[(size_t)k * FF + j] * gk, wu = Wu[(size_t)k * FF + j] * gk;
#pragma unroll
        for (int r = 0; r < 8; ++r) { const float a = bf2f(A[(size_t)(row0 + r) * D + k]); ag[r] += a * wg; au[r] += a * wu; }
    }
#pragma unroll
    for (int r = 0; r < 8; ++r) {
        const int row = row0 + r;
        const float rs = nslots ? rsqrtf(slot_sum(ssq + (size_t)row * nslots, nslots) * (1.f / D) + EPS) : 1.f;
        const float g = ag[r] * rs, u = au[r] * rs;
        Hh[(size_t)row * FF + j] = f2bf(g / (1.f + expf(-g)) * u);
    }
}
__global__ __launch_bounds__(256) void down(const bf16_t* __restrict__ Hh, const float* __restrict__ Wd, const float* resid, float* out) {
    const int c = blockIdx.x * 256 + threadIdx.x, row0 = blockIdx.y * 8;
    float acc[8];
#pragma unroll
    for (int r = 0; r < 8; ++r) acc[r] = 0.f;
    for (int k = 0; k < FF; ++k) {
        const float w = Wd[(size_t)k * D + c];
#pragma unroll
        for (int r = 0; r < 8; ++r) acc[r] += bf2f(Hh[(size_t)(row0 + r) * FF + k]) * w;
    }
#pragma unroll
    for (int r = 0; r < 8; ++r) { const size_t o = (size_t)(row0 + r) * D + c; out[o] = resid[o] + 0.5f * acc[r]; }
}
__global__ __launch_bounds__(256) void win(const bf16_t* __restrict__ A, const float* __restrict__ gain, const float* __restrict__ ssq, int nslots,
                                           const float* __restrict__ W, MixBufs mb) {
    const int c = blockIdx.x * 256 + threadIdx.x, row0 = blockIdx.y * 8;
    if (c >= INC) return;
    float acc[8];
#pragma unroll
    for (int r = 0; r < 8; ++r) acc[r] = 0.f;
    for (int k = 0; k < D; ++k) {
        const float w = W[(size_t)k * INC + c] * gain[k];
#pragma unroll
        for (int r = 0; r < 8; ++r) acc[r] += bf2f(A[(size_t)(row0 + r) * D + k]) * w;
    }
#pragma unroll
    for (int r = 0; r < 8; ++r) {
        const int row = row0 + r;
        const float rs = rsqrtf(slot_sum(ssq + (size_t)row * nslots, nslots) * (1.f / D) + EPS);
        win_store1(mb, row, c, acc[r] * rs);
    }
}
__global__ __launch_bounds__(256) void cmp_hidden(const bf16_t* __restrict__ kvin  , const float* __restrict__ pos, const float* __restrict__ w1,
                                                   const float* __restrict__ b1, bf16_t* __restrict__ HID) {
    const int n = threadIdx.x, row = blockIdx.x, i = row & 255, bg = row >> 8;
    if (i == 255) { HID[(size_t)row * 256 + n] = 0; return; }
    const bf16_t* src = kvin + ((size_t)bg * T + 16 * i) * 64;
    float acc = b1[n];
    for (int kk = 0; kk < CMP_LEN * 64; ++kk) acc += (bf2f(src[kk]) + pos[kk]) * w1[(size_t)kk * 256 + n];
    HID[(size_t)row * 256 + n] = f2bf(gelu_tanh(acc));
}
__global__ __launch_bounds__(64) void cmp_out(const bf16_t* __restrict__ HID, const float* __restrict__ w2, bf16_t* __restrict__ KC) {
    const int d = threadIdx.x, row = blockIdx.x;
    float acc = 0.f;
    for (int n = 0; n < 256; ++n) acc += bf2f(HID[(size_t)row * 256 + n]) * w2[n * 64 + d];
    KC[(size_t)row * 64 + d] = f2bf(acc);
}
__device__ __forceinline__ float dot64(const float* q  , const bf16_t* k) {
    float s = 0.f;
    const uint4* kp = (const uint4*)k;
#pragma unroll
    for (int c = 0; c < 8; ++c) {
        const uint4 w = kp[c];
        s += q[8 * c + 0] * __uint_as_float(w.x << 16) + q[8 * c + 1] * __uint_as_float(w.x & 0xffff0000u);
        s += q[8 * c + 2] * __uint_as_float(w.y << 16) + q[8 * c + 3] * __uint_as_float(w.y & 0xffff0000u);
        s += q[8 * c + 4] * __uint_as_float(w.z << 16) + q[8 * c + 5] * __uint_as_float(w.z & 0xffff0000u);
        s += q[8 * c + 6] * __uint_as_float(w.w << 16) + q[8 * c + 7] * __uint_as_float(w.w & 0xffff0000u);
    }
    return s;
}
__global__ __launch_bounds__(64) void attn(const bf16_t* __restrict__ Q, const bf16_t* __restrict__ KV, const bf16_t* __restrict__ KC, const bf16_t* __restrict__ VC,
                                           const float* __restrict__ GATES, bf16_t* __restrict__ ATT, float* __restrict__ SSQA) {
    const int lane = threadIdx.x, idx = blockIdx.x, t = idx & (T - 1), g = (idx >> 12) & 1, b = idx >> 13, row = b * T + t, cur = t >> 6;
    __shared__ float pc[4][256];
    __shared__ float sc[1024];
    __shared__ float qs[4][64];
    __shared__ float impS[64];
    const float NEG = -INFINITY;
    for (int r = 0; r < 4; ++r) qs[r][lane] = bf2f(Q[(((size_t)(b * NH + g * 4 + r)) * T + t) * 64 + lane]);
    __syncthreads();
    const size_t bg = (size_t)(b * 2 + g);
    const bf16_t* kc = KC + bg * 256 * 64; const bf16_t* vc = VC + bg * 256 * 64;
    const bf16_t* ks = KV + 2 * KVPART + bg * T * 64; const bf16_t* vs = KV + 3 * KVPART + bg * T * 64;
    const bf16_t* kw = KV + 4 * KVPART + bg * T * 64; const bf16_t* vw = KV + 5 * KVPART + bg * T * 64;
    float oc[4], osl[4], ow[4];
    int nvc = (t >= 31) ? ((t - 31) / 16 + 1) : 0; if (nvc > NC) nvc = NC;
    for (int r = 0; r < 4; ++r) {
        float mx = NEG;
        for (int ps = 0; ps < 4; ++ps) { const int i = ps * 64 + lane; float s = NEG; if (i < nvc) s = dot64(qs[r], kc + (size_t)i * 64); pc[r][i] = s; mx = fmaxf(mx, s); }
        mx = wmax(mx); if (mx == NEG) mx = 0.f;
        float sum = 0.f;
        for (int ps = 0; ps < 4; ++ps) { const int i = ps * 64 + lane; const float e = (i < nvc) ? exp2f(pc[r][i] - mx) : 0.f; pc[r][i] = e; sum += e; }
        sum = wsum(sum); const float inv = 1.f / fmaxf(sum, 1e-30f);
        for (int ps = 0; ps < 4; ++ps) pc[r][ps * 64 + lane] *= inv;
        __syncthreads();
        float o = 0.f;
        for (int i = 0; i < nvc; ++i) o += pc[r][i] * bf2f(vc[(size_t)i * 64 + lane]);
        oc[r] = o;
    }
    __syncthreads();
    {
        const int j = lane; float im = 0.f;
        for (int r = 0; r < 4; ++r) for (int i = 4 * j - 1; i <= 4 * j + 3; ++i) if (i >= 0 && i < NC) im += pc[r][i];
        const bool forced = (j == 0) || (j == cur) || (j == cur - 1), valid = j <= cur;
        impS[j] = forced ? INFINITY : (valid ? im : NEG);
    }
    __syncthreads();
    unsigned long long mask;
    {
        const float my = impS[lane]; int rank = 0;
        for (int j2 = 0; j2 < 64; ++j2) { const float o = impS[j2]; rank += (o > my) || (o == my && j2 < lane); }
        mask = __ballot(rank < SEL_TOPK && lane <= cur);
    }
    for (int r = 0; r < 4; ++r) {
        int cnt = 0; float mx = NEG;
        for (unsigned long long mm = mask; mm; mm &= mm - 1) { const int j = __builtin_ctzll(mm); const int key = 64 * j + lane; float s = NEG; if (key <= t) s = dot64(qs[r], ks + (size_t)key * 64); sc[cnt * 64 + lane] = s; mx = fmaxf(mx, s); ++cnt; }
        mx = wmax(mx);
        float sum = 0.f;
        for (int c = 0; c < cnt; ++c) { const float e = exp2f(sc[c * 64 + lane] - mx); sc[c * 64 + lane] = e; sum += e; }
        sum = wsum(sum); const float inv = 1.f / fmaxf(sum, 1e-30f);
        __syncthreads();
        float o = 0.f; cnt = 0;
        for (unsigned long long mm = mask; mm; mm &= mm - 1) { const int j = __builtin_ctzll(mm); for (int kk = 0; kk < 64; ++kk) o += sc[cnt * 64 + kk] * bf2f(vs[(size_t)(64 * j + kk) * 64 + lane]); ++cnt; }
        osl[r] = o * inv;
        __syncthreads();
    }
    for (int r = 0; r < 4; ++r) {
        const int base = t - (WINDOW - 1); float mx = NEG;
        for (int ps = 0; ps < 8; ++ps) { const int key = base + ps * 64 + lane; float s = NEG; if (key >= 0) s = dot64(qs[r], kw + (size_t)key * 64); sc[ps * 64 + lane] = s; mx = fmaxf(mx, s); }
        mx = wmax(mx);
        float sum = 0.f;
        for (int ps = 0; ps < 8; ++ps) { const float e = exp2f(sc[ps * 64 + lane] - mx); sc[ps * 64 + lane] = e; sum += e; }
        sum = wsum(sum); const float inv = 1.f / fmaxf(sum, 1e-30f);
        __syncthreads();
        float o = 0.f;
        for (int kk = 0; kk < WINDOW; ++kk) { const int key = base + kk; if (key >= 0) o += sc[kk] * bf2f(vw[(size_t)key * 64 + lane]); }
        ow[r] = o * inv;
        __syncthreads();
    }
    float ssq = 0.f;
    for (int r = 0; r < 4; ++r) {
        const int head = g * 4 + r; const float* gp = GATES + (size_t)row * 24 + head * 3;
        const float v = gp[0] * oc[r] + gp[1] * osl[r] + gp[2] * ow[r];
        ATT[(size_t)row * 512 + head * 64 + lane] = f2bf(v); ssq += v * v;
    }
    ssq = wsum(ssq);
    if (lane == 0) SSQA[(size_t)row * 2 + g] = ssq;
}
__global__ __launch_bounds__(64) void s5(const bf16_t* __restrict__ UX, const float* __restrict__ lam_re, const float* __restrict__ lam_im, const float* __restrict__ log_dt,
                                         const float* __restrict__ b_re, const float* __restrict__ b_im, const float* __restrict__ c_re, const float* __restrict__ c_im,
                                         const float* __restrict__ dsk, bf16_t* __restrict__ YG) {
    const int g = blockIdx.x & 31, b = blockIdx.x >> 5, p = threadIdx.x, lane = p;
    const float dt = expf(log_dt[g]), lr = lam_re[g * 64 + p], li = lam_im[g * 64 + p];
    const float mag = expf(lr * dt), ar = mag * cosf(li * dt), ai = mag * sinf(li * dt);
    const float nr = ar - 1.f, den = lr * lr + li * li, fr = (nr * lr + ai * li) / den, fi = (ai * lr - nr * li) / den;
    float bbr[16], bbi[16], cr[16], ci[16];
#pragma unroll
    for (int h = 0; h < 16; ++h) {
        const float br = b_re[(size_t)(g * 64 + p) * 16 + h], bi = b_im[(size_t)(g * 64 + p) * 16 + h];
        bbr[h] = fr * br - fi * bi; bbi[h] = fr * bi + fi * br;
        cr[h] = c_re[(size_t)(g * 16 + h) * 64 + p]; ci[h] = c_im[(size_t)(g * 16 + h) * 64 + p];
    }
    const float dsk_l = dsk[g * 16 + (lane & 15)];
    float xr = 0.f, xi = 0.f;
    for (int t = 0; t < T; ++t) {
        const bf16_t* up = UX + ((size_t)(g * 2048 + b * 256 + (t >> 4))) * 384 + (t & 15) * 16;
        float u[16];
#pragma unroll
        for (int h = 0; h < 16; ++h) u[h] = bf2f(up[h]);
        float bur = 0.f, bui = 0.f;
#pragma unroll
        for (int h = 0; h < 16; ++h) { bur += bbr[h] * u[h]; bui += bbi[h] * u[h]; }
        const float nxr = ar * xr - ai * xi + bur, nxi = ar * xi + ai * xr + bui; xr = nxr; xi = nxi;
        float y = 0.f, ul = 0.f;
#pragma unroll
        for (int h = 0; h < 16; ++h) { const float v = wsum(cr[h] * xr - ci[h] * xi); if (lane == h) { y = v; ul = u[h]; } }
        if (lane < 16) YG[(size_t)(b * T + t) * 512 + g * 16 + lane] = f2bf(gelu_tanh(y + dsk_l * ul));
    }
}
__global__ __launch_bounds__(256) void glu(const bf16_t* __restrict__ YG, const float* __restrict__ W, const float* __restrict__ bias, bf16_t* __restrict__ SSM) {
    const int c = blockIdx.x * 256 + threadIdx.x, row0 = blockIdx.y * 8;
    float acc[8];
#pragma unroll
    for (int r = 0; r < 8; ++r) acc[r] = 0.f;
    for (int k = 0; k < 512; ++k) {
        const float w = W[(size_t)k * 512 + c];
#pragma unroll
        for (int r = 0; r < 8; ++r) acc[r] += bf2f(YG[(size_t)(row0 + r) * 512 + k]) * w;
    }
#pragma unroll
    for (int r = 0; r < 8; ++r) { const size_t o = (size_t)(row0 + r) * 512 + c; const float z = acc[r] + bias[c]; SSM[o] = f2bf(bf2f(YG[o]) / (1.f + expf(-z))); }
}
__global__ __launch_bounds__(256) void wout(const bf16_t* __restrict__ ATT, const bf16_t* __restrict__ SSM, const float* __restrict__ SSQA, const float* __restrict__ SSQS, int nslots_s,
                                            const float* __restrict__ ga, const float* __restrict__ gs, const float* __restrict__ W, float* X) {
    const int c = blockIdx.x * 256 + threadIdx.x, row0 = blockIdx.y * 8;
    float a1[8], a2[8];
#pragma unroll
    for (int r = 0; r < 8; ++r) { a1[r] = 0.f; a2[r] = 0.f; }
    for (int k = 0; k < 512; ++k) {
        const float w1 = W[(size_t)k * D + c] * ga[k], w2 = W[(size_t)(512 + k) * D + c] * gs[k];
#pragma unroll
        for (int r = 0; r < 8; ++r) { a1[r] += bf2f(ATT[(size_t)(row0 + r) * 512 + k]) * w1; a2[r] += bf2f(SSM[(size_t)(row0 + r) * 512 + k]) * w2; }
    }
#pragma unroll
    for (int r = 0; r < 8; ++r) {
        const int row = row0 + r;
        const float ra = rsqrtf((SSQA[(size_t)row * 2] + SSQA[(size_t)row * 2 + 1]) * (1.f / 512) + EPS);
        const float rs = rsqrtf(slot_sum(SSQS + (size_t)row * nslots_s, nslots_s) * (1.f / 512) + EPS);
        X[(size_t)row * D + c] += ra * a1[r] + rs * a2[r];
    }
}
__global__ __launch_bounds__(256) void final_norm(float* X, const float* __restrict__ gain) {
    const int row = blockIdx.x * 4 + (threadIdx.x >> 6), lane = threadIdx.x & 63;
    float4* xr = (float4*)(X + (size_t)row * D) + lane; const float4* gr = (const float4*)gain + lane;
    float4 v[4]; float s = 0.f;
#pragma unroll
    for (int j = 0; j < 4; ++j) { v[j] = xr[64 * j]; s += v[j].x * v[j].x + v[j].y * v[j].y + v[j].z * v[j].z + v[j].w * v[j].w; }
    s = wsum(s);
    const float r = rsqrtf(s * (1.f / D) + EPS);
#pragma unroll
    for (int j = 0; j < 4; ++j) { const float4 gq = gr[64 * j]; float4 o; o.x = v[j].x * r * gq.x; o.y = v[j].y * r * gq.y; o.z = v[j].z * r * gq.z; o.w = v[j].w * r * gq.w; xr[64 * j] = o; }
}
}
extern "C" void kernel_launch(void* const* d_in, const int* in_sizes, int n_in, void* d_out, int out_size, void* d_ws, size_t ws_size, hipStream_t stream) {
    using namespace cfg;
    if (n_in != 34 || out_size != M * D || ws_size < wsl::END) { fprintf(stderr, "kernel_launch: unexpected shapes (n_in %d out %d ws %zu)\n", n_in, out_size, ws_size); return; }
    const float* const* in = (const float* const*)d_in;
    unsigned char* ws = (unsigned char*)d_ws; float* out = (float*)d_out;
    bf16_t* XB = (bf16_t*)(ws + wsl::XB); bf16_t* Hh = (bf16_t*)(ws + wsl::H);
    MixBufs mb{(bf16_t*)(ws + wsl::Q), (bf16_t*)(ws + wsl::KV), (float*)(ws + wsl::GATES), (bf16_t*)(ws + wsl::UX), in[7]};
    float* SSQ1 = (float*)(ws + wsl::SSQ1); float* SSQ2 = (float*)(ws + wsl::SSQ2); float* SSQS = (float*)(ws + wsl::SSQS); float* SSQA = (float*)(ws + wsl::SSQA);
    bf16_t* HIDK = (bf16_t*)(ws + wsl::HIDK); bf16_t* HIDV = (bf16_t*)(ws + wsl::HIDV); bf16_t* KC = (bf16_t*)(ws + wsl::KC); bf16_t* VC = (bf16_t*)(ws + wsl::VC);
    bf16_t* YG = (bf16_t*)(ws + wsl::YG); bf16_t* SSM = (bf16_t*)(ws + wsl::SSM); bf16_t* ATT = (bf16_t*)(ws + wsl::ATT);
    nv::rownorm_x<<<M / 4, 256, 0, stream>>>(in[0], XB);
    nv::gateup<<<dim3(FF / 256, M / 8), 256, 0, stream>>>(XB, in[1], nullptr, 0, in[2], in[3], Hh);
    nv::down<<<dim3(D / 256, M / 8), 256, 0, stream>>>(Hh, in[4], in[0], out);
    nv::rowstat<<<M / 4, 256, 0, stream>>>(out, XB, SSQ1, 16);
    nv::win<<<dim3((INC + 255) / 256, M / 8), 256, 0, stream>>>(XB, in[5], SSQ1, 16, in[6], mb);
    nv::cmp_hidden<<<4096, 256, 0, stream>>>(mb.KV + 0 * KVPART, in[8], in[10], in[11], HIDK);
    nv::cmp_hidden<<<4096, 256, 0, stream>>>(mb.KV + 1 * KVPART, in[9], in[13], in[14], HIDV);
    nv::cmp_out<<<4096, 64, 0, stream>>>(HIDK, in[12], KC);
    nv::cmp_out<<<4096, 64, 0, stream>>>(HIDV, in[15], VC);
    nv::attn<<<BATCH * NKV * T, 64, 0, stream>>>(mb.Q, mb.KV, KC, VC, mb.GATES, ATT, SSQA);
    nv::s5<<<BATCH * SGRP, 64, 0, stream>>>(mb.UX, in[16], in[17], in[18], in[19], in[20], in[21], in[22], in[23], YG);
    nv::glu<<<dim3(2, M / 8), 256, 0, stream>>>(YG, in[24], in[25], SSM);
    nv::rowssq_bf16<<<M / 4, 256, 0, stream>>>(SSM, 512, SSQS, 8);
    nv::wout<<<dim3(D / 256, M / 8), 256, 0, stream>>>(ATT, SSM, SSQA, SSQS, 8, in[26], in[27], in[28], out);
    nv::rowstat<<<M / 4, 256, 0, stream>>>(out, XB, SSQ2, 16);
    nv::gateup<<<dim3(FF / 256, M / 8), 256, 0, stream>>>(XB, in[29], SSQ2, 16, in[30], in[31], Hh);
    nv::down<<<dim3(D / 256, M / 8), 256, 0, stream>>>(Hh, in[32], out, out);
    nv::final_norm<<<M / 4, 256, 0, stream>>>(out, in[33]);
}
```

```cpp
#include <hip/hip_runtime.h>
#include <cstdio>
#include <cstdint>
#include <cmath>

namespace cfg {
constexpr int BATCH = 8, T = 4096, D = 1024, M = BATCH * T, FF = 2816, INC = 1816, INC_PAD = 2048;
constexpr int NH = 8, NKV = 2, HD = 64, NC = 255, NB = 64, SEL_TOPK = 16, WINDOW = 512, CMP_LEN = 32;
constexpr int SGRP = 32, SCH = 16, SST = 64;
constexpr int LCH = 16, NCHUNK = T / LCH;
constexpr float EPS = 1e-6f;
constexpr float C2 = 0.125f * 1.4426950408889634f;
constexpr int MIXP = 1024;
constexpr size_t KVPART = (size_t)BATCH * NKV * T * HD;
}
typedef unsigned short bf16_t;

__device__ __forceinline__ float bf2f(bf16_t v) { return __uint_as_float(((unsigned)v) << 16); }
__device__ __forceinline__ unsigned f2bf_u(float f) { unsigned u = __float_as_uint(f); return (u + 0x7fffu + ((u >> 16) & 1u)) >> 16; }
__device__ __forceinline__ bf16_t f2bf(float f) { return (bf16_t)f2bf_u(f); }
__device__ __forceinline__ unsigned pk2(float lo, float hi) { return f2bf_u(lo) | (f2bf_u(hi) << 16); }
__device__ __forceinline__ float gelu_tanh(float x) { const float u = 0.7978845608028654f * (x + 0.044715f * x * x * x); return 0.5f * x * (1.f + tanhf(u)); }

__device__ __forceinline__ int lane_id() { int r; asm volatile("v_mbcnt_lo_u32_b32 %0, -1, 0\n\tv_mbcnt_hi_u32_b32 %0, -1, %0" : "=v"(r)); return r; }

struct MixBufs { bf16_t* Q; bf16_t* KV; float* GATES; bf16_t* UX; const float* gate_bias; };
namespace wsl {
constexpr size_t MiB = 1u << 20;
constexpr size_t CTL = 0, CTL_BYTES = 1 * MiB;
constexpr size_t W1A = 1 * MiB;
constexpr size_t W1D = 12 * MiB;
constexpr size_t W2A = 18 * MiB;
constexpr size_t W2D = 29 * MiB;
constexpr size_t WIN = 35 * MiB;
constexpr size_t WOUT = 39 * MiB;
constexpr size_t CW1K = 41 * MiB;
constexpr size_t CW1V = 42 * MiB;
constexpr size_t GLUW = 43 * MiB;
constexpr size_t CW2K = 43 * MiB + 512 * 1024;
constexpr size_t CW2V = CW2K + 64 * 1024;
constexpr size_t CB1K = CW2V + 64 * 1024;
constexpr size_t CB1V = CB1K + 4096;
constexpr size_t BTS = 44 * MiB;
constexpr size_t BTY = 48 * MiB;
constexpr size_t S5A = 54 * MiB;
constexpr size_t XB = 56 * MiB;
constexpr size_t H = 120 * MiB;
constexpr size_t Q = 120 * MiB;
constexpr size_t KV = 152 * MiB;
constexpr size_t UX = 200 * MiB;
constexpr size_t S = 248 * MiB;
constexpr size_t HIDK = 280 * MiB, HIDV = 282 * MiB;
constexpr size_t KC = 284 * MiB, VC = 284 * MiB + 512 * 1024;
constexpr size_t YG = 296 * MiB;
constexpr size_t MIX = 328 * MiB;
constexpr size_t GATES = 392 * MiB;
constexpr size_t SSQ1 = 395 * MiB, SSQ2 = 397 * MiB, SSQ3 = 399 * MiB;
constexpr size_t SSQS = 401 * MiB;
constexpr size_t SSQA = 402 * MiB;
constexpr size_t END = 403 * MiB;
}
#define GAS __attribute__((address_space(1)))
#define LAS __attribute__((address_space(3)))
typedef unsigned v4u __attribute__((ext_vector_type(4)));
typedef float f32x4 __attribute__((ext_vector_type(4)));
typedef short bf16x8 __attribute__((ext_vector_type(8)));
typedef GAS unsigned gu32;
typedef GAS unsigned long long gu64;
#define RLX_AGENT __ATOMIC_RELAXED, __HIP_MEMORY_SCOPE_AGENT
#define LDS_WAIT() asm volatile("s_waitcnt lgkmcnt(0)" ::: "memory")
#define VM_WAIT() asm volatile("s_waitcnt vmcnt(0)" ::: "memory")
__device__ __forceinline__ unsigned long long rt() { return __builtin_amdgcn_s_memrealtime(); }
#define XB_TMO      128
#define XB_XCNT(j)  (256  + 64 * (j))
#define XB_XSUB(j)  (1280 + 64 * (j))
#define XB_XGEN(j)  (2304 + 64 * (j))
#define XB_TOP      3328
#define XB_TOPGEN   3392
#define XCD_BAR_WORDS 3456
#define XB_SPIN_CAP (1u << 18)

__device__ __forceinline__ unsigned xb_ld(unsigned* p)              { return __hip_atomic_load(p, __ATOMIC_RELAXED, __HIP_MEMORY_SCOPE_AGENT); }
__device__ __forceinline__ unsigned xb_add(unsigned* p, unsigned v) { return __hip_atomic_fetch_add(p, v, __ATOMIC_RELAXED, __HIP_MEMORY_SCOPE_AGENT); }
__device__ __forceinline__ unsigned xb_xcc_id() { return (unsigned)__builtin_amdgcn_s_getreg((3 << 11) | 20) & 0xFu; }
#define XB_SPIN(cond, bar) do { unsigned _sp = 0; while (cond) { __builtin_amdgcn_s_sleep(1); \
    if ((++_sp & 255u) == 0u) { if (xb_ld(&(bar)[XB_TMO])) break; if (_sp > XB_SPIN_CAP) { atomicAdd(&(bar)[XB_TMO], 1u); break; } } } } while (0)

struct XcdBarrier {
    unsigned* bar; unsigned x; unsigned w0;
    volatile LAS unsigned* st;
};

__device__ __forceinline__ XcdBarrier xcd_barrier_post(unsigned* bar, volatile LAS unsigned* st) {
    XcdBarrier b; b.bar = bar; b.x = xb_xcc_id(); b.st = st; b.w0 = (__builtin_amdgcn_readfirstlane(threadIdx.x) < 64u) ? 1u : 0u;
    if (b.w0 && lane_id() == 0) (void)xb_add(&bar[XB_XCNT(b.x)], 1u);
    return b;
}
__device__ __forceinline__ void xcd_barrier_complete(unsigned* bar, unsigned x, unsigned& nloc, unsigned& nx) {
    const unsigned G = gridDim.x * gridDim.y * gridDim.z;
    unsigned sum, cnt, mine, sp = 0u;
    for (;;) {
        sum = 0u; cnt = 0u; mine = 0u;
#pragma unroll
        for (unsigned j = 0; j < 16; ++j) { const unsigned c = xb_ld(&bar[XB_XCNT(j)]); sum += c; cnt += (c > 0u) ? 1u : 0u; mine = (j == x) ? c : mine; }
        if (sum == G) break;
        __builtin_amdgcn_s_sleep(1);
        if ((++sp & 255u) == 0u) { if (xb_ld(&bar[XB_TMO])) break; if (sp > XB_SPIN_CAP) { atomicAdd(&bar[XB_TMO], 1u); break; } }
    }
    nloc = mine > 0u ? mine : 1u; nx = cnt > 0u ? cnt : 1u;
}

__device__ __forceinline__ void xcd_barrier(const XcdBarrier& b) {
    asm volatile("s_waitcnt vmcnt(0)" ::: "memory");
    __syncthreads();
    if (b.w0 && lane_id() == 0) {
        unsigned* bar = b.bar;
        __builtin_amdgcn_s_waitcnt(0);
        unsigned nloc = b.st[0], nx = b.st[1];
        if (nloc == 0u) { xcd_barrier_complete(bar, b.x, nloc, nx); b.st[0] = nloc; b.st[1] = nx; }
        const unsigned old = xb_add(&bar[XB_XSUB(b.x)], 1u);
        const unsigned gen = old / nloc;
        if (old + 1u == (gen + 1u) * nloc) {
            __builtin_amdgcn_fence(__ATOMIC_RELEASE, "agent");
            asm volatile("s_waitcnt vmcnt(0)" ::: "memory");
            const unsigned og = xb_add(&bar[XB_TOP], 1u);
            const unsigned tg = og / nx;
            if (og + 1u == (tg + 1u) * nx) xb_add(&bar[XB_TOPGEN], 1u);
            else XB_SPIN(xb_ld(&bar[XB_TOPGEN]) == tg, bar);
            __builtin_amdgcn_fence(__ATOMIC_ACQUIRE, "agent");
            xb_add(&bar[XB_XGEN(b.x)], 1u);
            asm volatile("s_waitcnt vmcnt(0)" ::: "memory");
        } else {
            XB_SPIN(xb_ld(&bar[XB_XGEN(b.x)]) == gen, bar);
            __builtin_amdgcn_fence(__ATOMIC_ACQUIRE, "agent");
            asm volatile("s_waitcnt vmcnt(0)" ::: "memory");
        }
    }
    __syncthreads();
}
namespace pg8 {
#define PG8_LAS __attribute__((address_space(3)))
typedef unsigned short bf16_t;
typedef short bf16x8 __attribute__((ext_vector_type(8)));
typedef float f32x4 __attribute__((ext_vector_type(4)));
typedef unsigned u32x4 __attribute__((ext_vector_type(4)));
constexpr int BM = 256, BK = 64, HALF = 128, HTB = HALF * BK * 2  , STAGE_BYTES = 8 * HTB, NXCD = 8, WGM = 8;

__host__ __device__ __forceinline__ int lds_byte(int r, int c) { const int st = (r >> 4) * 2 + (c >> 5), rr = r & 15, cc = c & 31, ob = rr * 64 + cc * 2; return st * 1024 + (ob ^ (((ob >> 9) & 1) << 5)); }
__host__ __device__ __forceinline__ void stage_rc(int b, int& R, int& C) { const int st = b / 1024, sb = b % 1024, swz = sb ^ (((sb >> 9) & 1) << 5); R = (st >> 1) * 16 + swz / 64; C = (st & 1) * 32 + (swz % 64) / 2; }
__host__ __device__ __forceinline__ int perm32(int rho) { const int n = rho >> 4, i = rho & 15; return 8 * (i >> 2) + 4 * n + (i & 3); }

struct Unit { int pm, pn; };
struct Gemm { const bf16_t* A; const bf16_t* Bt; int M, N, K, lda, ldb, bdiv, kslice; };

struct OneUnit {
    int pm, pn;
    __host__ __device__ bool next(int i, Unit& u) const { if (i) return false; u.pm = pm; u.pn = pn; return true; }
    __device__ __forceinline__ void a_ready(const Unit&) const {}
    __device__ __forceinline__ void done(const Unit&) const {}
};
struct StaticOrder {
    int nM, nN, nwg, G, c;
    __host__ __device__ void init(int M, int N, int G_, int c_) { nM = M / BM; nN = N / BM; nwg = nM * nN; G = G_; c = c_; }
    __host__ __device__ bool next(int i, Unit& u) const {
        const long L = (long)i * G + c; if (L >= nwg) return false;
        int wgid = (int)L; { const int q = nwg / NXCD, r = nwg % NXCD, xcd = wgid % NXCD, off = wgid / NXCD; wgid = (xcd < r ? xcd * (q + 1) : r * (q + 1) + (xcd - r) * q) + off; }
        const int nig = WGM * nN, gid = wgid / nig, fm = gid * WGM, gsz = (nM - fm) < WGM ? (nM - fm) : WGM;
        u.pm = fm + ((wgid % nig) % gsz); u.pn = (wgid % nig) / gsz; return true;
    }
    __device__ __forceinline__ void a_ready(const Unit&) const {}
    __device__ __forceinline__ void done(const Unit&) const {}
};


template <class Epi, class Sched, bool ALIGN_EPI = false, bool SP2 = false>
__device__ __forceinline__ void gemm_phase(PG8_LAS unsigned char* lds, const Gemm g, const Sched& S, const Epi& E, const int wid) {
    const int lane = lane_id(), tid = wid * 64 + lane, wr = wid >> 2, wc = wid & 3, fr = lane & 15, fq = lane >> 4;
    int nt = g.K / BK; asm volatile("" : "+s"(nt));
    unsigned voffA[2], voffB[2];
#pragma unroll
    for (int i = 0; i < 2; ++i) { int R, C; stage_rc(tid * 16 + i * 8192, R, C); const int Rb = Epi::PERM ? ((R & ~31) + perm32(R & 31)) : R;
        voffA[i] = (unsigned)(R * g.lda + C) * 2u; voffB[i] = (unsigned)(Rb * g.ldb + C) * 2u; }
    const size_t kstep = (size_t)(BK * 2);
    const size_t hstepA = (size_t)HALF * g.lda * 2, hstepB = (size_t)HALF * g.ldb * 2;
    const size_t tstepA = 2 * hstepA, tstepB = 2 * hstepB;
#define PG8_BT(u) ((size_t)(g.kslice > 0 ? 0 : (g.bdiv > 0 ? (u).pm / g.bdiv : (u).pn)))
#define PG8_KO(u) ((size_t)(g.kslice > 0 ? (u).pn * g.kslice * 2 : 0))
    const unsigned ldsw = (unsigned)wid * 1024u;
    const int aoff = lds_byte(wr * 64 + fr, fq * 8), boff = lds_byte(wc * 32 + fr, fq * 8);
#define PG8_SA(b, h) (((b) * 2 + (h)) * HTB)
#define PG8_SB(b, h) ((4 + (b) * 2 + (h)) * HTB)
#define PG8_STAGE(bufoff, gbase, voff) do { _Pragma("unroll") for (int _i = 0; _i < 2; ++_i) \
        __builtin_amdgcn_global_load_lds((const unsigned*)((const char*)(gbase) + (voff)[_i]), (PG8_LAS unsigned*)(lds + (bufoff) + ldsw + _i * 8192), 16, 0, 0); } while (0)
#define PG8_LDA(dst, b, h) do { _Pragma("unroll") for (int m = 0; m < 4; ++m) _Pragma("unroll") for (int k = 0; k < 2; ++k) dst[m][k] = *(const PG8_LAS bf16x8*)(lds + PG8_SA(b, h) + aoff + m * 2048 + k * 1024); } while (0)
#define PG8_LDB(dst, b, h) do { _Pragma("unroll") for (int n = 0; n < 2; ++n) _Pragma("unroll") for (int k = 0; k < 2; ++k) dst[n][k] = *(const PG8_LAS bf16x8*)(lds + PG8_SB(b, h) + boff + n * 2048 + k * 1024); } while (0)
#define PG8_MMA(ai, bj, At, Bt) do { __builtin_amdgcn_s_setprio(1); _Pragma("unroll") for (int m = 0; m < 4; ++m) _Pragma("unroll") for (int n = 0; n < 2; ++n) _Pragma("unroll") for (int k = 0; k < 2; ++k) \
        acc[ai][bj][m][n] = __builtin_amdgcn_mfma_f32_16x16x32_bf16(Bt[n][k], At[m][k], acc[ai][bj][m][n], 0, 0, 0); __builtin_amdgcn_s_setprio(0); } while (0)
#define PG8_WAIT_V(n) asm volatile("s_waitcnt vmcnt(" #n ")" ::: "memory")
#define PG8_WAIT_L(n) asm volatile("s_waitcnt lgkmcnt(" #n ")" ::: "memory")
#define PG8_BAR __builtin_amdgcn_s_barrier()
#define PG8_SCHED __builtin_amdgcn_sched_barrier(0)
    Unit cur, nxt; int ui = 0;
    if (!S.next(0, cur)) return;
    f32x4 acc[2][2][4][2];
    typename Epi::Pre pre;
    if constexpr (Epi::HAS_PRE) E.prefetch(pre, cur, wr, fr);
    if constexpr (Epi::HAS_INIT) E.init(acc, cur, wr, wc, fr, fq);
    else {
#pragma unroll
    for (int a = 0; a < 2; ++a)
#pragma unroll
        for (int b = 0; b < 2; ++b)
#pragma unroll
            for (int m = 0; m < 4; ++m)
#pragma unroll
                for (int n = 0; n < 2; ++n) acc[a][b][m][n] = (f32x4){0.f, 0.f, 0.f, 0.f};
    }
    bf16x8 At[4][2], B0[2][2], B1[2][2];
    const char* cA = (const char*)g.A + (size_t)cur.pm * tstepA + PG8_KO(cur); const char* cB = (const char*)g.Bt + PG8_BT(cur) * tstepB + PG8_KO(cur);
    S.a_ready(cur);
    if constexpr (SP2) {
        PG8_STAGE(PG8_SB(0, 0), cB, voffB); PG8_STAGE(PG8_SB(0, 1), cB + hstepB, voffB); PG8_STAGE(PG8_SA(0, 0), cA, voffA); PG8_STAGE(PG8_SA(0, 1), cA + hstepA, voffA);
        if (wr == 1) PG8_BAR;
        PG8_WAIT_V(2); PG8_BAR;
        PG8_STAGE(PG8_SB(1, 0), cB + kstep, voffB); PG8_STAGE(PG8_SA(1, 0), cA + kstep, voffA); PG8_STAGE(PG8_SB(1, 1), cB + hstepB + kstep, voffB);
        PG8_WAIT_V(6); PG8_BAR;
    } else {
        PG8_STAGE(PG8_SB(0, 0), cB, voffB); PG8_STAGE(PG8_SA(0, 0), cA, voffA); PG8_STAGE(PG8_SB(0, 1), cB + hstepB, voffB); PG8_STAGE(PG8_SA(0, 1), cA + hstepA, voffA);
        if (wr == 1) PG8_BAR;
        PG8_WAIT_V(4); PG8_BAR;
        PG8_STAGE(PG8_SB(1, 0), cB + kstep, voffB); PG8_STAGE(PG8_SA(1, 0), cA + kstep, voffA); PG8_STAGE(PG8_SB(1, 1), cB + hstepB + kstep, voffB);
        PG8_WAIT_V(6); PG8_BAR;
    }
    for (;;) {
        const bool has_next = S.next(ui + 1, nxt);
        const char* nA = has_next ? (const char*)g.A + (size_t)nxt.pm * tstepA + PG8_KO(nxt) : cA; const char* nB = has_next ? (const char*)g.Bt + PG8_BT(nxt) * tstepB + PG8_KO(nxt) : cB;
        for (int t = 0; t < nt; t += 2) {
            const bool last = (t == nt - 2);
            if constexpr (Epi::MIDK) { if (t == (nt >> 1)) E.midk(acc, cur, wr, fr); }
            const char* a1 = cA + (size_t)(t + 1) * kstep;
            const char* a2 = last ? nA : cA + (size_t)(t + 2) * kstep; const char* b2 = last ? nB : cB + (size_t)(t + 2) * kstep;
            const char* a3 = a2 + kstep; const char* b3 = b2 + kstep;
            if (last && has_next) S.a_ready(nxt);
            if constexpr (SP2) {
            PG8_LDB(B0, 0, 0); PG8_LDB(B1, 0, 1); PG8_SCHED; PG8_LDA(At, 0, 0); PG8_STAGE(PG8_SA(1, 1), a1 + hstepA, voffA);
            PG8_WAIT_V(8); PG8_WAIT_L(0); PG8_BAR; PG8_MMA(0, 0, At, B0); PG8_MMA(0, 1, At, B1); PG8_BAR; PG8_SCHED;
            PG8_LDA(At, 0, 1); PG8_STAGE(PG8_SB(0, 0), b2, voffB); PG8_STAGE(PG8_SB(0, 1), b2 + hstepB, voffB); PG8_STAGE(PG8_SA(0, 0), a2, voffA);
            PG8_WAIT_V(8); PG8_WAIT_L(0); PG8_BAR; PG8_MMA(1, 0, At, B0); PG8_MMA(1, 1, At, B1); PG8_BAR; PG8_SCHED;
            PG8_LDB(B0, 1, 0); PG8_LDB(B1, 1, 1); PG8_SCHED; PG8_LDA(At, 1, 0); PG8_STAGE(PG8_SA(0, 1), a2 + hstepA, voffA);
            PG8_WAIT_V(8); PG8_WAIT_L(0); PG8_BAR; PG8_MMA(0, 0, At, B0); PG8_MMA(0, 1, At, B1); PG8_BAR; PG8_SCHED;
            PG8_LDA(At, 1, 1); PG8_STAGE(PG8_SB(1, 0), b3, voffB); PG8_STAGE(PG8_SB(1, 1), b3 + hstepB, voffB); PG8_STAGE(PG8_SA(1, 0), a3, voffA);
            PG8_WAIT_V(8); PG8_WAIT_L(0); PG8_BAR; PG8_MMA(1, 0, At, B0); PG8_MMA(1, 1, At, B1); PG8_BAR; PG8_SCHED;
            } else {
            PG8_LDB(B0, 0, 0); PG8_SCHED; PG8_LDA(At, 0, 0); PG8_STAGE(PG8_SA(1, 1), a1 + hstepA, voffA);
            PG8_WAIT_L(8); PG8_BAR; PG8_WAIT_L(0); PG8_MMA(0, 0, At, B0); PG8_BAR; PG8_SCHED;
            PG8_LDB(B1, 0, 1); PG8_STAGE(PG8_SB(0, 0), b2, voffB);
            PG8_BAR; PG8_WAIT_L(0); PG8_MMA(0, 1, At, B1); PG8_BAR;
            PG8_LDA(At, 0, 1); PG8_STAGE(PG8_SA(0, 0), a2, voffA);
            PG8_BAR; PG8_WAIT_L(0); PG8_MMA(1, 0, At, B0); PG8_BAR; PG8_SCHED;
            PG8_STAGE(PG8_SB(0, 1), b2 + hstepB, voffB);
            PG8_WAIT_V(6); PG8_BAR; PG8_MMA(1, 1, At, B1); PG8_BAR;
            PG8_LDB(B0, 1, 0); PG8_SCHED; PG8_LDA(At, 1, 0); PG8_STAGE(PG8_SA(0, 1), a2 + hstepA, voffA);
            PG8_WAIT_L(8); PG8_BAR; PG8_WAIT_L(0); PG8_MMA(0, 0, At, B0); PG8_BAR; PG8_SCHED;
            PG8_LDB(B1, 1, 1); PG8_STAGE(PG8_SB(1, 0), b3, voffB);
            PG8_BAR; PG8_WAIT_L(0); PG8_MMA(0, 1, At, B1); PG8_BAR;
            PG8_LDA(At, 1, 1); PG8_STAGE(PG8_SA(1, 0), a3, voffA);
            PG8_BAR; PG8_WAIT_L(0); PG8_MMA(1, 0, At, B0); PG8_BAR; PG8_SCHED;
            PG8_STAGE(PG8_SB(1, 1), b3 + hstepB, voffB);
            PG8_WAIT_V(6); PG8_BAR; PG8_MMA(1, 1, At, B1); PG8_BAR;
            }
        }
        if constexpr (ALIGN_EPI) { if (wr == 0) PG8_BAR; }
        if constexpr (!Epi::AFTER_DRAIN) { if constexpr (Epi::HAS_PRE) E(acc, cur, wr, wc, fr, fq, pre); else E(acc, cur, wr, wc, fr, fq); S.done(cur); }
        if (!has_next) break;
        if constexpr (Epi::HAS_PRE) E.prefetch(pre, nxt, wr, fr);
        if constexpr (Epi::HAS_INIT) E.init(acc, nxt, wr, wc, fr, fq);
        else {
#pragma unroll
        for (int a = 0; a < 2; ++a)
#pragma unroll
            for (int b = 0; b < 2; ++b)
#pragma unroll
                for (int m = 0; m < 4; ++m)
#pragma unroll
                    for (int n = 0; n < 2; ++n) acc[a][b][m][n] = (f32x4){0.f, 0.f, 0.f, 0.f};
        }
        cur = nxt; cA = nA; cB = nB; ++ui;
        if constexpr (ALIGN_EPI) { if (wr == 1) PG8_BAR; }
    }
    PG8_WAIT_V(0);
    if constexpr (!ALIGN_EPI) { if (wr == 0) PG8_BAR; }
    PG8_BAR;
    if constexpr (Epi::AFTER_DRAIN) { E.fused(acc, cur, wr, wc, fr, fq, lds, wid, lane); S.done(cur); }
#undef PG8_BT
#undef PG8_KO
#undef PG8_SA
#undef PG8_SB
#undef PG8_STAGE
#undef PG8_LDA
#undef PG8_LDB
#undef PG8_MMA
#undef PG8_WAIT_V
#undef PG8_WAIT_L
#undef PG8_BAR
#undef PG8_SCHED
}
}
namespace pg8 {
typedef float f32x2 __attribute__((ext_vector_type(2)));
typedef unsigned u32x2 __attribute__((ext_vector_type(2)));
__device__ __forceinline__ unsigned cvt_pk_bf16(float lo, float hi) { unsigned r; asm volatile("v_cvt_pk_bf16_f32 %0, %1, %2" : "=v"(r) : "v"(lo), "v"(hi)); return r; }
__device__ __forceinline__ u32x4 pack8(const f32x4 a, const f32x4 b) { u32x4 w; w.x = cvt_pk_bf16(a[0], a[1]); w.y = cvt_pk_bf16(a[2], a[3]); w.z = cvt_pk_bf16(b[0], b[1]); w.w = cvt_pk_bf16(b[2], b[3]); return w; }
__device__ __forceinline__ float fast_sigmoid(float x) { return __builtin_amdgcn_rcpf(1.f + __builtin_amdgcn_exp2f(-1.4426950408889634f * x)); }
__device__ __forceinline__ float fast_gelu_tanh(float x) { const float u2 = 1.5957691216057308f * (x + 0.044715f * x * x * x); return x * fast_sigmoid(u2); }
__device__ __forceinline__ float sum16(const float* p) { const f32x4 a = *(const f32x4*)p, b = *(const f32x4*)(p + 4), c = *(const f32x4*)(p + 8), d = *(const f32x4*)(p + 12);
    return ((a[0] + a[1]) + (a[2] + a[3])) + ((b[0] + b[1]) + (b[2] + b[3])) + ((c[0] + c[1]) + (c[2] + c[3])) + ((d[0] + d[1]) + (d[2] + d[3])); }
__device__ __forceinline__ float sum8(const float* p) { const f32x4 a = *(const f32x4*)p, b = *(const f32x4*)(p + 4); return ((a[0] + a[1]) + (a[2] + a[3])) + ((b[0] + b[1]) + (b[2] + b[3])); }
__device__ __forceinline__ float dot4(const f32x4 x) { return (x[0] * x[0] + x[1] * x[1]) + (x[2] * x[2] + x[3] * x[3]); }

struct RowScaleTable {
    const PG8_LAS float* tab; int pmA, pmB; const float* ssq;
    __device__ __forceinline__ float get(int pm, int row) const {
        if (pm == pmA) return tab[row & 255];
        if (pm == pmB) return tab[256 + (row & 255)];
        return __builtin_amdgcn_rsqf(sum16(ssq + (size_t)row * 16) * (1.f / cfg::D) + cfg::EPS);
    }
};
template <class Sched> __device__ __forceinline__ RowScaleTable make_row_scale_table(PG8_LAS float* tab, const float* ssq, const Sched& S, int tid) {
    RowScaleTable T; T.tab = tab; T.ssq = ssq; T.pmA = -1; T.pmB = -1;
    Unit u;
    for (int i = 0; S.next(i, u); ++i) { if (T.pmA < 0) T.pmA = u.pm; else if (u.pm != T.pmA && T.pmB < 0) T.pmB = u.pm; }
    const int pm = (tid < 256) ? T.pmA : T.pmB;
    if (pm >= 0) { const int row = pm * 256 + (tid & 255); tab[tid] = __builtin_amdgcn_rsqf(sum16(ssq + (size_t)row * 16) * (1.f / cfg::D) + cfg::EPS); }
    __syncthreads();
    return T;
}
struct EpiSwiGLU {
    static constexpr bool PERM = true, AFTER_DRAIN = false, MIDK = false, HAS_INIT = false, HAS_PRE = false; struct Pre {};
    bf16_t* Hh; bool scaled; RowScaleTable rt;
    __device__ __forceinline__ void operator()(const f32x4 (&acc)[2][2][4][2], const Unit& u, int wr, int wc, int fr, int fq) const {
        const int row0 = u.pm * BM + wr * 64 + fr, hcol = u.pn * 128 + wc * 32 + 8 * fq;
#pragma unroll
        for (int ai = 0; ai < 2; ++ai)
#pragma unroll
            for (int m = 0; m < 4; ++m) {
                const int row = row0 + ai * HALF + m * 16;
                const float rs = scaled ? rt.get(u.pm, row) : 1.f;
                f32x4 h0, h1;
#pragma unroll
                for (int i = 0; i < 4; ++i) { const float g0 = acc[ai][0][m][0][i] * rs, g1 = acc[ai][0][m][1][i] * rs;
                    h0[i] = g0 * fast_sigmoid(g0) * (acc[ai][1][m][0][i] * rs); h1[i] = g1 * fast_sigmoid(g1) * (acc[ai][1][m][1][i] * rs); }
                *(u32x4*)(Hh + (size_t)row * cfg::FF + hcol) = pack8(h0, h1);
            }
    }
};
template <int MODE> struct EpiResid {
    static constexpr bool PERM = true, AFTER_DRAIN = false, MIDK = (MODE == 1), HAS_INIT = true, HAS_PRE = false; struct Pre {};
    const float* resid32; bf16_t* XBp; float* ssq; const float* ssq_a; const float* ssq_s;
    __device__ __forceinline__ float rs_of(int row) const { return __builtin_amdgcn_rsqf(sum8(ssq_s + (size_t)row * 8) * (1.f / 512) + cfg::EPS); }
    __device__ __forceinline__ void midk(f32x4 (&acc)[2][2][4][2], const Unit& u, int wr, int fr) const {
        const int row0 = u.pm * BM + wr * 64 + fr;
#pragma unroll
        for (int ai = 0; ai < 2; ++ai)
#pragma unroll
            for (int m = 0; m < 4; ++m) {
                int row = row0 + ai * HALF + m * 16; asm volatile("" : "+v"(row));
                const f32x2 sa = *(const f32x2*)(ssq_a + (size_t)row * 2);
                const float ra = __builtin_amdgcn_rsqf((sa[0] + sa[1]) * (1.f / 512) + cfg::EPS);
                const float rho = ra * __builtin_amdgcn_rcpf(rs_of(row));
#pragma unroll
                for (int bj = 0; bj < 2; ++bj)
#pragma unroll
                    for (int n = 0; n < 2; ++n) acc[ai][bj][m][n] = acc[ai][bj][m][n] * rho;
            }
    }
    __device__ __forceinline__ void init(f32x4 (&acc)[2][2][4][2], const Unit& u, int wr, int wc, int fr, int fq) const {
        const int row0 = u.pm * BM + wr * 64 + fr, col0 = u.pn * BM + wc * 32 + 8 * fq;
#pragma unroll
        for (int ai = 0; ai < 2; ++ai)
#pragma unroll
            for (int m = 0; m < 4; ++m) {
                const int row = row0 + ai * HALF + m * 16;
                float s0 = 2.f;
                if (MODE == 1) { const f32x2 sa = *(const f32x2*)(ssq_a + (size_t)row * 2); s0 = __builtin_amdgcn_sqrtf((sa[0] + sa[1]) * (1.f / 512) + cfg::EPS); }
#pragma unroll
                for (int bj = 0; bj < 2; ++bj) {
                    const size_t off = (size_t)row * cfg::D + col0 + bj * HALF;
                    if (MODE == 0) { acc[ai][bj][m][0] = *(const f32x4*)(resid32 + off) * s0; acc[ai][bj][m][1] = *(const f32x4*)(resid32 + off + 4) * s0; }
                    else { const u32x4 w = *(const u32x4*)(XBp + off);
                        acc[ai][bj][m][0] = (f32x4){__uint_as_float(w.x << 16), __uint_as_float(w.x & 0xffff0000u), __uint_as_float(w.y << 16), __uint_as_float(w.y & 0xffff0000u)} * s0;
                        acc[ai][bj][m][1] = (f32x4){__uint_as_float(w.z << 16), __uint_as_float(w.z & 0xffff0000u), __uint_as_float(w.w << 16), __uint_as_float(w.w & 0xffff0000u)} * s0; }
                }
            }
    }
    __device__ __forceinline__ void operator()(const f32x4 (&acc)[2][2][4][2], const Unit& u, int wr, int wc, int fr, int fq) const {
        const int row0 = u.pm * BM + wr * 64 + fr, col0 = u.pn * BM + wc * 32 + 8 * fq;
#pragma unroll
        for (int ai = 0; ai < 2; ++ai)
#pragma unroll
            for (int m = 0; m < 4; ++m) {
                int row = row0 + ai * HALF + m * 16; if (MODE == 1) asm volatile("" : "+v"(row));
                const float sc = MODE == 1 ? rs_of(row) : 0.5f;
                float sq = 0.f;
#pragma unroll
                for (int bj = 0; bj < 2; ++bj) {
                    const f32x4 x0 = acc[ai][bj][m][0] * sc, x1 = acc[ai][bj][m][1] * sc;
                    sq += dot4(x0) + dot4(x1);
                    *(u32x4*)(XBp + (size_t)row * cfg::D + col0 + bj * HALF) = pack8(x0, x1);
                }
                sq += __shfl_xor(sq, 16); sq += __shfl_xor(sq, 32);
                if (fq == 0) ssq[(size_t)row * 16 + u.pn * 4 + wc] = sq;
            }
    }
};
struct EpiWin {
    static constexpr bool PERM = true, AFTER_DRAIN = false, MIDK = false, HAS_INIT = false, HAS_PRE = false; struct Pre {};
    MixBufs mb; RowScaleTable rt;
    __device__ __forceinline__ void operator()(const f32x4 (&acc)[2][2][4][2], const Unit& u, int wr, int wc, int fr, int fq) const {
        using namespace cfg;
        const int row0 = u.pm * BM + wr * 64 + fr, colb = u.pn * BM + wc * 32 + 8 * fq;
#pragma unroll
        for (int ai = 0; ai < 2; ++ai)
#pragma unroll
            for (int m = 0; m < 4; ++m) {
                const int row = row0 + ai * HALF + m * 16, b = row >> 12, t = row & (T - 1);
                const float rs = rt.get(u.pm, row);
#pragma unroll
                for (int bj = 0; bj < 2; ++bj) {
                    const int col = colb + bj * HALF;
                    f32x4 v0 = acc[ai][bj][m][0] * rs, v1 = acc[ai][bj][m][1] * rs;
                    if (col < 512) { const int h = col >> 6, d = col & 63; *(u32x4*)(mb.Q + (((size_t)(b * NH + h)) * T + t) * 64 + d) = pack8(v0 * C2, v1 * C2); }
                    else if (col < 1280) { const int c = col - 512, part = c >> 7, g = (c >> 6) & 1, d = c & 63; *(u32x4*)(mb.KV + (size_t)part * KVPART + (((size_t)(b * 2 + g)) * T + t) * 64 + d) = pack8(v0, v1); }
                    else if (col < 1304) { const int c = col - 1280; const f32x4 b0 = *(const f32x4*)(mb.gate_bias + c), b1 = *(const f32x4*)(mb.gate_bias + c + 4);
#pragma unroll
                        for (int i = 0; i < 4; ++i) { v0[i] = fast_sigmoid(v0[i] + b0[i]); v1[i] = fast_sigmoid(v1[i] + b1[i]); }
                        *(f32x4*)(mb.GATES + (size_t)row * 24 + c) = v0; *(f32x4*)(mb.GATES + (size_t)row * 24 + c + 4) = v1; }
                    else if (col < INC) { const int c = col - 1304, g = c >> 4, h = c & 15; *(u32x4*)(mb.UX + ((size_t)(g * 2048 + b * 256 + (t >> 4))) * 384 + (t & 15) * 16 + h) = pack8(v0, v1); }
                }
            }
    }
};
struct EpiPart {
    static constexpr bool PERM = false, AFTER_DRAIN = false, MIDK = false, HAS_INIT = false, HAS_PRE = false; struct Pre {};
    float* PART;
    __device__ __forceinline__ void operator()(const f32x4 (&acc)[2][2][4][2], const Unit& u, int wr, int wc, int fr, int fq) const {
        const int row0 = u.pm * BM + wr * 64 + fr, col0 = wc * 32 + 4 * fq; float* P = PART + (size_t)u.pn * 4096 * 256;
#pragma unroll
        for (int ai = 0; ai < 2; ++ai)
#pragma unroll
            for (int m = 0; m < 4; ++m)
#pragma unroll
                for (int bj = 0; bj < 2; ++bj)
#pragma unroll
                    for (int n = 0; n < 2; ++n) *(f32x4*)(P + (size_t)(row0 + ai * HALF + m * 16) * 256 + col0 + bj * HALF + n * 16) = acc[ai][bj][m][n];
    }
};
struct EpiS5S {
    static constexpr bool PERM = false, AFTER_DRAIN = false, MIDK = false, HAS_INIT = false, HAS_PRE = false; struct Pre {};
    float* S;
    __device__ __forceinline__ void operator()(const f32x4 (&acc)[2][2][4][2], const Unit& u, int wr, int wc, int fr, int fq) const {
        const int row0 = u.pm * BM + wr * 64 + fr, col0 = wc * 32 + 4 * fq;
#pragma unroll
        for (int ai = 0; ai < 2; ++ai)
#pragma unroll
            for (int m = 0; m < 4; ++m)
#pragma unroll
                for (int n = 0; n < 2; ++n) *(f32x4*)(S + (size_t)(row0 + ai * HALF + m * 16) * 128 + col0 + n * 16) = acc[ai][0][m][n];
    }
};
struct EpiS5Y {
    static constexpr bool PERM = true, AFTER_DRAIN = false, MIDK = false, HAS_INIT = false, HAS_PRE = false; struct Pre {};
    bf16_t* YG;
    __device__ __forceinline__ void operator()(const f32x4 (&acc)[2][2][4][2], const Unit& u, int wr, int wc, int fr, int fq) const {
        const int row0 = u.pm * BM + wr * 64 + fr, colb = wc * 32 + 8 * fq;
#pragma unroll
        for (int ai = 0; ai < 2; ++ai)
#pragma unroll
            for (int m = 0; m < 4; ++m) {
                int R = row0 + ai * HALF + m * 16; asm volatile("" : "+v"(R));
                const int g = R >> 11, rr = R & 2047, b = rr >> 8, c = rr & 255;
#pragma unroll
                for (int bj = 0; bj < 2; ++bj) {
                    const int col = colb + bj * HALF, tl = col >> 4, h = col & 15;
                    f32x4 v0 = acc[ai][bj][m][0], v1 = acc[ai][bj][m][1];
#pragma unroll
                    for (int i = 0; i < 4; ++i) { v0[i] = fast_gelu_tanh(v0[i]); v1[i] = fast_gelu_tanh(v1[i]); }
                    *(u32x4*)(YG + ((size_t)(b * cfg::T + c * 16 + tl)) * 512 + g * 16 + h) = pack8(v0, v1);
                }
                __builtin_amdgcn_sched_barrier(0);
            }
    }
};
struct EpiGLU {
    static constexpr bool PERM = true, AFTER_DRAIN = false, MIDK = false, HAS_INIT = false, HAS_PRE = false; struct Pre {};
    const bf16_t* YG; const float* bias; bf16_t* SSM; float* ssq;
    __device__ __forceinline__ void operator()(const f32x4 (&acc)[2][2][4][2], const Unit& u, int wr, int wc, int fr, int fq) const {
        const int row0 = u.pm * BM + wr * 64 + fr, colb = u.pn * BM + wc * 32 + 8 * fq;
#pragma unroll
        for (int ai = 0; ai < 2; ++ai)
#pragma unroll
            for (int m = 0; m < 4; ++m) {
                const int row = row0 + ai * HALF + m * 16; float sq = 0.f;
#pragma unroll
                for (int bj = 0; bj < 2; ++bj) {
                    const int col = colb + bj * HALF;
                    const f32x4 b0 = *(const f32x4*)(bias + col), b1 = *(const f32x4*)(bias + col + 4);
                    const u32x4 yw = *(const u32x4*)(YG + (size_t)row * 512 + col);
                    f32x4 y0, y1;
                    y0[0] = __uint_as_float(yw.x << 16); y0[1] = __uint_as_float(yw.x & 0xffff0000u); y0[2] = __uint_as_float(yw.y << 16); y0[3] = __uint_as_float(yw.y & 0xffff0000u);
                    y1[0] = __uint_as_float(yw.z << 16); y1[1] = __uint_as_float(yw.z & 0xffff0000u); y1[2] = __uint_as_float(yw.w << 16); y1[3] = __uint_as_float(yw.w & 0xffff0000u);
                    f32x4 v0, v1;
#pragma unroll
                    for (int i = 0; i < 4; ++i) { v0[i] = y0[i] * fast_sigmoid(acc[ai][bj][m][0][i] + b0[i]); v1[i] = y1[i] * fast_sigmoid(acc[ai][bj][m][1][i] + b1[i]); }
                    sq += dot4(v0) + dot4(v1);
                    *(u32x4*)(SSM + (size_t)row * cfg::MIXP + col) = pack8(v0, v1);
                }
                sq += __shfl_xor(sq, 16); sq += __shfl_xor(sq, 32);
                if (fq == 0) ssq[(size_t)row * 8 + u.pn * 4 + wc] = sq;
            }
    }
};
}
constexpr int NWAVES = 8;
constexpr int RING_BYTES = 131072;
constexpr int LDSCTL_OFF = RING_BYTES, MISC_OFF = LDSCTL_OFF + 320;
constexpr int BIAS_OFF = RING_BYTES + 1024;
constexpr int LDS_BYTES = 147456;
constexpr size_t WS_CBP = wsl::S5A + 64 * 1024;

struct Args { const float* in[34]; float* out; unsigned char* ws; int ph_lo, ph_hi; };

struct Frame { LAS unsigned char* lds; int wave, G, gw, NGW; __device__ __forceinline__ int tid() const { return wave * 64 + lane_id(); } };

__device__ __forceinline__ float wave_sum(float v) {
#pragma unroll
    for (int o = 1; o < 64; o <<= 1) v += __shfl_xor(v, o);
    return v;
}
__device__ __forceinline__ void tr_item(const float* __restrict__ W, int N, int Npad, const float* __restrict__ gain, bf16_t* WT, int ldt, int mode, LAS float* scr, int item, int lane) {
    const int nblk = Npad / 32, kb = item / nblk, nb = item % nblk, k0 = 64 * kb, n0 = 32 * nb;
    const int kk8 = lane >> 3, n4 = (lane & 7) * 4; const bool ok = (n0 + n4) < N;
    f32x4 v[8];
#pragma unroll
    for (int i = 0; i < 8; ++i) v[i] = ok ? *(const GAS f32x4*)(W + (size_t)(k0 + 8 * i + kk8) * N + n0 + n4) : (f32x4){0.f, 0.f, 0.f, 0.f};
#pragma unroll
    for (int i = 0; i < 8; ++i) { const int kk = 8 * i + kk8; const float gk = gain ? gain[k0 + kk] : 1.f; LAS float* d = scr + kk * 33 + n4;
        d[0] = v[i].x * gk; d[1] = v[i].y * gk; d[2] = v[i].z * gk; d[3] = v[i].w * gk; }
    LDS_WAIT(); asm volatile("" ::: "memory");
    const int c = lane & 7;
#pragma unroll
    for (int j = 0; j < 4; ++j) { const int nl = (lane >> 3) + 8 * j, n = n0 + nl; const LAS float* s = scr + (8 * c) * 33 + nl;
        const int row = mode == 0 ? n : ((n >> 7) * 256 + (mode == 2 ? 128 : 0) + (n & 127));
        v4u o; o.x = pk2(s[0 * 33], s[1 * 33]); o.y = pk2(s[2 * 33], s[3 * 33]); o.z = pk2(s[4 * 33], s[5 * 33]); o.w = pk2(s[6 * 33], s[7 * 33]);
        *(GAS v4u*)(WT + (size_t)row * ldt + k0 + 8 * c) = o; }
    LDS_WAIT(); asm volatile("" ::: "memory");
}
struct S5P { float xr, xi, fr, fi; };
__device__ __forceinline__ S5P s5_param(const float* const* in, int g, int p) {
    const float dt = expf(in[18][g]), lr = in[16][g * 64 + p], li = in[17][g * 64 + p];
    S5P q; q.xr = lr * dt; q.xi = li * dt;
    const float mag = expf(q.xr), ar = mag * cosf(q.xi), ai = mag * sinf(q.xi), nr = ar - 1.f, den = lr * lr + li * li;
    q.fr = (nr * lr + ai * li) / den; q.fi = (ai * lr - nr * li) / den; return q;
}
__device__ __forceinline__ void cpow(const S5P& q, int n, float& re, float& im) { const float mag = expf(n * q.xr), ang = n * q.xi; re = mag * cosf(ang); im = mag * sinf(ang); }

__device__ __forceinline__ void p0_prologue(Frame& F, const Args& a) {
    using namespace cfg;
    unsigned char* ws = a.ws; const float* const* in = a.in;
    LAS float* scr = (LAS float*)(F.lds + F.wave * 16384);
    const int lane = lane_id();
    bf16_t* BTS = (bf16_t*)(ws + wsl::BTS); bf16_t* BTY = (bf16_t*)(ws + wsl::BTY);
    constexpr int N_KT = SGRP * 31, N_V = SGRP * 16, N_S = SGRP * 16, N_Z = SGRP * 8, N_A = SGRP, N_CB = 2 * 4 * 16;
    constexpr int NS5 = N_KT + N_V + N_S + N_Z + N_A + N_CB;
    for (int it = F.gw; it < NS5; it += F.NGW) {
        int r = it;
        if (r < N_KT) {
            const int g = r / 31, tau = r % 31 - 15; bf16_t* Bg = BTY + (size_t)g * 256 * 384;
            if (tau < 0) {
                for (int t = 0; t <= 15 + tau; ++t) { const int s = t - tau;
#pragma unroll
                    for (int e = 0; e < 4; ++e) { const int idx = lane + 64 * e, h = idx >> 4, h2 = idx & 15; Bg[(size_t)(t * 16 + h) * 384 + s * 16 + h2] = 0; } }
                continue;
            }
            const int p = lane; const S5P q = s5_param(in, g, p); float pr, pi; cpow(q, tau, pr, pi);
            float car[16], cai[16];
#pragma unroll
            for (int h = 0; h < 16; ++h) { const float cr = in[21][(size_t)(g * 16 + h) * 64 + p], ci = in[22][(size_t)(g * 16 + h) * 64 + p]; car[h] = cr * pr - ci * pi; cai[h] = cr * pi + ci * pr; }
            float keep[4] = {0.f, 0.f, 0.f, 0.f};
#pragma unroll 1
            for (int h2 = 0; h2 < 16; ++h2) {
                const float br = in[19][(size_t)(g * 64 + p) * 16 + h2], bi = in[20][(size_t)(g * 64 + p) * 16 + h2];
                const float bbr = q.fr * br - q.fi * bi, bbi = q.fr * bi + q.fi * br;
#pragma unroll
                for (int h = 0; h < 16; ++h) { const float v = wave_sum(car[h] * bbr - cai[h] * bbi); if ((((h & 3) << 4) | h2) == lane) keep[h >> 2] = v; }
            }
#pragma unroll
            for (int e = 0; e < 4; ++e) { const int idx = lane + 64 * e, h = idx >> 4, h2 = idx & 15;
                const float v = keep[e] + ((tau == 0 && h == h2) ? in[23][g * 16 + h] : 0.f); const bf16_t w = f2bf(v);
                for (int t = tau; t < 16; ++t) Bg[(size_t)(t * 16 + h) * 384 + (t - tau) * 16 + h2] = w; }
            continue;
        } r -= N_KT;
        if (r < N_V) {
            const int g = r >> 4, t = r & 15, p = lane; const S5P q = s5_param(in, g, p); float pr, pi; cpow(q, t + 1, pr, pi);
            bf16_t* Bg = BTY + (size_t)g * 256 * 384;
#pragma unroll
            for (int h = 0; h < 16; ++h) { const float cr = in[21][(size_t)(g * 16 + h) * 64 + p], ci = in[22][(size_t)(g * 16 + h) * 64 + p];
                Bg[(size_t)(t * 16 + h) * 384 + 256 + p] = f2bf(cr * pr - ci * pi); Bg[(size_t)(t * 16 + h) * 384 + 320 + p] = f2bf(-(cr * pi + ci * pr)); }
            continue;
        } r -= N_V;
        if (r < N_S) {
            const int g = r >> 4, s = r & 15, p = lane; const S5P q = s5_param(in, g, p); float pr, pi; cpow(q, 15 - s, pr, pi);
            bf16_t* Bg = BTS + (size_t)g * 256 * 256;
#pragma unroll
            for (int h = 0; h < 16; ++h) { const float br = in[19][(size_t)(g * 64 + p) * 16 + h], bi = in[20][(size_t)(g * 64 + p) * 16 + h];
                const float bbr = q.fr * br - q.fi * bi, bbi = q.fr * bi + q.fi * br;
                Bg[(size_t)p * 256 + s * 16 + h] = f2bf(pr * bbr - pi * bbi); Bg[(size_t)(64 + p) * 256 + s * 16 + h] = f2bf(pr * bbi + pi * bbr); }
            continue;
        } r -= N_S;
        if (r < N_Z) {
            const int g = r >> 3, blk = r & 7; GAS v4u* z = (GAS v4u*)(BTS + (size_t)g * 256 * 256 + (size_t)(128 + 16 * blk) * 256);
            for (int i = lane; i < 16 * 256 * 2 / 16; i += 64) z[i] = (v4u){0u, 0u, 0u, 0u};
            continue;
        } r -= N_Z;
        if (r < N_A) { const int g = r, p = lane; const S5P q = s5_param(in, g, p); float pr, pi; cpow(q, LCH, pr, pi); float* A16 = (float*)(ws + wsl::S5A); A16[(g * 64 + p) * 2] = pr; A16[(g * 64 + p) * 2 + 1] = pi; continue; } r -= N_A;
        {
            const int ten = r >> 6, nb = (r >> 4) & 3, ks = r & 15, n = nb * 64 + lane; const float* pos = ten ? in[9] : in[8]; const float* w1 = ten ? in[13] : in[10];
            float acc = 0.f;
            for (int kk = ks * 128; kk < ks * 128 + 128; ++kk) acc += pos[kk] * w1[(size_t)kk * 256 + n];
            ((float*)(ws + WS_CBP))[(ten * 16 + ks) * 256 + n] = acc;
        }
    }
    constexpr int I_GU = 16 * 88, I_DN = 44 * 32, I_WIN = 16 * 64, I_WO = 8 * 32, I_C1 = 32 * 8, I_C2 = 4 * 2, I_GLU = 8 * 16;
    constexpr int NTR = 2 * (2 * I_GU + I_DN) + I_WIN + 2 * I_WO + 2 * I_C1 + 2 * I_C2 + I_GLU;
    for (int it = F.gw; it < NTR; it += F.NGW) {
        int r = it;
        if (r < I_GU) { tr_item(in[2], FF, FF, in[1], (bf16_t*)(ws + wsl::W1A), D, 1, scr, r, lane); continue; } r -= I_GU;
        if (r < I_GU) { tr_item(in[3], FF, FF, in[1], (bf16_t*)(ws + wsl::W1A), D, 2, scr, r, lane); continue; } r -= I_GU;
        if (r < I_DN) { tr_item(in[4], D, D, nullptr, (bf16_t*)(ws + wsl::W1D), FF, 0, scr, r, lane); continue; } r -= I_DN;
        if (r < I_GU) { tr_item(in[30], FF, FF, in[29], (bf16_t*)(ws + wsl::W2A), D, 1, scr, r, lane); continue; } r -= I_GU;
        if (r < I_GU) { tr_item(in[31], FF, FF, in[29], (bf16_t*)(ws + wsl::W2A), D, 2, scr, r, lane); continue; } r -= I_GU;
        if (r < I_DN) { tr_item(in[32], D, D, nullptr, (bf16_t*)(ws + wsl::W2D), FF, 0, scr, r, lane); continue; } r -= I_DN;
        if (r < I_WIN) { tr_item(in[6], INC, INC_PAD, in[5], (bf16_t*)(ws + wsl::WIN), D, 0, scr, r, lane); continue; } r -= I_WIN;
        if (r < I_WO) { tr_item(in[28], D, D, in[26], (bf16_t*)(ws + wsl::WOUT), D, 0, scr, r, lane); continue; } r -= I_WO;
        if (r < I_WO) { tr_item(in[28] + (size_t)512 * D, D, D, in[27], (bf16_t*)(ws + wsl::WOUT) + 512, D, 0, scr, r, lane); continue; } r -= I_WO;
        if (r < I_C1) { tr_item(in[10], 256, 256, nullptr, (bf16_t*)(ws + wsl::CW1K), 2048, 0, scr, r, lane); continue; } r -= I_C1;
        if (r < I_C1) { tr_item(in[13], 256, 256, nullptr, (bf16_t*)(ws + wsl::CW1V), 2048, 0, scr, r, lane); continue; } r -= I_C1;
        if (r < I_C2) { tr_item(in[12], 64, 64, nullptr, (bf16_t*)(ws + wsl::CW2K), 256, 0, scr, r, lane); continue; } r -= I_C2;
        if (r < I_C2) { tr_item(in[15], 64, 64, nullptr, (bf16_t*)(ws + wsl::CW2V), 256, 0, scr, r, lane); continue; } r -= I_C2;
        tr_item(in[24], 512, 512, nullptr, (bf16_t*)(ws + wsl::GLUW), 512, 0, scr, r, lane);
    }
    for (int m = F.gw; m < M; m += 2 * F.NGW) {
        const int m2 = m + F.NGW;
        const GAS f32x4* xr = (const GAS f32x4*)(in[0] + (size_t)m * D) + lane; const GAS f32x4* xr2 = (const GAS f32x4*)(in[0] + (size_t)(m2 < M ? m2 : m) * D) + lane;
        f32x4 v[4], w[4]; float s = 0.f, s2 = 0.f;
#pragma unroll
        for (int j = 0; j < 4; ++j) { v[j] = xr[64 * j]; w[j] = xr2[64 * j]; }
#pragma unroll
        for (int j = 0; j < 4; ++j) { s += (v[j].x * v[j].x + v[j].y * v[j].y) + (v[j].z * v[j].z + v[j].w * v[j].w); s2 += (w[j].x * w[j].x + w[j].y * w[j].y) + (w[j].z * w[j].z + w[j].w * w[j].w); }
        const float r = rsqrtf(wave_sum(s) * (1.f / D) + EPS), r2 = rsqrtf(wave_sum(s2) * (1.f / D) + EPS);
        GAS unsigned long long* o8 = (GAS unsigned long long*)((bf16_t*)(ws + wsl::XB) + (size_t)m * D) + lane;
#pragma unroll
        for (int j = 0; j < 4; ++j) o8[64 * j] = (unsigned long long)pk2(v[j].x * r, v[j].y * r) | ((unsigned long long)pk2(v[j].z * r, v[j].w * r) << 32);
        if (m2 < M) { GAS unsigned long long* p8 = (GAS unsigned long long*)((bf16_t*)(ws + wsl::XB) + (size_t)m2 * D) + lane;
#pragma unroll
            for (int j = 0; j < 4; ++j) p8[64 * j] = (unsigned long long)pk2(w[j].x * r2, w[j].y * r2) | ((unsigned long long)pk2(w[j].z * r2, w[j].w * r2) << 32); }
    }
}
__device__ __forceinline__ void s5_scan_task(const Args& a, int bg, int lane) {
    using namespace cfg;
    const int g = bg & 31, b = bg >> 5, p = lane;
    const float* A16 = (const float*)(a.ws + wsl::S5A); const float ar = A16[(g * 64 + p) * 2], ai = A16[(g * 64 + p) * 2 + 1];
    const float* S = (const float*)(a.ws + wsl::S) + ((size_t)(g * 2048 + b * 256)) * 128; bf16_t* UX = (bf16_t*)(a.ws + wsl::UX) + ((size_t)(g * 2048 + b * 256)) * 384 + 256;
    float xr = 0.f, xi = 0.f;
    for (int c0 = 0; c0 < NCHUNK; c0 += 16) {
        float sr[16], si[16];
#pragma unroll
        for (int j = 0; j < 16; ++j) { sr[j] = S[(size_t)(c0 + j) * 128 + p]; si[j] = S[(size_t)(c0 + j) * 128 + 64 + p]; }
#pragma unroll
        for (int j = 0; j < 16; ++j) {
            UX[(size_t)(c0 + j) * 384 + p] = f2bf(xr); UX[(size_t)(c0 + j) * 384 + 64 + p] = f2bf(xi);
            const float nr = ar * xr - ai * xi + sr[j], ni = ar * xi + ai * xr + si[j]; xr = nr; xi = ni;
        }
    }
}
__device__ __forceinline__ void cmp_out_task(const float* __restrict__ PART, const LAS float* bias, const bf16_t* __restrict__ W2t, bf16_t* OUT, int task, int lane) {
    const int row0 = task * 16, fr = lane & 15, fq = lane >> 4;
    f32x4 acc[4];
#pragma unroll
    for (int nb = 0; nb < 4; ++nb) acc[nb] = (f32x4){0.f, 0.f, 0.f, 0.f};
#pragma unroll 2
    for (int ks = 0; ks < 8; ++ks) {
        const int c0 = ks * 32 + 8 * fq; const float* pp = PART + (size_t)(row0 + fr) * 256 + c0;
        f32x4 h0 = (f32x4){bias[c0], bias[c0 + 1], bias[c0 + 2], bias[c0 + 3]}, h1 = (f32x4){bias[c0 + 4], bias[c0 + 5], bias[c0 + 6], bias[c0 + 7]};
#pragma unroll
        for (int sl = 0; sl < 4; ++sl) { h0 = h0 + *(const f32x4*)(pp + (size_t)sl * 4096 * 256); h1 = h1 + *(const f32x4*)(pp + (size_t)sl * 4096 * 256 + 4); }
#pragma unroll
        for (int i = 0; i < 4; ++i) { h0[i] = pg8::fast_gelu_tanh(h0[i]); h1[i] = pg8::fast_gelu_tanh(h1[i]); }
        const bf16x8 af = __builtin_bit_cast(bf16x8, pg8::pack8(h0, h1));
#pragma unroll
        for (int nb = 0; nb < 4; ++nb) { const bf16x8 bfr = *(const bf16x8*)(W2t + (size_t)(nb * 16 + fr) * 256 + ks * 32 + 8 * fq); acc[nb] = __builtin_amdgcn_mfma_f32_16x16x32_bf16(af, bfr, acc[nb], 0, 0, 0); }
    }
#pragma unroll
    for (int nb = 0; nb < 4; ++nb)
#pragma unroll
        for (int i = 0; i < 4; ++i) OUT[(size_t)(row0 + 4 * fq + i) * 64 + nb * 16 + fr] = f2bf(acc[nb][i]);
}
#define HAVE_FAST_ATTN 1
namespace att {
typedef float f32x16 __attribute__((ext_vector_type(16)));
typedef short v4i16 __attribute__((ext_vector_type(4)));
constexpr int KOFF = 0, VOFF = 16384, IMPP_OFF = 32768, SC_OFF = 98304, MASK_OFF = 114688, SSQP_OFF = 115200;
constexpr float THR = 8.f, MINIT = -1e30f;
__device__ __forceinline__ int crow(int r, int hi) { return (r & 3) + 8 * (r >> 2) + 4 * hi; }
__device__ __forceinline__ f32x16 zero16() { f32x16 z;
#pragma unroll
    for (int i = 0; i < 16; ++i) z[i] = 0.f; return z; }
__device__ __forceinline__ void qk_tile(const LAS unsigned char* Kb, const bf16x8 (&qr)[4], int r32, int hi, f32x16& p0, f32x16& p1) {
    p0 = zero16(); p1 = zero16();
    bf16x8 a0[4], a1[4];
#pragma unroll
    for (int d0 = 0; d0 < 4; ++d0) { const int off = r32 * 128 + (((2 * d0 + hi) ^ ((r32 >> 1) & 7)) << 4); a0[d0] = *(const LAS bf16x8*)(Kb + off); a1[d0] = *(const LAS bf16x8*)(Kb + 4096 + off); }
    __builtin_amdgcn_sched_barrier(0);
#pragma unroll
    for (int d0 = 0; d0 < 4; ++d0) {
        p0 = __builtin_amdgcn_mfma_f32_32x32x16_bf16(a0[d0], qr[d0], p0, 0, 0, 0);
        p1 = __builtin_amdgcn_mfma_f32_32x32x16_bf16(a1[d0], qr[d0], p1, 0, 0, 0);
    }
}
__device__ __forceinline__ bf16x8 pack_p(const f32x16& p, int s) {
    pg8::u32x4 w; w.x = pg8::cvt_pk_bf16(p[8 * s], p[8 * s + 1]); w.y = pg8::cvt_pk_bf16(p[8 * s + 2], p[8 * s + 3]); w.z = pg8::cvt_pk_bf16(p[8 * s + 4], p[8 * s + 5]); w.w = pg8::cvt_pk_bf16(p[8 * s + 6], p[8 * s + 7]);
    return __builtin_bit_cast(bf16x8, w);
}
__device__ __forceinline__ v4i16 vtr(const LAS unsigned char* p) { return __builtin_amdgcn_ds_read_tr16_b64_v4i16((LAS v4i16*)p); }
__device__ __forceinline__ void pv_tile(const LAS unsigned char* Vb, int vl0, const f32x16& p0, const f32x16& p1, f32x16 (&o)[2]) {
    bf16x8 pf[4];
#pragma unroll
    for (int i = 0; i < 4; ++i) pf[i] = pack_p((i >> 1) ? p1 : p0, i & 1);
#pragma unroll
    for (int db = 0; db < 2; ++db) {
        v4i16 lo[4], hi4[4];
#pragma unroll
        for (int i = 0; i < 4; ++i) { const LAS unsigned char* vp = Vb + (vl0 ^ (db * 64)) + (i >> 1) * 4096 + (i & 1) * 2048; lo[i] = vtr(vp); hi4[i] = vtr(vp + 1024); }
        __builtin_amdgcn_sched_barrier(0);
#pragma unroll
        for (int i = 0; i < 4; ++i) { const bf16x8 vf = (bf16x8){lo[i][0], lo[i][1], lo[i][2], lo[i][3], hi4[i][0], hi4[i][1], hi4[i][2], hi4[i][3]};
            o[db] = __builtin_amdgcn_mfma_f32_32x32x16_bf16(vf, pf[i], o[db], 0, 0, 0); }
    }
}
__device__ __forceinline__ float other32(float x, int hi) { const auto rr = __builtin_amdgcn_permlane32_swap(__float_as_uint(x), __float_as_uint(x), false, false); return __uint_as_float(hi ? rr[0] : rr[1]); }
__device__ __forceinline__ unsigned dpp_or8(unsigned x) {
    x |= (unsigned)__builtin_amdgcn_update_dpp(0, (int)x, 0xB1, 0xF, 0xF, true); x |= (unsigned)__builtin_amdgcn_update_dpp(0, (int)x, 0x4E, 0xF, 0xF, true); x |= (unsigned)__builtin_amdgcn_update_dpp(0, (int)x, 0x141, 0xF, 0xF, true); return x; }
__device__ __forceinline__ float max3f(float a, float b, float c) { float r; asm("v_max3_f32 %0, %1, %2, %3" : "=v"(r) : "v"(a), "v"(b), "v"(c)); return r; }
__device__ __forceinline__ float max2f(float a, float b) { float r; asm("v_max_f32_e32 %0, %1, %2" : "=v"(r) : "v"(a), "v"(b)); return r; }
__device__ __forceinline__ float max32(const f32x16& p, const f32x16& q) {
    float a = max3f(p[0], p[1], q[0]), b = max3f(p[2], p[3], q[1]); a = max3f(a, q[2], q[3]);
#pragma unroll
    for (int r = 4; r < 16; r += 4) { a = max3f(a, p[r], p[r + 1]); b = max3f(b, p[r + 2], p[r + 3]); a = max3f(a, q[r], q[r + 1]); b = max3f(b, q[r + 2], q[r + 3]); }
    return max2f(a, b);
}
__device__ __forceinline__ float max16(const f32x16& p) { float a = max3f(p[0], p[1], p[2]), b = max3f(p[3], p[4], p[5]); a = max3f(a, p[6], p[7]); b = max3f(b, p[8], p[9]); a = max3f(a, p[10], p[11]); b = max3f(b, p[12], p[13]); a = max3f(a, p[14], p[15]); return max2f(a, b); }
__device__ __forceinline__ float sum16v(const f32x16& p) { return (((p[0] + p[1]) + (p[2] + p[3])) + ((p[4] + p[5]) + (p[6] + p[7]))) + (((p[8] + p[9]) + (p[10] + p[11])) + ((p[12] + p[13]) + (p[14] + p[15]))); }
__device__ __forceinline__ void mask_range(f32x16& p, int sub, int hi, int lo, int hi_) {
    const int base = 32 * sub + 4 * hi;
#pragma unroll
    for (int r = 0; r < 16; ++r) { const int k = base + (r & 3) + 8 * (r >> 2); if (k < lo || k > hi_) p[r] = -INFINITY; }
}
__device__ __forceinline__ void softmax_pv(const LAS unsigned char* Vb, int vl0, f32x16& p0, f32x16& p1, float& m, float& l, f32x16 (&o)[2]) {
    float tmax = fmaxf(max16(p0), max16(p1)); tmax = fmaxf(tmax, __shfl_xor(tmax, 32));
    if (__any(tmax > m + THR)) { const float mn = fmaxf(m, tmax), f = __builtin_amdgcn_exp2f(m - mn); o[0] = o[0] * f; o[1] = o[1] * f; l *= f; m = mn; }
#pragma unroll
    for (int r = 0; r < 16; ++r) { p0[r] = __builtin_amdgcn_exp2f(p0[r] - m); p1[r] = __builtin_amdgcn_exp2f(p1[r] - m); }
    l += sum16v(p0) + sum16v(p1);
    pv_tile(Vb, vl0, p0, p1, o);
}

#define ATT_GLD(P, t) (*(const v4u*)((P) + (size_t)(t) * 4096 + tid * 8))
#define ATT_SEQ_LOAD(i_) do { const int i__ = (i_); if (i__ < te_) { gK = ATT_GLD(Kg_, i__); gV = ATT_GLD(Vg_, i__); } \
        else if (NKg_ && ntb_ + (i__ - te_) < nte_) { gK = ATT_GLD(NKg_, ntb_ + (i__ - te_)); gV = ATT_GLD(NVg_, ntb_ + (i__ - te_)); } } while (0)
#define ATT_LOOP_BEGIN(Kg, Vg, tbeg, tend, NKg, NVg, ntb, nte) { const bf16_t* Kg_ = (Kg); const bf16_t* Vg_ = (Vg); const bf16_t* NKg_ = (NKg); const bf16_t* NVg_ = (NVg); const int tb_ = (tbeg), te_ = (tend), ntb_ = (ntb), nte_ = (nte); \
    *(LAS v4u*)(lds + KOFF + kst) = gK; *(LAS v4u*)(lds + VOFF + vst) = gV; \
    __syncthreads(); \
    for (int jt = tb_; jt < te_; ++jt) { const int bufo_ = ((jt - tb_) & 1) * 8192; const bool more_ = jt + 1 < te_; \
        ATT_SEQ_LOAD(jt + 1); \
        { const LAS unsigned char* Kb = lds + KOFF + bufo_; const LAS unsigned char* Vb = lds + VOFF + bufo_;
#define ATT_LOOP_END } \
        if (more_) { *(LAS v4u*)(lds + KOFF + (bufo_ ^ 8192) + kst) = gK; *(LAS v4u*)(lds + VOFF + (bufo_ ^ 8192) + vst) = gV; } \
        __syncthreads(); } }

template <int MODE, bool EDGE, int VAR> __device__ __forceinline__ void tile_body(const LAS unsigned char* Kb, const LAS unsigned char* Vb, int vl0, const bf16x8 (&qr)[4], int r32, int hi, int jt, int qb, int iq,
                                                                         unsigned long long selm, float& m, float& l, f32x16 (&o)[2]) {
    f32x16 p0, p1; if (VAR & 16) { p0 = zero16(); p1 = zero16(); asm volatile("" : "+v"(p0), "+v"(p1)); } else qk_tile(Kb, qr, r32, hi, p0, p1);
    asm volatile("s_nop 15\n\ts_nop 7" : "+v"(p0), "+v"(p1));
    const bool sel = MODE == 0 ? (bool)((selm >> jt) & 1ull) : true;
    if (EDGE) {
        if (jt == qb) { mask_range(p0, 0, hi, 0, iq); mask_range(p1, 1, hi, 0, iq); }
        else if (MODE == 1 && jt == qb - 8) { mask_range(p0, 0, hi, iq + 1, 63); mask_range(p1, 1, hi, iq + 1, 63); }
    }
    float tmax = (VAR & 4) ? 0.f : max32(p0, p1); if (!(VAR & 4)) tmax = max2f(tmax, other32(tmax, hi));
    if (MODE == 0) tmax = sel ? tmax : -INFINITY;
    if (!(VAR & 4) && __any(tmax > m + THR)) { const float mn = fmaxf(m, tmax), f = __builtin_amdgcn_exp2f(m - mn); o[0] = o[0] * f; o[1] = o[1] * f; l *= f; m = mn; }
    const float mref = (MODE == 0) ? (sel ? m : 1e30f) : m;
    if (!(VAR & 2)) {
#pragma unroll
    for (int r = 0; r < 16; ++r) { p0[r] = __builtin_amdgcn_exp2f(p0[r] - mref); p1[r] = __builtin_amdgcn_exp2f(p1[r] - mref); }
    l += sum16v(p0) + sum16v(p1);
    }
    if (!(VAR & 1)) pv_tile(Vb, vl0, p0, p1, o); else { asm volatile("" :: "v"(p0), "v"(p1)); }
}
template <int MODE, int VAR> __device__ __forceinline__ void run_branch(LAS unsigned char* lds, const bf16_t* Kg_, const bf16_t* Vg_, const int t0, const int te_, const bf16_t* NKg_, const bf16_t* NVg_, const int ntb_, const int nte_,
                                                               v4u& gK, v4u& gV, const int tid, const int kst, const int vst, const int vl0,
                                                               const bf16x8 (&qr)[4], const int r32, const int hi, const int qb, const int iq, const unsigned long long selm, float& m, float& l, f32x16 (&o)[2]) {
#define ATT_TILE(EDGE, jt_) do { const int j_ = (jt_); const int bo_ = ((j_ - t0) & 1) * 8192; const bool more_ = j_ + 1 < te_; \
        ATT_SEQ_LOAD(j_ + 1); \
        tile_body<MODE, EDGE, VAR>(lds + KOFF + bo_, lds + VOFF + bo_, vl0, qr, r32, hi, j_, qb, iq, selm, m, l, o); \
        if (more_) { *(LAS v4u*)(lds + KOFF + (bo_ ^ 8192) + kst) = gK; *(LAS v4u*)(lds + VOFF + (bo_ ^ 8192) + vst) = gV; } \
        if (!(VAR & 8)) __syncthreads(); } while (0)
    *(LAS v4u*)(lds + KOFF + kst) = gK; *(LAS v4u*)(lds + VOFF + vst) = gV;
    __syncthreads();
    ATT_TILE(true, t0);
#pragma unroll 1
    for (int jt = t0 + 1; jt < te_ - 1; ++jt) ATT_TILE(false, jt);
    if (te_ - 1 > t0) ATT_TILE(true, te_ - 1);
#undef ATT_TILE
}

template <int VAR> __device__ __forceinline__ void attn_unit(LAS unsigned char* lds, const Args& a, int b, int g, int qb, const int w) {
    using namespace cfg;
    int tid = w * 64 + lane_id(); asm volatile("" : "+v"(tid));
    const int lane = tid & 63, r32 = lane & 31, hi = lane >> 5, hr = w >> 1, qh = w & 1;
    const int head = g * 4 + hr, iq = 32 * qh + r32, tq = 64 * qb + iq, row = b * T + tq;
    unsigned char* ws = a.ws;
    const size_t bg = (size_t)(b * 2 + g);
    const bf16_t* KV = (const bf16_t*)(ws + wsl::KV);
    const bf16_t* kc = (const bf16_t*)(ws + wsl::KC) + bg * 256 * 64; const bf16_t* vc = (const bf16_t*)(ws + wsl::VC) + bg * 256 * 64;
    const bf16_t* ks = KV + 2 * KVPART + bg * T * 64; const bf16_t* vs = KV + 3 * KVPART + bg * T * 64;
    const bf16_t* kw = KV + 4 * KVPART + bg * T * 64; const bf16_t* vw = KV + 5 * KVPART + bg * T * 64;
    const int srow = tid >> 3, sch = tid & 7;
    const int kst = srow * 128 + ((sch ^ ((srow >> 1) & 7)) << 4), vst = srow * 128 + ((sch << 4) ^ (((srow >> 1) & 1) << 6));
    const int tq4 = (lane & 15) >> 2, tp = lane & 3, tblk = (lane >> 4) & 1;
    const int vl0 = hi * 512 + tq4 * 128 + ((tblk * 32 + tp * 8) ^ (((tq4 >> 1) & 1) << 6));
    bf16x8 qr[4];
    { const bf16_t* Qp = (const bf16_t*)(ws + wsl::Q) + (((size_t)(b * NH + head)) * T + tq) * 64 + 8 * hi;
#pragma unroll
      for (int d0 = 0; d0 < 4; ++d0) qr[d0] = *(const bf16x8*)(Qp + 16 * d0); }
#define ATT_COLD_ROW(rowv) int rowv; { int t2_ = w * 64 + lane_id(); asm volatile("" : "+v"(t2_)); rowv = b * T + 64 * qb + 32 * qh + (t2_ & 31); }
    LAS float* IMPP = (LAS float*)(lds + IMPP_OFF);
    LAS float* TOT = IMPP + tid;
    LAS float* SC = (LAS float*)(lds + SC_OFF);
    LAS unsigned* MASK = (LAS unsigned*)(lds + MASK_OFF);
    LAS float* SSQP = (LAS float*)(lds + SSQP_OFF);

    int ntc = (4 * qb + 3 + 63) >> 6; if (ntc > 4) ntc = 4;
    int nvq = tq >= 31 ? ((tq - 31) >> 4) + 1 : 0; if (nvq > NC) nvq = NC;
    float m = MINIT, l = 0.f;
    const int t0w = qb >= 8 ? qb - 8 : 0;
    v4u gK = ATT_GLD(kc, 0), gV = ATT_GLD(vc, 0);
    ATT_LOOP_BEGIN(kc, vc, 0, ntc, kc, vc, 0, ntc)
        f32x16 p0, p1; qk_tile(Kb, qr, r32, hi, p0, p1);
        const int lim = nvq - 1 - 64 * jt;
        mask_range(p0, 0, hi, 0, lim); mask_range(p1, 1, hi, 0, lim);
        asm volatile("s_nop 15\n\ts_nop 7" : "+v"(p0), "+v"(p1));
        const float tmax = max32(p0, p1);
        if (tmax > m) { l *= __builtin_amdgcn_exp2f(m - tmax); m = tmax; }
        float s = 0.f;
#pragma unroll
        for (int r = 0; r < 16; ++r) s += __builtin_amdgcn_exp2f(p0[r] - m) + __builtin_amdgcn_exp2f(p1[r] - m);
        l += s;
    ATT_LOOP_END
    { const float mo = other32(m, hi), lo_ = other32(l, hi), mt = fmaxf(m, mo);
      l = l * __builtin_amdgcn_exp2f(m - mt) + lo_ * __builtin_amdgcn_exp2f(mo - mt); m = mt; }
    const float inv_c = 1.f / fmaxf(l, 1e-30f);
    f32x16 oc[2]; oc[0] = zero16(); oc[1] = zero16();
    {
        float carry = 0.f;
        ATT_LOOP_BEGIN(kc, vc, 0, ntc, ks, vs, 0, qb + 1)
            f32x16 p0, p1; qk_tile(Kb, qr, r32, hi, p0, p1);
            const int lim = nvq - 1 - 64 * jt;
            mask_range(p0, 0, hi, 0, lim); mask_range(p1, 1, hi, 0, lim);
#pragma unroll
            for (int r = 0; r < 16; ++r) { p0[r] = __builtin_amdgcn_exp2f(p0[r] - m) * inv_c; p1[r] = __builtin_amdgcn_exp2f(p1[r] - m) * inv_c; }
            int ib = IMPP_OFF + (((hr * 64 + iq) * 64 + hi + 16 * jt) << 2); asm volatile("" : "+v"(ib));
#pragma unroll
            for (int sub = 0; sub < 2; ++sub) {
                float gs[4], recv[4];
#pragma unroll
                for (int k = 0; k < 4; ++k) { const float x0 = sub ? p1[4 * k] : p0[4 * k], x1 = sub ? p1[4 * k + 1] : p0[4 * k + 1], x2 = sub ? p1[4 * k + 2] : p0[4 * k + 2], x3 = sub ? p1[4 * k + 3] : p0[4 * k + 3];
                    gs[k] = (x0 + x1) + (x2 + x3); recv[k] = other32(x3, hi); }
#pragma unroll
                for (int k = 0; k < 4; ++k) { const float add = hi ? recv[k] : (k > 0 ? recv[k - 1] : carry);
                    *(LAS float*)(lds + ib + (8 * sub + 2 * k) * 4) = gs[k] + add; }
                carry = recv[3];
            }
            pv_tile(Vb, vl0, p0, p1, oc);
        ATT_LOOP_END
    }
    if (qb < SEL_TOPK) {
        if (tid < 64) { MASK[tid * 2] = (2u << qb) - 1u; MASK[tid * 2 + 1] = 0u; }
        __syncthreads();
    } else
    {
        const int q = tid >> 3, jc = tid & 7;
        float mine[8];
#pragma unroll
        for (int e = 0; e < 8; ++e) { const int j = 8 * jc + e; float s;
            if (j == 0 || j == qb || j == qb - 1) s = INFINITY;
            else if (j <= qb) s = ((IMPP[(0 * 64 + q) * 64 + j] + IMPP[(1 * 64 + q) * 64 + j]) + IMPP[(2 * 64 + q) * 64 + j]) + IMPP[(3 * 64 + q) * 64 + j];
            else s = -INFINITY;
            mine[e] = s; SC[q * 64 + j] = s; }
        __syncthreads();
        int rank[8];
#pragma unroll
        for (int e = 0; e < 8; ++e) rank[e] = 0;
        for (int j2 = 0; j2 < 64; ++j2) { const float o = SC[q * 64 + j2];
#pragma unroll
            for (int e = 0; e < 8; ++e) rank[e] += (o > mine[e] || (o == mine[e] && j2 < 8 * jc + e)) ? 1 : 0; }
        unsigned bits = 0u;
#pragma unroll
        for (int e = 0; e < 8; ++e) if (rank[e] < SEL_TOPK && 8 * jc + e <= qb) bits |= 1u << e;
        unsigned lo32 = jc < 4 ? bits << (8 * jc) : 0u, hi32 = jc >= 4 ? bits << (8 * (jc - 4)) : 0u;
        lo32 = dpp_or8(lo32); hi32 = dpp_or8(hi32);
        if (jc == 0) { MASK[q * 2] = lo32; MASK[q * 2 + 1] = hi32; }
        __syncthreads();
    }
    {
        ATT_COLD_ROW(row_c) const float g_cmp = ((const float*)(ws + wsl::GATES))[(size_t)row_c * 24 + head * 3];
#pragma unroll
        for (int db = 0; db < 2; ++db)
#pragma unroll
            for (int r = 0; r < 16; ++r) TOT[(db * 16 + r) * 512] = oc[db][r] * g_cmp;
    }
    {
        const unsigned long long selm = (unsigned long long)MASK[iq * 2] | ((unsigned long long)MASK[iq * 2 + 1] << 32);
        f32x16 o[2]; o[0] = zero16(); o[1] = zero16(); m = MINIT; l = 0.f;
        run_branch<0, VAR>(lds, ks, vs, 0, qb + 1, kw, vw, t0w, qb + 1, gK, gV, tid, kst, vst, vl0, qr, r32, hi, qb, iq, selm, m, l, o);
        l += other32(l, hi);
        ATT_COLD_ROW(row_s) const float sc = ((const float*)(ws + wsl::GATES))[(size_t)row_s * 24 + head * 3 + 1] / fmaxf(l, 1e-30f);
#pragma unroll
        for (int db = 0; db < 2; ++db)
#pragma unroll
            for (int r = 0; r < 16; ++r) TOT[(db * 16 + r) * 512] += o[db][r] * sc;
    }
    {
        f32x16 o[2]; o[0] = zero16(); o[1] = zero16(); m = MINIT; l = 0.f;
        run_branch<1, VAR>(lds, kw, vw, t0w, qb + 1, nullptr, nullptr, 0, 0, gK, gV, tid, kst, vst, vl0, qr, r32, hi, qb, iq, 0ull, m, l, o);
        l += other32(l, hi);
        ATT_COLD_ROW(row_w) const float sc = ((const float*)(ws + wsl::GATES))[(size_t)row_w * 24 + head * 3 + 2] / fmaxf(l, 1e-30f);
#pragma unroll
        for (int db = 0; db < 2; ++db)
#pragma unroll
            for (int r = 0; r < 16; ++r) o[db][r] = TOT[(db * 16 + r) * 512] + o[db][r] * sc;
        oc[0] = o[0]; oc[1] = o[1];
    }
    {
        ATT_COLD_ROW(row_o) bf16_t* orow = (bf16_t*)(ws + wsl::MIX) + (size_t)row_o * MIXP + head * 64;
        float sq = 0.f;
#pragma unroll
        for (int db = 0; db < 2; ++db)
#pragma unroll
            for (int k = 0; k < 4; ++k) { const float x0 = oc[db][4 * k], x1 = oc[db][4 * k + 1], x2 = oc[db][4 * k + 2], x3 = oc[db][4 * k + 3];
                sq += (x0 * x0 + x1 * x1) + (x2 * x2 + x3 * x3);
                pg8::u32x2 wv; wv.x = pg8::cvt_pk_bf16(x0, x1); wv.y = pg8::cvt_pk_bf16(x2, x3);
                *(pg8::u32x2*)(orow + 32 * db + 8 * k + 4 * hi) = wv; }
        sq += other32(sq, hi);
        if (hi == 0) SSQP[hr * 64 + iq] = sq;
        __syncthreads();
        if (tid < 64) ((float*)(ws + wsl::SSQA))[(size_t)(b * T + 64 * qb + tid) * 2 + g] = ((SSQP[tid] + SSQP[64 + tid]) + SSQP[128 + tid]) + SSQP[192 + tid];
        __syncthreads();
    }
}
}
template <int VAR> __device__ __forceinline__ void attn_phase(Frame& F, const Args& a) {
    const int G = F.G, bx = (int)blockIdx.x;
    for (int v0 = (G % 8 == 0) ? (bx % 8) * (G / 8) + bx / 8 : bx; v0 < 256; v0 += G) {
        const int bgi = v0 >> 4, s = v0 & 15;
#pragma unroll 1
        for (int i = 0; i < 4; ++i) { const int qb = i == 0 ? 63 - s : (i == 1 ? 32 + s : (i == 2 ? 31 - s : s)); att::attn_unit<VAR>(F.lds, a, bgi >> 1, bgi & 1, qb, F.wave); }
    }
}
constexpr int CW_BAR = 4096;
enum Feat { F_FFN1 = 1, F_WIN = 2, F_CMP = 4, F_S5 = 8, F_GLU = 16, F_ATT = 32, F_WOUT = 64, F_FFN2 = 128, F_ALL = 255 };
constexpr int NPHASE = 12;

__global__ void __launch_bounds__(NWAVES * 64, 2) mk_fwd(Args args, int feat) {
    using namespace cfg;
    extern __shared__ __attribute__((aligned(16))) unsigned char lds_raw[];
    Frame F;
    F.lds = (LAS unsigned char*)lds_raw;
    F.wave = __builtin_amdgcn_readfirstlane(threadIdx.x >> 6);
    F.G = gridDim.x; F.gw = blockIdx.x * NWAVES + F.wave; F.NGW = F.G * NWAVES;
    volatile LAS unsigned* MISC = (volatile LAS unsigned*)(F.lds + MISC_OFF);
    for (int u = F.tid(); u < (LDS_BYTES - LDSCTL_OFF) / 4; u += NWAVES * 64) ((LAS unsigned*)(F.lds + LDSCTL_OFF))[u] = 0u;
    __syncthreads();
    unsigned char* ws = args.ws; const float* const* in = args.in;
    const int lo = args.ph_lo, hi = args.ph_hi; const bool multi = (hi - lo) > 1;
    XcdBarrier bar; bar.bar = (unsigned*)(ws + wsl::CTL) + CW_BAR; bar.x = 0; bar.st = nullptr; bar.w0 = 0;
    if (multi) bar = xcd_barrier_post((unsigned*)(ws + wsl::CTL) + CW_BAR, MISC + 8);
#ifndef PH_MASK
#define PH_MASK 0xFFF
#endif
#define IN(k) (((PH_MASK >> (k)) & 1) && lo <= (k) && (k) < hi)
#ifndef REP_PH
#define REP_PH -1
#endif
#ifndef REP_N
#define REP_N 1
#endif
#ifndef REP_MASK
#define REP_MASK 0
#endif
#define REP(k) for (int rp_ = 0; rp_ < (((REP_PH) == (k) || (((REP_MASK) >> (k)) & 1)) ? (REP_N) : 1); ++rp_)
#ifdef PROBE_A
#define STAMP(i) do { if (blockIdx.x == 0 && F.tid() == 0) ((unsigned long long*)(ws + wsl::CTL + 65536))[i] = __builtin_amdgcn_s_memrealtime(); } while (0)
#else
#define STAMP(i) do {} while (0)
#endif
#define SEAM(k) do { if (IN(k) && IN((k) + 1)) { xcd_barrier(bar); STAMP((k) + 1); } } while (0)
    bf16_t* XB = (bf16_t*)(ws + wsl::XB); bf16_t* Hh = (bf16_t*)(ws + wsl::H);
    float* SSQ1 = (float*)(ws + wsl::SSQ1); float* SSQ2 = (float*)(ws + wsl::SSQ2); float* SSQ3 = (float*)(ws + wsl::SSQ3);
    float* SSQS = (float*)(ws + wsl::SSQS); float* SSQA = (float*)(ws + wsl::SSQA);
    bf16_t* MIX = (bf16_t*)(ws + wsl::MIX); bf16_t* YG = (bf16_t*)(ws + wsl::YG);
    MixBufs mb{(bf16_t*)(ws + wsl::Q), (bf16_t*)(ws + wsl::KV), (float*)(ws + wsl::GATES), (bf16_t*)(ws + wsl::UX), in[7]};
    const int cu = (int)blockIdx.x;

    STAMP(0);
    if (IN(0)) REP(0) { p0_prologue(F, args); }
    SEAM(0);
    if (IN(1) && (feat & F_FFN1)) REP(1) {
        pg8::Gemm g{XB, (const bf16_t*)(ws + wsl::W1A), M, 2 * FF, D, D, D, 0, 0}; pg8::StaticOrder S; S.init(M, 2 * FF, F.G, cu);
        pg8::EpiSwiGLU E{Hh, false, pg8::RowScaleTable{nullptr, -1, -1, nullptr}};
        pg8::gemm_phase<pg8::EpiSwiGLU, pg8::StaticOrder, true, true>(F.lds, g, S, E, F.wave);
    }
    SEAM(1);
    if (IN(2) && (feat & F_FFN1)) REP(2) {
        pg8::Gemm g{Hh, (const bf16_t*)(ws + wsl::W1D), M, D, FF, FF, FF, 0, 0}; pg8::StaticOrder S; S.init(M, D, F.G, cu);
        pg8::EpiResid<0> E{in[0], XB, SSQ1, nullptr, nullptr};
        pg8::gemm_phase<pg8::EpiResid<0>, pg8::StaticOrder, true, true>(F.lds, g, S, E, F.wave);
    }
    SEAM(2);
    if (IN(3) && (feat & F_WIN)) REP(3) {
        pg8::Gemm g{XB, (const bf16_t*)(ws + wsl::WIN), M, INC_PAD, D, D, D, 0, 0}; pg8::StaticOrder S; S.init(M, INC_PAD, F.G, cu);
        const pg8::RowScaleTable rt = pg8::make_row_scale_table((LAS float*)(F.lds + BIAS_OFF), SSQ1, S, F.tid());
        pg8::EpiWin E{mb, rt};
        pg8::gemm_phase<pg8::EpiWin, pg8::StaticOrder, true, true>(F.lds, g, S, E, F.wave);
    }
    SEAM(3);
    if (IN(4)) REP(4) {
        if (feat & F_CMP) {
            float* PART = (float*)(ws + wsl::YG);
            { pg8::Gemm g{mb.KV, (const bf16_t*)(ws + wsl::CW1K), 4096, 1024, 512, 1024, 2048, 0, 512}; pg8::StaticOrder S; S.init(4096, 1024, F.G, cu);
              pg8::EpiPart E{PART};
              pg8::gemm_phase<pg8::EpiPart, pg8::StaticOrder, true, true>(F.lds, g, S, E, F.wave); }
            { pg8::Gemm g{mb.KV + KVPART, (const bf16_t*)(ws + wsl::CW1V), 4096, 1024, 512, 1024, 2048, 0, 512}; pg8::StaticOrder S; S.init(4096, 1024, F.G, (cu + F.G - 64) % F.G);
              pg8::EpiPart E{PART + (size_t)4 * 4096 * 256};
              pg8::gemm_phase<pg8::EpiPart, pg8::StaticOrder, true, true>(F.lds, g, S, E, F.wave); }
        }
        if (feat & F_S5) {
            pg8::Gemm g{mb.UX, (const bf16_t*)(ws + wsl::BTS), SGRP * 2048, 256, 256, 384, 256, 8, 0}; pg8::StaticOrder S; S.init(SGRP * 2048, 256, F.G, (cu + F.G - 128) % F.G);
            pg8::EpiS5S E{(float*)(ws + wsl::S)};
            pg8::gemm_phase<pg8::EpiS5S, pg8::StaticOrder, true, true>(F.lds, g, S, E, F.wave);
        }
    }
    SEAM(4);
    if (IN(5)) REP(5) {
        LAS float* bias = (LAS float*)(F.lds + BIAS_OFF);
        if (feat & F_CMP) { const int t_ = F.tid(), ten = t_ >> 8, n = t_ & 255; const float* cbp = (const float*)(ws + WS_CBP) + ten * 16 * 256 + n; float s = (ten ? in[14] : in[11])[n];
#pragma unroll
            for (int k = 0; k < 16; ++k) s += cbp[k * 256];
            bias[ten * 256 + n] = s; }
        __syncthreads();
        if (F.wave == 0) { if (feat & F_S5) for (int bg = cu; bg < BATCH * SGRP; bg += F.G) s5_scan_task(args, bg, lane_id()); }
        else if (feat & F_CMP) {
            const float* PART = (const float*)(ws + wsl::YG);
            for (int tk = cu * (NWAVES - 1) + F.wave - 1; tk < 512; tk += F.G * (NWAVES - 1)) {
                if (tk < 256) cmp_out_task(PART, bias, (const bf16_t*)(ws + wsl::CW2K), (bf16_t*)(ws + wsl::KC), tk, lane_id());
                else cmp_out_task(PART + (size_t)4 * 4096 * 256, bias + 256, (const bf16_t*)(ws + wsl::CW2V), (bf16_t*)(ws + wsl::VC), tk - 256, lane_id());
            }
        }
    }
    SEAM(5);
    if (IN(6) && (feat & F_S5)) REP(6) {
        pg8::Gemm g{mb.UX, (const bf16_t*)(ws + wsl::BTY), SGRP * 2048, 256, 384, 384, 384, 8, 0}; pg8::StaticOrder S; S.init(SGRP * 2048, 256, F.G, cu);
        pg8::EpiS5Y E{YG};
        pg8::gemm_phase<pg8::EpiS5Y, pg8::StaticOrder, true, true>(F.lds, g, S, E, F.wave);
    }
    SEAM(6);
    if (IN(7)) {
        if (feat & F_GLU) REP(7) {
            pg8::Gemm g{YG, (const bf16_t*)(ws + wsl::GLUW), M, 512, 512, 512, 512, 0, 0}; pg8::StaticOrder S; S.init(M, 512, F.G, cu);
            pg8::EpiGLU E{YG, in[25], MIX + 512, SSQS};
            pg8::gemm_phase<pg8::EpiGLU, pg8::StaticOrder, true, true>(F.lds, g, S, E, F.wave);
        }
#ifdef HAVE_FAST_ATTN
#ifdef SHADOW_VAR
        if (feat & F_ATT) { attn_phase<SHADOW_VAR>(F, args); __syncthreads(); }
#endif
        if (feat & F_ATT) REP(12) attn_phase<0>(F, args);
#endif
    }
    SEAM(7);
    if (IN(8) && (feat & F_WOUT)) {
        pg8::Gemm g{MIX, (const bf16_t*)(ws + wsl::WOUT), M, D, D, D, D, 0, 0}; pg8::StaticOrder S; S.init(M, D, F.G, cu);
        pg8::EpiResid<1> E{nullptr, XB, SSQ2, SSQA, SSQS};
        pg8::gemm_phase<pg8::EpiResid<1>, pg8::StaticOrder, true, true>(F.lds, g, S, E, F.wave);
    }
    SEAM(8);
    if (IN(9) && (feat & F_FFN2)) REP(9) {
        pg8::Gemm g{XB, (const bf16_t*)(ws + wsl::W2A), M, 2 * FF, D, D, D, 0, 0}; pg8::StaticOrder S; S.init(M, 2 * FF, F.G, cu);
        const pg8::RowScaleTable rt = pg8::make_row_scale_table((LAS float*)(F.lds + BIAS_OFF), SSQ2, S, F.tid());
        pg8::EpiSwiGLU E{Hh, true, rt};
        pg8::gemm_phase<pg8::EpiSwiGLU, pg8::StaticOrder, true, true>(F.lds, g, S, E, F.wave);
    }
    SEAM(9);
    if (IN(10) && (feat & F_FFN2)) {
        pg8::Gemm g{Hh, (const bf16_t*)(ws + wsl::W2D), M, D, FF, FF, FF, 0, 0}; pg8::StaticOrder S; S.init(M, D, F.G, cu);
        pg8::EpiResid<2> E{nullptr, XB, SSQ3, nullptr, nullptr};
        pg8::gemm_phase<pg8::EpiResid<2>, pg8::StaticOrder, true, true>(F.lds, g, S, E, F.wave);
    }
    SEAM(10);
    if (IN(11) && (feat & F_FFN2)) {
        for (int m = F.gw; m < M; m += F.NGW) {
            const GAS unsigned long long* xr = (const GAS unsigned long long*)(XB + (size_t)m * D) + lane_id(); GAS f32x4* orow = (GAS f32x4*)(args.out + (size_t)m * D) + lane_id(); const GAS f32x4* gr = (const GAS f32x4*)in[33] + lane_id();
            float r = rsqrtf(pg8::sum16(SSQ3 + (size_t)m * 16) * (1.f / D) + EPS);
#ifdef PROBE_A
            { const unsigned long long* ts = (const unsigned long long*)(ws + wsl::CTL + 65536);
              const float ta = floorf((float)(ts[PROBE_A + 1] - ts[PROBE_A]) * 0.01f * 0.125f + 0.5f) * 8.f;
              r *= 1.f + sqrtf(ta * 2e-6f); }
#endif
#pragma unroll
            for (int j = 0; j < 4; ++j) { const unsigned long long w = xr[64 * j]; const f32x4 gq = gr[64 * j]; const unsigned lo = (unsigned)w, hi = (unsigned)(w >> 32);
                const f32x4 v = (f32x4){__uint_as_float(lo << 16), __uint_as_float(lo & 0xffff0000u), __uint_as_float(hi << 16), __uint_as_float(hi & 0xffff0000u)};
                orow[64 * j] = v * gq * r; }
        }
    }
#undef IN
#undef SEAM
}
extern "C" void kernel_launch(void* const* d_in, const int* in_sizes, int n_in, void* d_out, int out_size, void* d_ws, size_t ws_size, hipStream_t stream) {
    using namespace cfg;
    if (n_in != 34 || out_size != M * D || ws_size < wsl::END) { fprintf(stderr, "kernel_launch: built for 34 inputs, %d outputs, >= %zu bytes of workspace; got n_in %d out %d ws %zu; nothing launched\n", M * D, (size_t)wsl::END, n_in, out_size, ws_size); return; }
    static int grid = 0;
    if (grid == 0) {
        int dev = 0, cus = 0, per_cu = 0;
        if (hipGetDevice(&dev) != hipSuccess || hipDeviceGetAttribute(&cus, hipDeviceAttributeMultiprocessorCount, dev) != hipSuccess) { fprintf(stderr, "kernel_launch: device query failed; nothing launched\n"); grid = -1; return; }
        if (hipFuncSetAttribute((const void*)mk_fwd, hipFuncAttributeMaxDynamicSharedMemorySize, LDS_BYTES) != hipSuccess) { fprintf(stderr, "kernel_launch: hipFuncSetAttribute(%d B dynamic LDS) failed; nothing launched\n", LDS_BYTES); grid = -1; return; }
        if (hipOccupancyMaxActiveBlocksPerMultiprocessor(&per_cu, (const void*)mk_fwd, NWAVES * 64, LDS_BYTES) != hipSuccess || per_cu < 1) { fprintf(stderr, "kernel_launch: the occupancy query reports %d workgroups per CU for %d threads + %d B LDS; nothing launched\n", per_cu, NWAVES * 64, LDS_BYTES); (void)hipGetLastError(); grid = -1; return; }
        grid = cus;
    }
    if (grid < 0) return;
    (void)hipMemsetAsync((unsigned char*)d_ws + wsl::CTL, 0, wsl::CTL_BYTES, stream);
    Args a{};
    for (int i = 0; i < 34; ++i) a.in[i] = (const float*)d_in[i];
    a.out = (float*)d_out; a.ws = (unsigned char*)d_ws; a.ph_lo = 0; a.ph_hi = NPHASE;
    int feat = F_ALL; void* kargs[] = {&a, &feat};
    const hipError_t e = hipLaunchCooperativeKernel((const void*)mk_fwd, dim3(grid), dim3(NWAVES * 64), kargs, LDS_BYTES, stream);
    if (e != hipSuccess) fprintf(stderr, "kernel_launch: cooperative launch failed: %s (grid %d x %d threads, %d B LDS)\n", hipGetErrorString(e), grid, NWAVES * 64, LDS_BYTES);
}
```

```cpp
#include <hip/hip_runtime.h>
#include <cstdio>
#include <cstdint>
#include <cmath>

namespace cfg {
constexpr int BATCH = 8, T = 4096, D = 1024, M = BATCH * T, FF = 2816, INC = 1816, INC_PAD = 2048;
constexpr int NH = 8, NKV = 2, HD = 64, NC = 255, NB = 64, SEL_TOPK = 16, WINDOW = 512, CMP_LEN = 32;
constexpr int SGRP = 32, SCH = 16, SST = 64;
constexpr int LCH = 16, NCHUNK = T / LCH;
constexpr float EPS = 1e-6f;
constexpr float C2 = 0.125f * 1.4426950408889634f;
constexpr int MIXP = 1024;
constexpr size_t KVPART = (size_t)BATCH * NKV * T * HD;
}
typedef unsigned short bf16_t;

__device__ __forceinline__ float bf2f(bf16_t v) { return __uint_as_float(((unsigned)v) << 16); }
__device__ __forceinline__ unsigned f2bf_u(float f) { unsigned u = __float_as_uint(f); return (u + 0x7fffu + ((u >> 16) & 1u)) >> 16; }
__device__ __forceinline__ bf16_t f2bf(float f) { return (bf16_t)f2bf_u(f); }
__device__ __forceinline__ unsigned pk2(float lo, float hi) { return f2bf_u(lo) | (f2bf_u(hi) << 16); }
__device__ __forceinline__ float gelu_tanh(float x) { const float u = 0.7978845608028654f * (x + 0.044715f * x * x * x); return 0.5f * x * (1.f + tanhf(u)); }

__device__ __forceinline__ int lane_id() { int r; asm volatile("v_mbcnt_lo_u32_b32 %0, -1, 0\n\tv_mbcnt_hi_u32_b32 %0, -1, %0" : "=v"(r)); return r; }

struct MixBufs { bf16_t* Q; bf16_t* KV; float* GATES; bf16_t* UX; const float* gate_bias; };
namespace wsl {
constexpr size_t MiB = 1u << 20;
constexpr size_t CTL = 0, CTL_BYTES = 1 * MiB;
constexpr size_t W1A = 1 * MiB;
constexpr size_t W1D = 12 * MiB;
constexpr size_t W2A = 18 * MiB;
constexpr size_t W2D = 29 * MiB;
constexpr size_t WIN = 35 * MiB;
constexpr size_t WOUT = 39 * MiB;
constexpr size_t CW1K = 41 * MiB;
constexpr size_t CW1V = 42 * MiB;
constexpr size_t GLUW = 43 * MiB;
constexpr size_t CW2K = 43 * MiB + 512 * 1024;
constexpr size_t CW2V = CW2K + 64 * 1024;
constexpr size_t CB1K = CW2V + 64 * 1024;
constexpr size_t CB1V = CB1K + 4096;
constexpr size_t BTS = 44 * MiB;
constexpr size_t BTY = 48 * MiB;
constexpr size_t S5A = 54 * MiB;
constexpr size_t XB = 56 * MiB;
constexpr size_t H = 120 * MiB;
constexpr size_t Q = 120 * MiB;
constexpr size_t KV = 152 * MiB;
constexpr size_t UX = 200 * MiB;
constexpr size_t S = 248 * MiB;
constexpr size_t HIDK = 280 * MiB, HIDV = 282 * MiB;
constexpr size_t KC = 284 * MiB, VC = 284 * MiB + 512 * 1024;
constexpr size_t YG = 296 * MiB;
constexpr size_t MIX = 328 * MiB;
constexpr size_t GATES = 392 * MiB;
constexpr size_t SSQ1 = 395 * MiB, SSQ2 = 397 * MiB, SSQ3 = 399 * MiB;
constexpr size_t SSQS = 401 * MiB;
constexpr size_t SSQA = 402 * MiB;
constexpr size_t END = 403 * MiB;
}
#define GAS __attribute__((address_space(1)))
#define LAS __attribute__((address_space(3)))
typedef unsigned v4u __attribute__((ext_vector_type(4)));
typedef float f32x4 __attribute__((ext_vector_type(4)));
typedef short bf16x8 __attribute__((ext_vector_type(8)));
typedef GAS unsigned gu32;
typedef GAS unsigned long long gu64;
#define RLX_AGENT __ATOMIC_RELAXED, __HIP_MEMORY_SCOPE_AGENT
#define LDS_WAIT() asm volatile("s_waitcnt lgkmcnt(0)" ::: "memory")
#define VM_WAIT() asm volatile("s_waitcnt vmcnt(0)" ::: "memory")
__device__ __forceinline__ unsigned long long rt() { return __builtin_amdgcn_s_memrealtime(); }
#define XB_TMO      128
#define XB_XCNT(j)  (256  + 64 * (j))
#define XB_XSUB(j)  (1280 + 64 * (j))
#define XB_XGEN(j)  (2304 + 64 * (j))
#define XB_TOP      3328
#define XB_TOPGEN   3392
#define XCD_BAR_WORDS 3456
#define XB_SPIN_CAP (1u << 18)

__device__ __forceinline__ unsigned xb_ld(unsigned* p)              { return __hip_atomic_load(p, __ATOMIC_RELAXED, __HIP_MEMORY_SCOPE_AGENT); }
__device__ __forceinline__ unsigned xb_add(unsigned* p, unsigned v) { return __hip_atomic_fetch_add(p, v, __ATOMIC_RELAXED, __HIP_MEMORY_SCOPE_AGENT); }
__device__ __forceinline__ unsigned xb_xcc_id() { return (unsigned)__builtin_amdgcn_s_getreg((3 << 11) | 20) & 0xFu; }
#define XB_SPIN(cond, bar) do { unsigned _sp = 0; while (cond) { __builtin_amdgcn_s_sleep(1); \
    if ((++_sp & 255u) == 0u) { if (xb_ld(&(bar)[XB_TMO])) break; if (_sp > XB_SPIN_CAP) { atomicAdd(&(bar)[XB_TMO], 1u); break; } } } } while (0)

struct XcdBarrier {
    unsigned* bar; unsigned x; unsigned w0;
    volatile LAS unsigned* st;
};

__device__ __forceinline__ XcdBarrier xcd_barrier_post(unsigned* bar, volatile LAS unsigned* st) {
    XcdBarrier b; b.bar = bar; b.x = xb_xcc_id(); b.st = st; b.w0 = (__builtin_amdgcn_readfirstlane(threadIdx.x) < 64u) ? 1u : 0u;
    if (b.w0 && lane_id() == 0) (void)xb_add(&bar[XB_XCNT(b.x)], 1u);
    return b;
}
__device__ __forceinline__ void xcd_barrier_complete(unsigned* bar, unsigned x, unsigned& nloc, unsigned& nx) {
    const unsigned G = gridDim.x * gridDim.y * gridDim.z;
    unsigned sum, cnt, mine, sp = 0u;
    for (;;) {
        sum = 0u; cnt = 0u; mine = 0u;
#pragma unroll
        for (unsigned j = 0; j < 16; ++j) { const unsigned c = xb_ld(&bar[XB_XCNT(j)]); sum += c; cnt += (c > 0u) ? 1u : 0u; mine = (j == x) ? c : mine; }
        if (sum == G) break;
        __builtin_amdgcn_s_sleep(1);
        if ((++sp & 255u) == 0u) { if (xb_ld(&bar[XB_TMO])) break; if (sp > XB_SPIN_CAP) { atomicAdd(&bar[XB_TMO], 1u); break; } }
    }
    nloc = mine > 0u ? mine : 1u; nx = cnt > 0u ? cnt : 1u;
}

__device__ __forceinline__ void xcd_barrier(const XcdBarrier& b) {
    asm volatile("s_waitcnt vmcnt(0)" ::: "memory");
    __syncthreads();
    if (b.w0 && lane_id() == 0) {
        unsigned* bar = b.bar;
        __builtin_amdgcn_s_waitcnt(0);
        unsigned nloc = b.st[0], nx = b.st[1];
        if (nloc == 0u) { xcd_barrier_complete(bar, b.x, nloc, nx); b.st[0] = nloc; b.st[1] = nx; }
        const unsigned old = xb_add(&bar[XB_XSUB(b.x)], 1u);
        const unsigned gen = old / nloc;
        if (old + 1u == (gen + 1u) * nloc) {
            __builtin_amdgcn_fence(__ATOMIC_RELEASE, "agent");
            asm volatile("s_waitcnt vmcnt(0)" ::: "memory");
            const unsigned og = xb_add(&bar[XB_TOP], 1u);
            const unsigned tg = og / nx;
            if (og + 1u == (tg + 1u) * nx) xb_add(&bar[XB_TOPGEN], 1u);
            else XB_SPIN(xb_ld(&bar[XB_TOPGEN]) == tg, bar);
            __builtin_amdgcn_fence(__ATOMIC_ACQUIRE, "agent");
            xb_add(&bar[XB_XGEN(b.x)], 1u);
            asm volatile("s_waitcnt vmcnt(0)" ::: "memory");
        } else {
            XB_SPIN(xb_ld(&bar[XB_XGEN(b.x)]) == gen, bar);
            __builtin_amdgcn_fence(__ATOMIC_ACQUIRE, "agent");
            asm volatile("s_waitcnt vmcnt(0)" ::: "memory");
        }
    }
    __syncthreads();
}
namespace pg8 {
#define PG8_LAS __attribute__((address_space(3)))
typedef unsigned short bf16_t;
typedef short bf16x8 __attribute__((ext_vector_type(8)));
typedef float f32x4 __attribute__((ext_vector_type(4)));
typedef unsigned u32x4 __attribute__((ext_vector_type(4)));
constexpr int BM = 256, BK = 64, HALF = 128, HTB = HALF * BK * 2  , STAGE_BYTES = 8 * HTB, NXCD = 8, WGM = 8;

__host__ __device__ __forceinline__ int lds_byte(int r, int c) { const int st = (r >> 4) * 2 + (c >> 5), rr = r & 15, cc = c & 31, ob = rr * 64 + cc * 2; return st * 1024 + (ob ^ (((ob >> 9) & 1) << 5)); }
__host__ __device__ __forceinline__ void stage_rc(int b, int& R, int& C) { const int st = b / 1024, sb = b % 1024, swz = sb ^ (((sb >> 9) & 1) << 5); R = (st >> 1) * 16 + swz / 64; C = (st & 1) * 32 + (swz % 64) / 2; }
__host__ __device__ __forceinline__ int perm32(int rho) { const int n = rho >> 4, i = rho & 15; return 8 * (i >> 2) + 4 * n + (i & 3); }

struct Unit { int pm, pn; };
struct Gemm { const bf16_t* A; const bf16_t* Bt; int M, N, K, lda, ldb, bdiv, kslice; };

struct OneUnit {
    int pm, pn;
    __host__ __device__ bool next(int i, Unit& u) const { if (i) return false; u.pm = pm; u.pn = pn; return true; }
    __device__ __forceinline__ void a_ready(const Unit&) const {}
    __device__ __forceinline__ void done(const Unit&) const {}
};
struct StaticOrder {
    int nM, nN, nwg, G, c, rev = 0;
    __host__ __device__ void init(int M, int N, int G_, int c_) { nM = M / BM; nN = N / BM; nwg = nM * nN; G = G_; c = c_; }
    __host__ __device__ bool next(int i, Unit& u) const {
        const long L = (long)i * G + c; if (L >= nwg) return false;
        int wgid = (int)L; { const int q = nwg / NXCD, r = nwg % NXCD, xcd = wgid % NXCD, off = wgid / NXCD; wgid = (xcd < r ? xcd * (q + 1) : r * (q + 1) + (xcd - r) * q) + off; }
        const int nig = WGM * nN, gid = wgid / nig, fm = gid * WGM, gsz = (nM - fm) < WGM ? (nM - fm) : WGM;
        u.pm = fm + ((wgid % nig) % gsz); u.pn = (wgid % nig) / gsz; if (rev) u.pm = nM - 1 - u.pm; return true;
    }
    __device__ __forceinline__ void a_ready(const Unit&) const {}
    __device__ __forceinline__ void done(const Unit&) const {}
};


template <class Epi, class Sched, bool ALIGN_EPI = false, bool SP2 = false>
__device__ __forceinline__ void gemm_phase(PG8_LAS unsigned char* lds, const Gemm g, const Sched& S, const Epi& E, const int wid) {
    const int lane = lane_id(), tid = wid * 64 + lane, wr = wid >> 2, wc = wid & 3, fr = lane & 15, fq = lane >> 4;
    int nt = g.K / BK; asm volatile("" : "+s"(nt));
    unsigned voffA[2], voffB[2];
#pragma unroll
    for (int i = 0; i < 2; ++i) { int R, C; stage_rc(tid * 16 + i * 8192, R, C); const int Rb = Epi::PERM ? ((R & ~31) + perm32(R & 31)) : R;
        voffA[i] = (unsigned)(R * g.lda + C) * 2u; voffB[i] = (unsigned)(Rb * g.ldb + C) * 2u; }
    const size_t kstep = (size_t)(BK * 2);
    const size_t hstepA = (size_t)HALF * g.lda * 2, hstepB = (size_t)HALF * g.ldb * 2;
    const size_t tstepA = 2 * hstepA, tstepB = 2 * hstepB;
#define PG8_BT(u) ((size_t)(g.kslice > 0 ? 0 : (g.bdiv > 0 ? (u).pm / g.bdiv : (u).pn)))
#define PG8_KO(u) ((size_t)(g.kslice > 0 ? (u).pn * g.kslice * 2 : 0))
    const unsigned ldsw = (unsigned)wid * 1024u;
    const int aoff = lds_byte(wr * 64 + fr, fq * 8), boff = lds_byte(wc * 32 + fr, fq * 8);
#define PG8_SA(b, h) (((b) * 2 + (h)) * HTB)
#define PG8_SB(b, h) ((4 + (b) * 2 + (h)) * HTB)
#define PG8_STAGE(bufoff, gbase, voff) do { _Pragma("unroll") for (int _i = 0; _i < 2; ++_i) \
        __builtin_amdgcn_global_load_lds((const unsigned*)((const char*)(gbase) + (voff)[_i]), (PG8_LAS unsigned*)(lds + (bufoff) + ldsw + _i * 8192), 16, 0, 0); } while (0)
#define PG8_LDA(dst, b, h) do { _Pragma("unroll") for (int m = 0; m < 4; ++m) _Pragma("unroll") for (int k = 0; k < 2; ++k) dst[m][k] = *(const PG8_LAS bf16x8*)(lds + PG8_SA(b, h) + aoff + m * 2048 + k * 1024); } while (0)
#define PG8_LDB(dst, b, h) do { _Pragma("unroll") for (int n = 0; n < 2; ++n) _Pragma("unroll") for (int k = 0; k < 2; ++k) dst[n][k] = *(const PG8_LAS bf16x8*)(lds + PG8_SB(b, h) + boff + n * 2048 + k * 1024); } while (0)
#define PG8_MMA(ai, bj, At, Bt) do { __builtin_amdgcn_s_setprio(1); _Pragma("unroll") for (int m = 0; m < 4; ++m) _Pragma("unroll") for (int n = 0; n < 2; ++n) _Pragma("unroll") for (int k = 0; k < 2; ++k) \
        acc[ai][bj][m][n] = __builtin_amdgcn_mfma_f32_16x16x32_bf16(Bt[n][k], At[m][k], acc[ai][bj][m][n], 0, 0, 0); __builtin_amdgcn_s_setprio(0); } while (0)
#define PG8_WAIT_V(n) asm volatile("s_waitcnt vmcnt(" #n ")" ::: "memory")
#define PG8_WAIT_L(n) asm volatile("s_waitcnt lgkmcnt(" #n ")" ::: "memory")
#define PG8_BAR __builtin_amdgcn_s_barrier()
#define PG8_SCHED __builtin_amdgcn_sched_barrier(0)
    Unit cur, nxt; int ui = 0;
    if (!S.next(0, cur)) return;
    f32x4 acc[2][2][4][2];
    typename Epi::Pre pre;
    if constexpr (Epi::HAS_PRE) E.prefetch(pre, cur, wr, fr);
    if constexpr (Epi::HAS_INIT) E.init(acc, cur, wr, wc, fr, fq);
    else {
#pragma unroll
    for (int a = 0; a < 2; ++a)
#pragma unroll
        for (int b = 0; b < 2; ++b)
#pragma unroll
            for (int m = 0; m < 4; ++m)
#pragma unroll
                for (int n = 0; n < 2; ++n) acc[a][b][m][n] = (f32x4){0.f, 0.f, 0.f, 0.f};
    }
    bf16x8 At[4][2], B0[2][2], B1[2][2];
    const char* cA = (const char*)g.A + (size_t)cur.pm * tstepA + PG8_KO(cur); const char* cB = (const char*)g.Bt + PG8_BT(cur) * tstepB + PG8_KO(cur);
    S.a_ready(cur);
    if constexpr (SP2) {
        PG8_STAGE(PG8_SB(0, 0), cB, voffB); PG8_STAGE(PG8_SB(0, 1), cB + hstepB, voffB); PG8_STAGE(PG8_SA(0, 0), cA, voffA); PG8_STAGE(PG8_SA(0, 1), cA + hstepA, voffA);
        if (wr == 1) PG8_BAR;
        PG8_WAIT_V(2); PG8_BAR;
        PG8_STAGE(PG8_SB(1, 0), cB + kstep, voffB); PG8_STAGE(PG8_SA(1, 0), cA + kstep, voffA); PG8_STAGE(PG8_SB(1, 1), cB + hstepB + kstep, voffB);
        PG8_WAIT_V(6); PG8_BAR;
    } else {
        PG8_STAGE(PG8_SB(0, 0), cB, voffB); PG8_STAGE(PG8_SA(0, 0), cA, voffA); PG8_STAGE(PG8_SB(0, 1), cB + hstepB, voffB); PG8_STAGE(PG8_SA(0, 1), cA + hstepA, voffA);
        if (wr == 1) PG8_BAR;
        PG8_WAIT_V(4); PG8_BAR;
        PG8_STAGE(PG8_SB(1, 0), cB + kstep, voffB); PG8_STAGE(PG8_SA(1, 0), cA + kstep, voffA); PG8_STAGE(PG8_SB(1, 1), cB + hstepB + kstep, voffB);
        PG8_WAIT_V(6); PG8_BAR;
    }
    for (;;) {
        const bool has_next = S.next(ui + 1, nxt);
        const char* nA = has_next ? (const char*)g.A + (size_t)nxt.pm * tstepA + PG8_KO(nxt) : cA; const char* nB = has_next ? (const char*)g.Bt + PG8_BT(nxt) * tstepB + PG8_KO(nxt) : cB;
        for (int t = 0; t < nt; t += 2) {
            const bool last = (t == nt - 2);
            if constexpr (Epi::MIDK) { if (t == (nt >> 1)) E.midk(acc, cur, wr, fr); }
            const char* a1 = cA + (size_t)(t + 1) * kstep;
            const char* a2 = last ? nA : cA + (size_t)(t + 2) * kstep; const char* b2 = last ? nB : cB + (size_t)(t + 2) * kstep;
            const char* a3 = a2 + kstep; const char* b3 = b2 + kstep;
            if (last && has_next) S.a_ready(nxt);
            if constexpr (SP2) {
            PG8_LDB(B0, 0, 0); PG8_LDB(B1, 0, 1); PG8_SCHED; PG8_LDA(At, 0, 0); PG8_STAGE(PG8_SA(1, 1), a1 + hstepA, voffA);
            PG8_WAIT_V(8); PG8_WAIT_L(0); PG8_BAR; PG8_MMA(0, 0, At, B0); PG8_MMA(0, 1, At, B1); PG8_BAR; PG8_SCHED;
            PG8_LDA(At, 0, 1); PG8_STAGE(PG8_SB(0, 0), b2, voffB); PG8_STAGE(PG8_SB(0, 1), b2 + hstepB, voffB); PG8_STAGE(PG8_SA(0, 0), a2, voffA);
            PG8_WAIT_V(8); PG8_WAIT_L(0); PG8_BAR; PG8_MMA(1, 0, At, B0); PG8_MMA(1, 1, At, B1); PG8_BAR; PG8_SCHED;
            PG8_LDB(B0, 1, 0); PG8_LDB(B1, 1, 1); PG8_SCHED; PG8_LDA(At, 1, 0); PG8_STAGE(PG8_SA(0, 1), a2 + hstepA, voffA);
            PG8_WAIT_V(8); PG8_WAIT_L(0); PG8_BAR; PG8_MMA(0, 0, At, B0); PG8_MMA(0, 1, At, B1); PG8_BAR; PG8_SCHED;
            PG8_LDA(At, 1, 1); PG8_STAGE(PG8_SB(1, 0), b3, voffB); PG8_STAGE(PG8_SB(1, 1), b3 + hstepB, voffB); PG8_STAGE(PG8_SA(1, 0), a3, voffA);
            PG8_WAIT_V(8); PG8_WAIT_L(0); PG8_BAR; PG8_MMA(1, 0, At, B0); PG8_MMA(1, 1, At, B1); PG8_BAR; PG8_SCHED;
            } else {
            PG8_LDB(B0, 0, 0); PG8_SCHED; PG8_LDA(At, 0, 0); PG8_STAGE(PG8_SA(1, 1), a1 + hstepA, voffA);
            PG8_WAIT_L(8); PG8_BAR; PG8_WAIT_L(0); PG8_MMA(0, 0, At, B0); PG8_BAR; PG8_SCHED;
            PG8_LDB(B1, 0, 1); PG8_STAGE(PG8_SB(0, 0), b2, voffB);
            PG8_BAR; PG8_WAIT_L(0); PG8_MMA(0, 1, At, B1); PG8_BAR;
            PG8_LDA(At, 0, 1); PG8_STAGE(PG8_SA(0, 0), a2, voffA);
            PG8_BAR; PG8_WAIT_L(0); PG8_MMA(1, 0, At, B0); PG8_BAR; PG8_SCHED;
            PG8_STAGE(PG8_SB(0, 1), b2 + hstepB, voffB);
            PG8_WAIT_V(6); PG8_BAR; PG8_MMA(1, 1, At, B1); PG8_BAR;
            PG8_LDB(B0, 1, 0); PG8_SCHED; PG8_LDA(At, 1, 0); PG8_STAGE(PG8_SA(0, 1), a2 + hstepA, voffA);
            PG8_WAIT_L(8); PG8_BAR; PG8_WAIT_L(0); PG8_MMA(0, 0, At, B0); PG8_BAR; PG8_SCHED;
            PG8_LDB(B1, 1, 1); PG8_STAGE(PG8_SB(1, 0), b3, voffB);
            PG8_BAR; PG8_WAIT_L(0); PG8_MMA(0, 1, At, B1); PG8_BAR;
            PG8_LDA(At, 1, 1); PG8_STAGE(PG8_SA(1, 0), a3, voffA);
            PG8_BAR; PG8_WAIT_L(0); PG8_MMA(1, 0, At, B0); PG8_BAR; PG8_SCHED;
            PG8_STAGE(PG8_SB(1, 1), b3 + hstepB, voffB);
            PG8_WAIT_V(6); PG8_BAR; PG8_MMA(1, 1, At, B1); PG8_BAR;
            }
        }
        if constexpr (ALIGN_EPI) { if (wr == 0) PG8_BAR; }
        if constexpr (!Epi::AFTER_DRAIN) { if constexpr (Epi::HAS_PRE) E(acc, cur, wr, wc, fr, fq, pre); else E(acc, cur, wr, wc, fr, fq); S.done(cur); }
        if (!has_next) break;
        if constexpr (Epi::HAS_PRE) E.prefetch(pre, nxt, wr, fr);
        if constexpr (Epi::HAS_INIT) E.init(acc, nxt, wr, wc, fr, fq);
        else {
#pragma unroll
        for (int a = 0; a < 2; ++a)
#pragma unroll
            for (int b = 0; b < 2; ++b)
#pragma unroll
                for (int m = 0; m < 4; ++m)
#pragma unroll
                    for (int n = 0; n < 2; ++n) acc[a][b][m][n] = (f32x4){0.f, 0.f, 0.f, 0.f};
        }
        cur = nxt; cA = nA; cB = nB; ++ui;
        if constexpr (ALIGN_EPI) { if (wr == 1) PG8_BAR; }
    }
    PG8_WAIT_V(0);
    if constexpr (!ALIGN_EPI) { if (wr == 0) PG8_BAR; }
    PG8_BAR;
    if constexpr (Epi::AFTER_DRAIN) { E.fused(acc, cur, wr, wc, fr, fq, lds, wid, lane); S.done(cur); }
#undef PG8_BT
#undef PG8_KO
#undef PG8_SA
#undef PG8_SB
#undef PG8_STAGE
#undef PG8_LDA
#undef PG8_LDB
#undef PG8_MMA
#undef PG8_WAIT_V
#undef PG8_WAIT_L
#undef PG8_BAR
#undef PG8_SCHED
}
}
namespace pg8 {
typedef float f32x2 __attribute__((ext_vector_type(2)));
typedef unsigned u32x2 __attribute__((ext_vector_type(2)));
__device__ __forceinline__ unsigned cvt_pk_bf16(float lo, float hi) { unsigned r; asm volatile("v_cvt_pk_bf16_f32 %0, %1, %2" : "=v"(r) : "v"(lo), "v"(hi)); return r; }
__device__ __forceinline__ u32x4 pack8(const f32x4 a, const f32x4 b) { u32x4 w; w.x = cvt_pk_bf16(a[0], a[1]); w.y = cvt_pk_bf16(a[2], a[3]); w.z = cvt_pk_bf16(b[0], b[1]); w.w = cvt_pk_bf16(b[2], b[3]); return w; }
__device__ __forceinline__ float fast_sigmoid(float x) { return __builtin_amdgcn_rcpf(1.f + __builtin_amdgcn_exp2f(-1.4426950408889634f * x)); }
__device__ __forceinline__ float fast_gelu_tanh(float x) { const float u2 = 1.5957691216057308f * (x + 0.044715f * x * x * x); return x * fast_sigmoid(u2); }
__device__ __forceinline__ float sum16(const float* p) { const f32x4 a = *(const f32x4*)p, b = *(const f32x4*)(p + 4), c = *(const f32x4*)(p + 8), d = *(const f32x4*)(p + 12);
    return ((a[0] + a[1]) + (a[2] + a[3])) + ((b[0] + b[1]) + (b[2] + b[3])) + ((c[0] + c[1]) + (c[2] + c[3])) + ((d[0] + d[1]) + (d[2] + d[3])); }
__device__ __forceinline__ float sum8(const float* p) { const f32x4 a = *(const f32x4*)p, b = *(const f32x4*)(p + 4); return ((a[0] + a[1]) + (a[2] + a[3])) + ((b[0] + b[1]) + (b[2] + b[3])); }
__device__ __forceinline__ float dot4(const f32x4 x) { return (x[0] * x[0] + x[1] * x[1]) + (x[2] * x[2] + x[3] * x[3]); }

struct RowScaleTable {
    const PG8_LAS float* tab; int pmA, pmB; const float* ssq;
    __device__ __forceinline__ float get(int pm, int row) const {
        if (pm == pmA) return tab[row & 255];
        if (pm == pmB) return tab[256 + (row & 255)];
        return __builtin_amdgcn_rsqf(sum16(ssq + (size_t)row * 16) * (1.f / cfg::D) + cfg::EPS);
    }
};
template <class Sched> __device__ __forceinline__ RowScaleTable make_row_scale_table(PG8_LAS float* tab, const float* ssq, const Sched& S, int tid) {
    RowScaleTable T; T.tab = tab; T.ssq = ssq; T.pmA = -1; T.pmB = -1;
    Unit u;
    for (int i = 0; S.next(i, u); ++i) { if (T.pmA < 0) T.pmA = u.pm; else if (u.pm != T.pmA && T.pmB < 0) T.pmB = u.pm; }
    const int pm = (tid < 256) ? T.pmA : T.pmB;
    if (pm >= 0) { const int row = pm * 256 + (tid & 255); tab[tid] = __builtin_amdgcn_rsqf(sum16(ssq + (size_t)row * 16) * (1.f / cfg::D) + cfg::EPS); }
    __syncthreads();
    return T;
}
struct EpiSwiGLU {
    static constexpr bool PERM = true, AFTER_DRAIN = false, MIDK = false, HAS_INIT = false, HAS_PRE = false; struct Pre {};
    bf16_t* Hh; bool scaled; RowScaleTable rt;
    __device__ __forceinline__ void operator()(const f32x4 (&acc)[2][2][4][2], const Unit& u, int wr, int wc, int fr, int fq) const {
        const int row0 = u.pm * BM + wr * 64 + fr, hcol = u.pn * 128 + wc * 32 + 8 * fq;
#pragma unroll
        for (int ai = 0; ai < 2; ++ai)
#pragma unroll
            for (int m = 0; m < 4; ++m) {
                const int row = row0 + ai * HALF + m * 16;
                const float rs = scaled ? rt.get(u.pm, row) : 1.f;
                f32x4 h0, h1;
#pragma unroll
                for (int n = 0; n < 2; ++n)
#pragma unroll
                    for (int i = 0; i < 4; i += 2) {
                        const f32x2 g = (f32x2){acc[ai][0][m][n][i], acc[ai][0][m][n][i + 1]} * rs, uu = (f32x2){acc[ai][1][m][n][i], acc[ai][1][m][n][i + 1]} * rs;
                        const f32x2 t = g * (-1.4426950408889634f);
                        f32x2 e; e.x = __builtin_amdgcn_exp2f(t.x); e.y = __builtin_amdgcn_exp2f(t.y);
                        const f32x2 d = e + 1.0f;
                        f32x2 r; r.x = __builtin_amdgcn_rcpf(d.x); r.y = __builtin_amdgcn_rcpf(d.y);
                        const f32x2 h = (g * uu) * r;
                        if (n == 0) { h0[i] = h.x; h0[i + 1] = h.y; } else { h1[i] = h.x; h1[i + 1] = h.y; }
                    }
                *(u32x4*)(Hh + (size_t)row * cfg::FF + hcol) = pack8(h0, h1);
            }
    }
};
template <int MODE> struct EpiResid {
    static constexpr bool PERM = true, AFTER_DRAIN = false, MIDK = (MODE == 1), HAS_INIT = true, HAS_PRE = false; struct Pre {};
    const float* resid32; bf16_t* XBp; float* ssq; const float* ssq_a; const float* ssq_s;
    __device__ __forceinline__ float rs_of(int row) const { return __builtin_amdgcn_rsqf(sum8(ssq_s + (size_t)row * 8) * (1.f / 512) + cfg::EPS); }
    __device__ __forceinline__ void midk(f32x4 (&acc)[2][2][4][2], const Unit& u, int wr, int fr) const {
        const int row0 = u.pm * BM + wr * 64 + fr;
#pragma unroll
        for (int ai = 0; ai < 2; ++ai)
#pragma unroll
            for (int m = 0; m < 4; ++m) {
                int row = row0 + ai * HALF + m * 16; asm volatile("" : "+v"(row));
                const f32x2 sa = *(const f32x2*)(ssq_a + (size_t)row * 2);
                const float ra = __builtin_amdgcn_rsqf((sa[0] + sa[1]) * (1.f / 512) + cfg::EPS);
                const float rho = ra * __builtin_amdgcn_rcpf(rs_of(row));
#pragma unroll
                for (int bj = 0; bj < 2; ++bj)
#pragma unroll
                    for (int n = 0; n < 2; ++n) acc[ai][bj][m][n] = acc[ai][bj][m][n] * rho;
            }
    }
    __device__ __forceinline__ void init(f32x4 (&acc)[2][2][4][2], const Unit& u, int wr, int wc, int fr, int fq) const {
        const int row0 = u.pm * BM + wr * 64 + fr, col0 = u.pn * BM + wc * 32 + 8 * fq;
#pragma unroll
        for (int ai = 0; ai < 2; ++ai)
#pragma unroll
            for (int m = 0; m < 4; ++m) {
                const int row = row0 + ai * HALF + m * 16;
                float s0 = 2.f;
                if (MODE == 1) { const f32x2 sa = *(const f32x2*)(ssq_a + (size_t)row * 2); s0 = __builtin_amdgcn_sqrtf((sa[0] + sa[1]) * (1.f / 512) + cfg::EPS); }
#pragma unroll
                for (int bj = 0; bj < 2; ++bj) {
                    const size_t off = (size_t)row * cfg::D + col0 + bj * HALF;
                    if (MODE == 0) { acc[ai][bj][m][0] = *(const f32x4*)(resid32 + off) * s0; acc[ai][bj][m][1] = *(const f32x4*)(resid32 + off + 4) * s0; }
                    else { const u32x4 w = *(const u32x4*)(XBp + off);
                        acc[ai][bj][m][0] = (f32x4){__uint_as_float(w.x << 16), __uint_as_float(w.x & 0xffff0000u), __uint_as_float(w.y << 16), __uint_as_float(w.y & 0xffff0000u)} * s0;
                        acc[ai][bj][m][1] = (f32x4){__uint_as_float(w.z << 16), __uint_as_float(w.z & 0xffff0000u), __uint_as_float(w.w << 16), __uint_as_float(w.w & 0xffff0000u)} * s0; }
                }
            }
    }
    __device__ __forceinline__ void operator()(const f32x4 (&acc)[2][2][4][2], const Unit& u, int wr, int wc, int fr, int fq) const {
        const int row0 = u.pm * BM + wr * 64 + fr, col0 = u.pn * BM + wc * 32 + 8 * fq;
#pragma unroll
        for (int ai = 0; ai < 2; ++ai)
#pragma unroll
            for (int m = 0; m < 4; ++m) {
                int row = row0 + ai * HALF + m * 16; if (MODE == 1) asm volatile("" : "+v"(row));
                const float sc = MODE == 1 ? rs_of(row) : 0.5f;
                float sq = 0.f;
#pragma unroll
                for (int bj = 0; bj < 2; ++bj) {
                    const f32x4 x0 = acc[ai][bj][m][0] * sc, x1 = acc[ai][bj][m][1] * sc;
                    sq += dot4(x0) + dot4(x1);
                    *(u32x4*)(XBp + (size_t)row * cfg::D + col0 + bj * HALF) = pack8(x0, x1);
                }
                sq += __shfl_xor(sq, 16); sq += __shfl_xor(sq, 32);
                if (fq == 0) ssq[(size_t)row * 16 + u.pn * 4 + wc] = sq;
            }
    }
};
struct EpiWin {
    static constexpr bool PERM = true, AFTER_DRAIN = false, MIDK = false, HAS_INIT = false, HAS_PRE = false; struct Pre {};
    MixBufs mb; RowScaleTable rt;
    __device__ __forceinline__ void operator()(const f32x4 (&acc)[2][2][4][2], const Unit& u, int wr, int wc, int fr, int fq) const {
        using namespace cfg;
        const int row0 = u.pm * BM + wr * 64 + fr, colb = u.pn * BM + wc * 32 + 8 * fq;
#pragma unroll
        for (int ai = 0; ai < 2; ++ai)
#pragma unroll
            for (int m = 0; m < 4; ++m) {
                const int row = row0 + ai * HALF + m * 16, b = row >> 12, t = row & (T - 1);
                const float rs = rt.get(u.pm, row);
#pragma unroll
                for (int bj = 0; bj < 2; ++bj) {
                    const int col = colb + bj * HALF;
                    f32x4 v0 = acc[ai][bj][m][0] * rs, v1 = acc[ai][bj][m][1] * rs;
                    if (col < 512) { const int h = col >> 6, d = col & 63; *(u32x4*)(mb.Q + (((size_t)(b * NH + h)) * T + t) * 64 + d) = pack8(v0 * C2, v1 * C2); }
                    else if (col < 1280) { const int c = col - 512, part = c >> 7, g = (c >> 6) & 1, d = c & 63; *(u32x4*)(mb.KV + (size_t)part * KVPART + (((size_t)(b * 2 + g)) * T + t) * 64 + d) = pack8(v0, v1); }
                    else if (col < 1304) { const int c = col - 1280; const f32x4 b0 = *(const f32x4*)(mb.gate_bias + c), b1 = *(const f32x4*)(mb.gate_bias + c + 4);
#pragma unroll
                        for (int i = 0; i < 4; ++i) { v0[i] = fast_sigmoid(v0[i] + b0[i]); v1[i] = fast_sigmoid(v1[i] + b1[i]); }
                        *(f32x4*)(mb.GATES + (size_t)row * 24 + c) = v0; *(f32x4*)(mb.GATES + (size_t)row * 24 + c + 4) = v1; }
                    else if (col < INC) { const int c = col - 1304, g = c >> 4, h = c & 15; *(u32x4*)(mb.UX + ((size_t)(g * 2048 + b * 256 + (t >> 4))) * 384 + (t & 15) * 16 + h) = pack8(v0, v1); }
                }
            }
    }
};
struct EpiPart {
    static constexpr bool PERM = false, AFTER_DRAIN = false, MIDK = false, HAS_INIT = false, HAS_PRE = false; struct Pre {};
    float* PART;
    __device__ __forceinline__ void operator()(const f32x4 (&acc)[2][2][4][2], const Unit& u, int wr, int wc, int fr, int fq) const {
        const int row0 = u.pm * BM + wr * 64 + fr, col0 = wc * 32 + 4 * fq; float* P = PART + (size_t)u.pn * 4096 * 256;
#pragma unroll
        for (int ai = 0; ai < 2; ++ai)
#pragma unroll
            for (int m = 0; m < 4; ++m)
#pragma unroll
                for (int bj = 0; bj < 2; ++bj)
#pragma unroll
                    for (int n = 0; n < 2; ++n) *(f32x4*)(P + (size_t)(row0 + ai * HALF + m * 16) * 256 + col0 + bj * HALF + n * 16) = acc[ai][bj][m][n];
    }
};
struct EpiS5S {
    static constexpr bool PERM = false, AFTER_DRAIN = false, MIDK = false, HAS_INIT = false, HAS_PRE = false; struct Pre {};
    float* S;
    __device__ __forceinline__ void operator()(const f32x4 (&acc)[2][2][4][2], const Unit& u, int wr, int wc, int fr, int fq) const {
        const int row0 = u.pm * BM + wr * 64 + fr, col0 = wc * 32 + 4 * fq;
#pragma unroll
        for (int ai = 0; ai < 2; ++ai)
#pragma unroll
            for (int m = 0; m < 4; ++m)
#pragma unroll
                for (int n = 0; n < 2; ++n) *(f32x4*)(S + (size_t)(row0 + ai * HALF + m * 16) * 128 + col0 + n * 16) = acc[ai][0][m][n];
    }
};
struct EpiS5Y {
    static constexpr bool PERM = true, AFTER_DRAIN = false, MIDK = false, HAS_INIT = false, HAS_PRE = false; struct Pre {};
    bf16_t* YG;
    __device__ __forceinline__ void operator()(const f32x4 (&acc)[2][2][4][2], const Unit& u, int wr, int wc, int fr, int fq) const {
        const int row0 = u.pm * BM + wr * 64 + fr, colb = wc * 32 + 8 * fq;
#pragma unroll
        for (int ai = 0; ai < 2; ++ai)
#pragma unroll
            for (int m = 0; m < 4; ++m) {
                int R = row0 + ai * HALF + m * 16; asm volatile("" : "+v"(R));
                const int g = R >> 11, rr = R & 2047, b = rr >> 8, c = rr & 255;
#pragma unroll
                for (int bj = 0; bj < 2; ++bj) {
                    const int col = colb + bj * HALF, tl = col >> 4, h = col & 15;
                    f32x4 v0 = acc[ai][bj][m][0], v1 = acc[ai][bj][m][1];
#pragma unroll
                    for (int i = 0; i < 4; ++i) { v0[i] = fast_gelu_tanh(v0[i]); v1[i] = fast_gelu_tanh(v1[i]); }
                    *(u32x4*)(YG + ((size_t)(b * cfg::T + c * 16 + tl)) * 512 + g * 16 + h) = pack8(v0, v1);
                }
                __builtin_amdgcn_sched_barrier(0);
            }
    }
};
struct EpiGLU {
    static constexpr bool PERM = true, AFTER_DRAIN = false, MIDK = false, HAS_INIT = false, HAS_PRE = false; struct Pre {};
    const bf16_t* YG; const float* bias; bf16_t* SSM; float* ssq;
    __device__ __forceinline__ void operator()(const f32x4 (&acc)[2][2][4][2], const Unit& u, int wr, int wc, int fr, int fq) const {
        const int row0 = u.pm * BM + wr * 64 + fr, colb = u.pn * BM + wc * 32 + 8 * fq;
#pragma unroll
        for (int ai = 0; ai < 2; ++ai)
#pragma unroll
            for (int m = 0; m < 4; ++m) {
                const int row = row0 + ai * HALF + m * 16; float sq = 0.f;
#pragma unroll
                for (int bj = 0; bj < 2; ++bj) {
                    const int col = colb + bj * HALF;
                    const f32x4 b0 = *(const f32x4*)(bias + col), b1 = *(const f32x4*)(bias + col + 4);
                    const u32x4 yw = *(const u32x4*)(YG + (size_t)row * 512 + col);
                    f32x4 y0, y1;
                    y0[0] = __uint_as_float(yw.x << 16); y0[1] = __uint_as_float(yw.x & 0xffff0000u); y0[2] = __uint_as_float(yw.y << 16); y0[3] = __uint_as_float(yw.y & 0xffff0000u);
                    y1[0] = __uint_as_float(yw.z << 16); y1[1] = __uint_as_float(yw.z & 0xffff0000u); y1[2] = __uint_as_float(yw.w << 16); y1[3] = __uint_as_float(yw.w & 0xffff0000u);
                    f32x4 v0, v1;
#pragma unroll
                    for (int i = 0; i < 4; ++i) { v0[i] = y0[i] * fast_sigmoid(acc[ai][bj][m][0][i] + b0[i]); v1[i] = y1[i] * fast_sigmoid(acc[ai][bj][m][1][i] + b1[i]); }
                    sq += dot4(v0) + dot4(v1);
                    *(u32x4*)(SSM + (size_t)row * cfg::MIXP + col) = pack8(v0, v1);
                }
                sq += __shfl_xor(sq, 16); sq += __shfl_xor(sq, 32);
                if (fq == 0) ssq[(size_t)row * 8 + u.pn * 4 + wc] = sq;
            }
    }
};
}
constexpr int NWAVES = 8;
constexpr int RING_BYTES = 131072;
constexpr int LDSCTL_OFF = RING_BYTES, MISC_OFF = LDSCTL_OFF + 320;
constexpr int BIAS_OFF = RING_BYTES + 1024;
constexpr int LDS_BYTES = 147456;
constexpr size_t WS_CBP = wsl::S5A + 64 * 1024;

struct Args { const float* in[34]; float* out; unsigned char* ws; int ph_lo, ph_hi; };

struct Frame { LAS unsigned char* lds; int wave, G, gw, NGW; __device__ __forceinline__ int tid() const { return wave * 64 + lane_id(); } };

__device__ __forceinline__ float wave_sum(float v) {
#pragma unroll
    for (int o = 1; o < 64; o <<= 1) v += __shfl_xor(v, o);
    return v;
}
__device__ __forceinline__ void tr_item(const float* __restrict__ W, int N, int Npad, const float* __restrict__ gain, bf16_t* WT, int ldt, int mode, LAS float* scr, int item, int lane) {
    const int nblk = Npad / 32, kb = item / nblk, nb = item % nblk, k0 = 64 * kb, n0 = 32 * nb;
    const int kk8 = lane >> 3, n4 = (lane & 7) * 4; const bool ok = (n0 + n4) < N;
    f32x4 v[8];
#pragma unroll
    for (int i = 0; i < 8; ++i) v[i] = ok ? *(const GAS f32x4*)(W + (size_t)(k0 + 8 * i + kk8) * N + n0 + n4) : (f32x4){0.f, 0.f, 0.f, 0.f};
#pragma unroll
    for (int i = 0; i < 8; ++i) { const int kk = 8 * i + kk8; const float gk = gain ? gain[k0 + kk] : 1.f; LAS float* d = scr + kk * 33 + n4;
        d[0] = v[i].x * gk; d[1] = v[i].y * gk; d[2] = v[i].z * gk; d[3] = v[i].w * gk; }
    LDS_WAIT(); asm volatile("" ::: "memory");
    const int c = lane & 7;
#pragma unroll
    for (int j = 0; j < 4; ++j) { const int nl = (lane >> 3) + 8 * j, n = n0 + nl; const LAS float* s = scr + (8 * c) * 33 + nl;
        const int row = mode == 0 ? n : ((n >> 7) * 256 + (mode == 2 ? 128 : 0) + (n & 127));
        v4u o; o.x = pk2(s[0 * 33], s[1 * 33]); o.y = pk2(s[2 * 33], s[3 * 33]); o.z = pk2(s[4 * 33], s[5 * 33]); o.w = pk2(s[6 * 33], s[7 * 33]);
        *(GAS v4u*)(WT + (size_t)row * ldt + k0 + 8 * c) = o; }
    LDS_WAIT(); asm volatile("" ::: "memory");
}
struct S5P { float xr, xi, fr, fi; };
__device__ __forceinline__ S5P s5_param(const float* const* in, int g, int p) {
    const float dt = expf(in[18][g]), lr = in[16][g * 64 + p], li = in[17][g * 64 + p];
    S5P q; q.xr = lr * dt; q.xi = li * dt;
    const float mag = expf(q.xr), ar = mag * cosf(q.xi), ai = mag * sinf(q.xi), nr = ar - 1.f, den = lr * lr + li * li;
    q.fr = (nr * lr + ai * li) / den; q.fi = (ai * lr - nr * li) / den; return q;
}
__device__ __forceinline__ void cpow(const S5P& q, int n, float& re, float& im) { const float mag = expf(n * q.xr), ang = n * q.xi; re = mag * cosf(ang); im = mag * sinf(ang); }

__device__ __forceinline__ void p0_prologue(Frame& F, const Args& a) {
    using namespace cfg;
    unsigned char* ws = a.ws; const float* const* in = a.in;
    LAS float* scr = (LAS float*)(F.lds + F.wave * 16384);
    const int lane = lane_id();
    bf16_t* BTS = (bf16_t*)(ws + wsl::BTS); bf16_t* BTY = (bf16_t*)(ws + wsl::BTY);
    constexpr int N_KT = SGRP * 31, N_V = SGRP * 16, N_S = SGRP * 16, N_Z = SGRP * 8, N_A = SGRP, N_CB = 2 * 4 * 16;
    constexpr int NS5 = N_KT + N_V + N_S + N_Z + N_A + N_CB;
    for (int it = F.gw; it < NS5; it += F.NGW) {
        int r = it;
        if (r < N_KT) {
            const int g = r / 31, tau = r % 31 - 15; bf16_t* Bg = BTY + (size_t)g * 256 * 384;
            if (tau < 0) {
                for (int t = 0; t <= 15 + tau; ++t) { const int s = t - tau;
#pragma unroll
                    for (int e = 0; e < 4; ++e) { const int idx = lane + 64 * e, h = idx >> 4, h2 = idx & 15; Bg[(size_t)(t * 16 + h) * 384 + s * 16 + h2] = 0; } }
                continue;
            }
            const int p = lane; const S5P q = s5_param(in, g, p); float pr, pi; cpow(q, tau, pr, pi);
            float car[16], cai[16];
#pragma unroll
            for (int h = 0; h < 16; ++h) { const float cr = in[21][(size_t)(g * 16 + h) * 64 + p], ci = in[22][(size_t)(g * 16 + h) * 64 + p]; car[h] = cr * pr - ci * pi; cai[h] = cr * pi + ci * pr; }
            float keep[4] = {0.f, 0.f, 0.f, 0.f};
#pragma unroll 1
            for (int h2 = 0; h2 < 16; ++h2) {
                const float br = in[19][(size_t)(g * 64 + p) * 16 + h2], bi = in[20][(size_t)(g * 64 + p) * 16 + h2];
                const float bbr = q.fr * br - q.fi * bi, bbi = q.fr * bi + q.fi * br;
#pragma unroll
                for (int h = 0; h < 16; ++h) { const float v = wave_sum(car[h] * bbr - cai[h] * bbi); if ((((h & 3) << 4) | h2) == lane) keep[h >> 2] = v; }
            }
#pragma unroll
            for (int e = 0; e < 4; ++e) { const int idx = lane + 64 * e, h = idx >> 4, h2 = idx & 15;
                const float v = keep[e] + ((tau == 0 && h == h2) ? in[23][g * 16 + h] : 0.f); const bf16_t w = f2bf(v);
                for (int t = tau; t < 16; ++t) Bg[(size_t)(t * 16 + h) * 384 + (t - tau) * 16 + h2] = w; }
            continue;
        } r -= N_KT;
        if (r < N_V) {
            const int g = r >> 4, t = r & 15, p = lane; const S5P q = s5_param(in, g, p); float pr, pi; cpow(q, t + 1, pr, pi);
            bf16_t* Bg = BTY + (size_t)g * 256 * 384;
#pragma unroll
            for (int h = 0; h < 16; ++h) { const float cr = in[21][(size_t)(g * 16 + h) * 64 + p], ci = in[22][(size_t)(g * 16 + h) * 64 + p];
                Bg[(size_t)(t * 16 + h) * 384 + 256 + p] = f2bf(cr * pr - ci * pi); Bg[(size_t)(t * 16 + h) * 384 + 320 + p] = f2bf(-(cr * pi + ci * pr)); }
            continue;
        } r -= N_V;
        if (r < N_S) {
            const int g = r >> 4, s = r & 15, p = lane; const S5P q = s5_param(in, g, p); float pr, pi; cpow(q, 15 - s, pr, pi);
            bf16_t* Bg = BTS + (size_t)g * 256 * 256;
#pragma unroll
            for (int h = 0; h < 16; ++h) { const float br = in[19][(size_t)(g * 64 + p) * 16 + h], bi = in[20][(size_t)(g * 64 + p) * 16 + h];
                const float bbr = q.fr * br - q.fi * bi, bbi = q.fr * bi + q.fi * br;
                Bg[(size_t)p * 256 + s * 16 + h] = f2bf(pr * bbr - pi * bbi); Bg[(size_t)(64 + p) * 256 + s * 16 + h] = f2bf(pr * bbi + pi * bbr); }
            continue;
        } r -= N_S;
        if (r < N_Z) {
            const int g = r >> 3, blk = r & 7; GAS v4u* z = (GAS v4u*)(BTS + (size_t)g * 256 * 256 + (size_t)(128 + 16 * blk) * 256);
            for (int i = lane; i < 16 * 256 * 2 / 16; i += 64) z[i] = (v4u){0u, 0u, 0u, 0u};
            continue;
        } r -= N_Z;
        if (r < N_A) { const int g = r, p = lane; const S5P q = s5_param(in, g, p); float pr, pi; cpow(q, LCH, pr, pi); float* A16 = (float*)(ws + wsl::S5A); A16[(g * 64 + p) * 2] = pr; A16[(g * 64 + p) * 2 + 1] = pi; continue; } r -= N_A;
        {
            const int ten = r >> 6, nb = (r >> 4) & 3, ks = r & 15, n = nb * 64 + lane; const float* pos = ten ? in[9] : in[8]; const float* w1 = ten ? in[13] : in[10];
            float acc = 0.f;
            for (int kk = ks * 128; kk < ks * 128 + 128; ++kk) acc += pos[kk] * w1[(size_t)kk * 256 + n];
            ((float*)(ws + WS_CBP))[(ten * 16 + ks) * 256 + n] = acc;
        }
    }
    constexpr int I_GU = 16 * 88, I_DN = 44 * 32, I_WIN = 16 * 64, I_WO = 8 * 32, I_C1 = 32 * 8, I_C2 = 4 * 2, I_GLU = 8 * 16;
    constexpr int NTR = 2 * (2 * I_GU + I_DN) + I_WIN + 2 * I_WO + 2 * I_C1 + 2 * I_C2 + I_GLU;
    for (int it = F.gw; it < NTR; it += F.NGW) {
        int r = it;
        if (r < I_GU) { tr_item(in[2], FF, FF, in[1], (bf16_t*)(ws + wsl::W1A), D, 1, scr, r, lane); continue; } r -= I_GU;
        if (r < I_GU) { tr_item(in[3], FF, FF, in[1], (bf16_t*)(ws + wsl::W1A), D, 2, scr, r, lane); continue; } r -= I_GU;
        if (r < I_DN) { tr_item(in[4], D, D, nullptr, (bf16_t*)(ws + wsl::W1D), FF, 0, scr, r, lane); continue; } r -= I_DN;
        if (r < I_GU) { tr_item(in[30], FF, FF, in[29], (bf16_t*)(ws + wsl::W2A), D, 1, scr, r, lane); continue; } r -= I_GU;
        if (r < I_GU) { tr_item(in[31], FF, FF, in[29], (bf16_t*)(ws + wsl::W2A), D, 2, scr, r, lane); continue; } r -= I_GU;
        if (r < I_DN) { tr_item(in[32], D, D, nullptr, (bf16_t*)(ws + wsl::W2D), FF, 0, scr, r, lane); continue; } r -= I_DN;
        if (r < I_WIN) { tr_item(in[6], INC, INC_PAD, in[5], (bf16_t*)(ws + wsl::WIN), D, 0, scr, r, lane); continue; } r -= I_WIN;
        if (r < I_WO) { tr_item(in[28], D, D, in[26], (bf16_t*)(ws + wsl::WOUT), D, 0, scr, r, lane); continue; } r -= I_WO;
        if (r < I_WO) { tr_item(in[28] + (size_t)512 * D, D, D, in[27], (bf16_t*)(ws + wsl::WOUT) + 512, D, 0, scr, r, lane); continue; } r -= I_WO;
        if (r < I_C1) { tr_item(in[10], 256, 256, nullptr, (bf16_t*)(ws + wsl::CW1K), 2048, 0, scr, r, lane); continue; } r -= I_C1;
        if (r < I_C1) { tr_item(in[13], 256, 256, nullptr, (bf16_t*)(ws + wsl::CW1V), 2048, 0, scr, r, lane); continue; } r -= I_C1;
        if (r < I_C2) { tr_item(in[12], 64, 64, nullptr, (bf16_t*)(ws + wsl::CW2K), 256, 0, scr, r, lane); continue; } r -= I_C2;
        if (r < I_C2) { tr_item(in[15], 64, 64, nullptr, (bf16_t*)(ws + wsl::CW2V), 256, 0, scr, r, lane); continue; } r -= I_C2;
        tr_item(in[24], 512, 512, nullptr, (bf16_t*)(ws + wsl::GLUW), 512, 0, scr, r, lane);
    }
    for (int m = F.gw; m < M; m += 2 * F.NGW) {
        const int m2 = m + F.NGW;
        const GAS f32x4* xr = (const GAS f32x4*)(in[0] + (size_t)m * D) + lane; const GAS f32x4* xr2 = (const GAS f32x4*)(in[0] + (size_t)(m2 < M ? m2 : m) * D) + lane;
        f32x4 v[4], w[4]; float s = 0.f, s2 = 0.f;
#pragma unroll
        for (int j = 0; j < 4; ++j) { v[j] = xr[64 * j]; w[j] = xr2[64 * j]; }
#pragma unroll
        for (int j = 0; j < 4; ++j) { s += (v[j].x * v[j].x + v[j].y * v[j].y) + (v[j].z * v[j].z + v[j].w * v[j].w); s2 += (w[j].x * w[j].x + w[j].y * w[j].y) + (w[j].z * w[j].z + w[j].w * w[j].w); }
        const float r = rsqrtf(wave_sum(s) * (1.f / D) + EPS), r2 = rsqrtf(wave_sum(s2) * (1.f / D) + EPS);
        GAS unsigned long long* o8 = (GAS unsigned long long*)((bf16_t*)(ws + wsl::XB) + (size_t)m * D) + lane;
#pragma unroll
        for (int j = 0; j < 4; ++j) o8[64 * j] = (unsigned long long)pk2(v[j].x * r, v[j].y * r) | ((unsigned long long)pk2(v[j].z * r, v[j].w * r) << 32);
        if (m2 < M) { GAS unsigned long long* p8 = (GAS unsigned long long*)((bf16_t*)(ws + wsl::XB) + (size_t)m2 * D) + lane;
#pragma unroll
            for (int j = 0; j < 4; ++j) p8[64 * j] = (unsigned long long)pk2(w[j].x * r2, w[j].y * r2) | ((unsigned long long)pk2(w[j].z * r2, w[j].w * r2) << 32); }
    }
}
__device__ __forceinline__ void s5_scan_task(const Args& a, int bg, int lane) {
    using namespace cfg;
    const int g = bg & 31, b = bg >> 5, p = lane;
    const float* A16 = (const float*)(a.ws + wsl::S5A); const float ar = A16[(g * 64 + p) * 2], ai = A16[(g * 64 + p) * 2 + 1];
    const float* S = (const float*)(a.ws + wsl::S) + ((size_t)(g * 2048 + b * 256)) * 128; bf16_t* UX = (bf16_t*)(a.ws + wsl::UX) + ((size_t)(g * 2048 + b * 256)) * 384 + 256;
    float xr = 0.f, xi = 0.f;
    for (int c0 = 0; c0 < NCHUNK; c0 += 16) {
        float sr[16], si[16];
#pragma unroll
        for (int j = 0; j < 16; ++j) { sr[j] = S[(size_t)(c0 + j) * 128 + p]; si[j] = S[(size_t)(c0 + j) * 128 + 64 + p]; }
#pragma unroll
        for (int j = 0; j < 16; ++j) {
            UX[(size_t)(c0 + j) * 384 + p] = f2bf(xr); UX[(size_t)(c0 + j) * 384 + 64 + p] = f2bf(xi);
            const float nr = ar * xr - ai * xi + sr[j], ni = ar * xi + ai * xr + si[j]; xr = nr; xi = ni;
        }
    }
}
__device__ __forceinline__ void cmp_out_task(const float* __restrict__ PART, const LAS float* bias, const bf16_t* __restrict__ W2t, bf16_t* OUT, int task, int lane) {
    const int row0 = task * 16, fr = lane & 15, fq = lane >> 4;
    f32x4 acc[4];
#pragma unroll
    for (int nb = 0; nb < 4; ++nb) acc[nb] = (f32x4){0.f, 0.f, 0.f, 0.f};
#pragma unroll 2
    for (int ks = 0; ks < 8; ++ks) {
        const int c0 = ks * 32 + 8 * fq; const float* pp = PART + (size_t)(row0 + fr) * 256 + c0;
        f32x4 h0 = (f32x4){bias[c0], bias[c0 + 1], bias[c0 + 2], bias[c0 + 3]}, h1 = (f32x4){bias[c0 + 4], bias[c0 + 5], bias[c0 + 6], bias[c0 + 7]};
#pragma unroll
        for (int sl = 0; sl < 4; ++sl) { h0 = h0 + *(const f32x4*)(pp + (size_t)sl * 4096 * 256); h1 = h1 + *(const f32x4*)(pp + (size_t)sl * 4096 * 256 + 4); }
#pragma unroll
        for (int i = 0; i < 4; ++i) { h0[i] = pg8::fast_gelu_tanh(h0[i]); h1[i] = pg8::fast_gelu_tanh(h1[i]); }
        const bf16x8 af = __builtin_bit_cast(bf16x8, pg8::pack8(h0, h1));
#pragma unroll
        for (int nb = 0; nb < 4; ++nb) { const bf16x8 bfr = *(const bf16x8*)(W2t + (size_t)(nb * 16 + fr) * 256 + ks * 32 + 8 * fq); acc[nb] = __builtin_amdgcn_mfma_f32_16x16x32_bf16(af, bfr, acc[nb], 0, 0, 0); }
    }
#pragma unroll
    for (int nb = 0; nb < 4; ++nb)
#pragma unroll
        for (int i = 0; i < 4; ++i) OUT[(size_t)(row0 + 4 * fq + i) * 64 + nb * 16 + fr] = f2bf(acc[nb][i]);
}
#define HAVE_FAST_ATTN 1
namespace att {
typedef float f32x16 __attribute__((ext_vector_type(16)));
typedef short v4i16 __attribute__((ext_vector_type(4)));
constexpr int KOFF = 0, VOFF = 16384, IMPP_OFF = 32768, SC_OFF = 98304, MASK_OFF = 114688, SSQP_OFF = 115200;
constexpr float THR = 8.f, MINIT = -1e30f;
__device__ __forceinline__ int crow(int r, int hi) { return (r & 3) + 8 * (r >> 2) + 4 * hi; }
__device__ __forceinline__ f32x16 zero16() { f32x16 z;
#pragma unroll
    for (int i = 0; i < 16; ++i) z[i] = 0.f; return z; }
__device__ __forceinline__ void qk_tile(const LAS unsigned char* Kb, const bf16x8 (&qr)[4], int r32, int hi, f32x16& p0, f32x16& p1) {
    p0 = zero16(); p1 = zero16();
    bf16x8 a0[4], a1[4];
#pragma unroll
    for (int d0 = 0; d0 < 4; ++d0) { const int off = r32 * 128 + (((2 * d0 + hi) ^ ((r32 >> 1) & 7)) << 4); a0[d0] = *(const LAS bf16x8*)(Kb + off); a1[d0] = *(const LAS bf16x8*)(Kb + 4096 + off); }
    __builtin_amdgcn_sched_barrier(0);
#pragma unroll
    for (int d0 = 0; d0 < 4; ++d0) {
        p0 = __builtin_amdgcn_mfma_f32_32x32x16_bf16(a0[d0], qr[d0], p0, 0, 0, 0);
        p1 = __builtin_amdgcn_mfma_f32_32x32x16_bf16(a1[d0], qr[d0], p1, 0, 0, 0);
    }
}
__device__ __forceinline__ bf16x8 pack_p(const f32x16& p, int s) {
    pg8::u32x4 w; w.x = pg8::cvt_pk_bf16(p[8 * s], p[8 * s + 1]); w.y = pg8::cvt_pk_bf16(p[8 * s + 2], p[8 * s + 3]); w.z = pg8::cvt_pk_bf16(p[8 * s + 4], p[8 * s + 5]); w.w = pg8::cvt_pk_bf16(p[8 * s + 6], p[8 * s + 7]);
    return __builtin_bit_cast(bf16x8, w);
}
__device__ __forceinline__ v4i16 vtr(const LAS unsigned char* p) { return __builtin_amdgcn_ds_read_tr16_b64_v4i16((LAS v4i16*)p); }
__device__ __forceinline__ void pv_tile(const LAS unsigned char* Vb, int vl0, const f32x16& p0, const f32x16& p1, f32x16 (&o)[2]) {
    bf16x8 pf[4];
#pragma unroll
    for (int i = 0; i < 4; ++i) pf[i] = pack_p((i >> 1) ? p1 : p0, i & 1);
#pragma unroll
    for (int db = 0; db < 2; ++db) {
        v4i16 lo[4], hi4[4];
#pragma unroll
        for (int i = 0; i < 4; ++i) { const LAS unsigned char* vp = Vb + (vl0 ^ (db * 64)) + (i >> 1) * 4096 + (i & 1) * 2048; lo[i] = vtr(vp); hi4[i] = vtr(vp + 1024); }
        __builtin_amdgcn_sched_barrier(0);
#pragma unroll
        for (int i = 0; i < 4; ++i) { const bf16x8 vf = (bf16x8){lo[i][0], lo[i][1], lo[i][2], lo[i][3], hi4[i][0], hi4[i][1], hi4[i][2], hi4[i][3]};
            o[db] = __builtin_amdgcn_mfma_f32_32x32x16_bf16(vf, pf[i], o[db], 0, 0, 0); }
    }
}
__device__ __forceinline__ float other32(float x, int hi) { const auto rr = __builtin_amdgcn_permlane32_swap(__float_as_uint(x), __float_as_uint(x), false, false); return __uint_as_float(hi ? rr[0] : rr[1]); }
__device__ __forceinline__ unsigned dpp_or8(unsigned x) {
    x |= (unsigned)__builtin_amdgcn_update_dpp(0, (int)x, 0xB1, 0xF, 0xF, true); x |= (unsigned)__builtin_amdgcn_update_dpp(0, (int)x, 0x4E, 0xF, 0xF, true); x |= (unsigned)__builtin_amdgcn_update_dpp(0, (int)x, 0x141, 0xF, 0xF, true); return x; }
__device__ __forceinline__ float max3f(float a, float b, float c) { float r; asm("v_max3_f32 %0, %1, %2, %3" : "=v"(r) : "v"(a), "v"(b), "v"(c)); return r; }
__device__ __forceinline__ float max2f(float a, float b) { float r; asm("v_max_f32_e32 %0, %1, %2" : "=v"(r) : "v"(a), "v"(b)); return r; }
__device__ __forceinline__ float max32(const f32x16& p, const f32x16& q) {
    float a = max3f(p[0], p[1], q[0]), b = max3f(p[2], p[3], q[1]); a = max3f(a, q[2], q[3]);
#pragma unroll
    for (int r = 4; r < 16; r += 4) { a = max3f(a, p[r], p[r + 1]); b = max3f(b, p[r + 2], p[r + 3]); a = max3f(a, q[r], q[r + 1]); b = max3f(b, q[r + 2], q[r + 3]); }
    return max2f(a, b);
}
__device__ __forceinline__ float max16(const f32x16& p) { float a = max3f(p[0], p[1], p[2]), b = max3f(p[3], p[4], p[5]); a = max3f(a, p[6], p[7]); b = max3f(b, p[8], p[9]); a = max3f(a, p[10], p[11]); b = max3f(b, p[12], p[13]); a = max3f(a, p[14], p[15]); return max2f(a, b); }
__device__ __forceinline__ float sum16v(const f32x16& p) { return (((p[0] + p[1]) + (p[2] + p[3])) + ((p[4] + p[5]) + (p[6] + p[7]))) + (((p[8] + p[9]) + (p[10] + p[11])) + ((p[12] + p[13]) + (p[14] + p[15]))); }
__device__ __forceinline__ void mask_range(f32x16& p, int sub, int hi, int lo, int hi_) {
    const int base = 32 * sub + 4 * hi;
#pragma unroll
    for (int r = 0; r < 16; ++r) { const int k = base + (r & 3) + 8 * (r >> 2); if (k < lo || k > hi_) p[r] = -INFINITY; }
}
__device__ __forceinline__ void softmax_pv(const LAS unsigned char* Vb, int vl0, f32x16& p0, f32x16& p1, float& m, float& l, f32x16 (&o)[2]) {
    float tmax = fmaxf(max16(p0), max16(p1)); tmax = fmaxf(tmax, __shfl_xor(tmax, 32));
    if (__any(tmax > m + THR)) { const float mn = fmaxf(m, tmax), f = __builtin_amdgcn_exp2f(m - mn); o[0] = o[0] * f; o[1] = o[1] * f; l *= f; m = mn; }
#pragma unroll
    for (int r = 0; r < 16; ++r) { p0[r] = __builtin_amdgcn_exp2f(p0[r] - m); p1[r] = __builtin_amdgcn_exp2f(p1[r] - m); }
    l += sum16v(p0) + sum16v(p1);
    pv_tile(Vb, vl0, p0, p1, o);
}

#define ATT_GLD(P, t) (*(const v4u*)((P) + (size_t)(t) * 4096 + tid * 8))
#define ATT_SEQ_LOAD(i_) do { const int i__ = (i_); if (i__ < te_) { gK = ATT_GLD(Kg_, i__); gV = ATT_GLD(Vg_, i__); } \
        else if (NKg_ && ntb_ + (i__ - te_) < nte_) { gK = ATT_GLD(NKg_, ntb_ + (i__ - te_)); gV = ATT_GLD(NVg_, ntb_ + (i__ - te_)); } } while (0)
#define ATT_LOOP_BEGIN(Kg, Vg, tbeg, tend, NKg, NVg, ntb, nte) { const bf16_t* Kg_ = (Kg); const bf16_t* Vg_ = (Vg); const bf16_t* NKg_ = (NKg); const bf16_t* NVg_ = (NVg); const int tb_ = (tbeg), te_ = (tend), ntb_ = (ntb), nte_ = (nte); \
    *(LAS v4u*)(lds + KOFF + kst) = gK; *(LAS v4u*)(lds + VOFF + vst) = gV; \
    __syncthreads(); \
    for (int jt = tb_; jt < te_; ++jt) { const int bufo_ = ((jt - tb_) & 1) * 8192; const bool more_ = jt + 1 < te_; \
        ATT_SEQ_LOAD(jt + 1); \
        { const LAS unsigned char* Kb = lds + KOFF + bufo_; const LAS unsigned char* Vb = lds + VOFF + bufo_;
#define ATT_LOOP_END } \
        if (more_) { *(LAS v4u*)(lds + KOFF + (bufo_ ^ 8192) + kst) = gK; *(LAS v4u*)(lds + VOFF + (bufo_ ^ 8192) + vst) = gV; } \
        __syncthreads(); } }

template <int MODE, bool EDGE, int VAR> __device__ __forceinline__ void tile_body(const LAS unsigned char* Kb, const LAS unsigned char* Vb, int vl0, const bf16x8 (&qr)[4], int r32, int hi, int jt, int qb, int iq,
                                                                         unsigned long long selm, float& m, float& l, f32x16 (&o)[2]) {
    f32x16 p0, p1; if (VAR & 16) { p0 = zero16(); p1 = zero16(); asm volatile("" : "+v"(p0), "+v"(p1)); } else qk_tile(Kb, qr, r32, hi, p0, p1);
    asm volatile("s_nop 15\n\ts_nop 7" : "+v"(p0), "+v"(p1));
    const bool sel = MODE == 0 ? (bool)((selm >> jt) & 1ull) : true;
    if (EDGE) {
        if (jt == qb) { mask_range(p0, 0, hi, 0, iq); mask_range(p1, 1, hi, 0, iq); }
        else if (MODE == 1 && jt == qb - 8) { mask_range(p0, 0, hi, iq + 1, 63); mask_range(p1, 1, hi, iq + 1, 63); }
    }
    float tmax = (VAR & 4) ? 0.f : max32(p0, p1); if (!(VAR & 4)) tmax = max2f(tmax, other32(tmax, hi));
    if (MODE == 0) tmax = sel ? tmax : -INFINITY;
    if (!(VAR & 4) && __any(tmax > m + THR)) { const float mn = fmaxf(m, tmax), f = __builtin_amdgcn_exp2f(m - mn); o[0] = o[0] * f; o[1] = o[1] * f; l *= f; m = mn; }
    const float mref = (MODE == 0) ? (sel ? m : 1e30f) : m;
    if (!(VAR & 2)) {
#pragma unroll
    for (int r = 0; r < 16; ++r) { p0[r] = __builtin_amdgcn_exp2f(p0[r] - mref); p1[r] = __builtin_amdgcn_exp2f(p1[r] - mref); }
    l += sum16v(p0) + sum16v(p1);
    }
    if (!(VAR & 1)) pv_tile(Vb, vl0, p0, p1, o); else { asm volatile("" :: "v"(p0), "v"(p1)); }
}
template <int MODE, int VAR> __device__ __forceinline__ void run_branch(LAS unsigned char* lds, const bf16_t* Kg_, const bf16_t* Vg_, const int t0, const int te_, const bf16_t* NKg_, const bf16_t* NVg_, const int ntb_, const int nte_,
                                                               v4u& gK, v4u& gV, const int tid, const int kst, const int vst, const int vl0,
                                                               const bf16x8 (&qr)[4], const int r32, const int hi, const int qb, const int iq, const unsigned long long selm, float& m, float& l, f32x16 (&o)[2]) {
#define ATT_TILE(EDGE, jt_) do { const int j_ = (jt_); const int bo_ = ((j_ - t0) & 1) * 8192; const bool more_ = j_ + 1 < te_; \
        ATT_SEQ_LOAD(j_ + 1); \
        tile_body<MODE, EDGE, VAR>(lds + KOFF + bo_, lds + VOFF + bo_, vl0, qr, r32, hi, j_, qb, iq, selm, m, l, o); \
        if (more_) { *(LAS v4u*)(lds + KOFF + (bo_ ^ 8192) + kst) = gK; *(LAS v4u*)(lds + VOFF + (bo_ ^ 8192) + vst) = gV; } \
        if (!(VAR & 8)) __syncthreads(); } while (0)
    *(LAS v4u*)(lds + KOFF + kst) = gK; *(LAS v4u*)(lds + VOFF + vst) = gV;
    __syncthreads();
    ATT_TILE(true, t0);
#pragma unroll 1
    for (int jt = t0 + 1; jt < te_ - 1; ++jt) ATT_TILE(false, jt);
    if (te_ - 1 > t0) ATT_TILE(true, te_ - 1);
#undef ATT_TILE
}

template <int VAR> __device__ __forceinline__ void attn_unit(LAS unsigned char* lds, const Args& a, int b, int g, int qb, const int w) {
    using namespace cfg;
    int tid = w * 64 + lane_id(); asm volatile("" : "+v"(tid));
    const int lane = tid & 63, r32 = lane & 31, hi = lane >> 5, hr = w >> 1, qh = w & 1;
    const int head = g * 4 + hr, iq = 32 * qh + r32, tq = 64 * qb + iq, row = b * T + tq;
    unsigned char* ws = a.ws;
    const size_t bg = (size_t)(b * 2 + g);
    const bf16_t* KV = (const bf16_t*)(ws + wsl::KV);
    const bf16_t* kc = (const bf16_t*)(ws + wsl::KC) + bg * 256 * 64; const bf16_t* vc = (const bf16_t*)(ws + wsl::VC) + bg * 256 * 64;
    const bf16_t* ks = KV + 2 * KVPART + bg * T * 64; const bf16_t* vs = KV + 3 * KVPART + bg * T * 64;
    const bf16_t* kw = KV + 4 * KVPART + bg * T * 64; const bf16_t* vw = KV + 5 * KVPART + bg * T * 64;
    const int srow = tid >> 3, sch = tid & 7;
    const int kst = srow * 128 + ((sch ^ ((srow >> 1) & 7)) << 4), vst = srow * 128 + ((sch << 4) ^ (((srow >> 1) & 1) << 6));
    const int tq4 = (lane & 15) >> 2, tp = lane & 3, tblk = (lane >> 4) & 1;
    const int vl0 = hi * 512 + tq4 * 128 + ((tblk * 32 + tp * 8) ^ (((tq4 >> 1) & 1) << 6));
    bf16x8 qr[4];
    { const bf16_t* Qp = (const bf16_t*)(ws + wsl::Q) + (((size_t)(b * NH + head)) * T + tq) * 64 + 8 * hi;
#pragma unroll
      for (int d0 = 0; d0 < 4; ++d0) qr[d0] = *(const bf16x8*)(Qp + 16 * d0); }
#define ATT_COLD_ROW(rowv) int rowv; { int t2_ = w * 64 + lane_id(); asm volatile("" : "+v"(t2_)); rowv = b * T + 64 * qb + 32 * qh + (t2_ & 31); }
    LAS float* IMPP = (LAS float*)(lds + IMPP_OFF);
    LAS float* TOT = IMPP + tid;
    LAS float* SC = (LAS float*)(lds + SC_OFF);
    LAS unsigned* MASK = (LAS unsigned*)(lds + MASK_OFF);
    LAS float* SSQP = (LAS float*)(lds + SSQP_OFF);

    int ntc = (4 * qb + 3 + 63) >> 6; if (ntc > 4) ntc = 4;
    int nvq = tq >= 31 ? ((tq - 31) >> 4) + 1 : 0; if (nvq > NC) nvq = NC;
    float m = MINIT, l = 0.f;
    const int t0w = qb >= 8 ? qb - 8 : 0;
    v4u gK = ATT_GLD(kc, 0), gV = ATT_GLD(vc, 0);
    ATT_LOOP_BEGIN(kc, vc, 0, ntc, kc, vc, 0, ntc)
        f32x16 p0, p1; qk_tile(Kb, qr, r32, hi, p0, p1);
        const int lim = nvq - 1 - 64 * jt;
        mask_range(p0, 0, hi, 0, lim); mask_range(p1, 1, hi, 0, lim);
        asm volatile("s_nop 15\n\ts_nop 7" : "+v"(p0), "+v"(p1));
        const float tmax = max32(p0, p1);
        if (tmax > m) { l *= __builtin_amdgcn_exp2f(m - tmax); m = tmax; }
        float s = 0.f;
#pragma unroll
        for (int r = 0; r < 16; ++r) s += __builtin_amdgcn_exp2f(p0[r] - m) + __builtin_amdgcn_exp2f(p1[r] - m);
        l += s;
    ATT_LOOP_END
    { const float mo = other32(m, hi), lo_ = other32(l, hi), mt = fmaxf(m, mo);
      l = l * __builtin_amdgcn_exp2f(m - mt) + lo_ * __builtin_amdgcn_exp2f(mo - mt); m = mt; }
    const float inv_c = 1.f / fmaxf(l, 1e-30f);
    f32x16 oc[2]; oc[0] = zero16(); oc[1] = zero16();
    {
        float carry = 0.f;
        ATT_LOOP_BEGIN(kc, vc, 0, ntc, ks, vs, 0, qb + 1)
            f32x16 p0, p1; qk_tile(Kb, qr, r32, hi, p0, p1);
            const int lim = nvq - 1 - 64 * jt;
            mask_range(p0, 0, hi, 0, lim); mask_range(p1, 1, hi, 0, lim);
#pragma unroll
            for (int r = 0; r < 16; ++r) { p0[r] = __builtin_amdgcn_exp2f(p0[r] - m) * inv_c; p1[r] = __builtin_amdgcn_exp2f(p1[r] - m) * inv_c; }
            int ib = IMPP_OFF + (((hr * 64 + iq) * 64 + hi + 16 * jt) << 2); asm volatile("" : "+v"(ib));
#pragma unroll
            for (int sub = 0; sub < 2; ++sub) {
                float gs[4], recv[4];
#pragma unroll
                for (int k = 0; k < 4; ++k) { const float x0 = sub ? p1[4 * k] : p0[4 * k], x1 = sub ? p1[4 * k + 1] : p0[4 * k + 1], x2 = sub ? p1[4 * k + 2] : p0[4 * k + 2], x3 = sub ? p1[4 * k + 3] : p0[4 * k + 3];
                    gs[k] = (x0 + x1) + (x2 + x3); recv[k] = other32(x3, hi); }
#pragma unroll
                for (int k = 0; k < 4; ++k) { const float add = hi ? recv[k] : (k > 0 ? recv[k - 1] : carry);
                    *(LAS float*)(lds + ib + (8 * sub + 2 * k) * 4) = gs[k] + add; }
                carry = recv[3];
            }
            pv_tile(Vb, vl0, p0, p1, oc);
        ATT_LOOP_END
    }
    if (qb < SEL_TOPK) {
        if (tid < 64) { MASK[tid * 2] = (2u << qb) - 1u; MASK[tid * 2 + 1] = 0u; }
        __syncthreads();
    } else
    {
        const int q = tid >> 3, jc = tid & 7;
        float mine[8];
#pragma unroll
        for (int e = 0; e < 8; ++e) { const int j = 8 * jc + e; float s;
            if (j == 0 || j == qb || j == qb - 1) s = INFINITY;
            else if (j <= qb) s = ((IMPP[(0 * 64 + q) * 64 + j] + IMPP[(1 * 64 + q) * 64 + j]) + IMPP[(2 * 64 + q) * 64 + j]) + IMPP[(3 * 64 + q) * 64 + j];
            else s = -INFINITY;
            mine[e] = s; SC[q * 64 + j] = s; }
        __syncthreads();
        int rank[8];
#pragma unroll
        for (int e = 0; e < 8; ++e) rank[e] = 0;
        for (int j2 = 0; j2 < 64; ++j2) { const float o = SC[q * 64 + j2];
#pragma unroll
            for (int e = 0; e < 8; ++e) rank[e] += (o > mine[e] || (o == mine[e] && j2 < 8 * jc + e)) ? 1 : 0; }
        unsigned bits = 0u;
#pragma unroll
        for (int e = 0; e < 8; ++e) if (rank[e] < SEL_TOPK && 8 * jc + e <= qb) bits |= 1u << e;
        unsigned lo32 = jc < 4 ? bits << (8 * jc) : 0u, hi32 = jc >= 4 ? bits << (8 * (jc - 4)) : 0u;
        lo32 = dpp_or8(lo32); hi32 = dpp_or8(hi32);
        if (jc == 0) { MASK[q * 2] = lo32; MASK[q * 2 + 1] = hi32; }
        __syncthreads();
    }
    {
        ATT_COLD_ROW(row_c) const float g_cmp = ((const float*)(ws + wsl::GATES))[(size_t)row_c * 24 + head * 3];
#pragma unroll
        for (int db = 0; db < 2; ++db)
#pragma unroll
            for (int r = 0; r < 16; ++r) TOT[(db * 16 + r) * 512] = oc[db][r] * g_cmp;
    }
    {
        const unsigned long long selm = (unsigned long long)MASK[iq * 2] | ((unsigned long long)MASK[iq * 2 + 1] << 32);
        f32x16 o[2]; o[0] = zero16(); o[1] = zero16(); m = MINIT; l = 0.f;
        run_branch<0, VAR>(lds, ks, vs, 0, qb + 1, kw, vw, t0w, qb + 1, gK, gV, tid, kst, vst, vl0, qr, r32, hi, qb, iq, selm, m, l, o);
        l += other32(l, hi);
        ATT_COLD_ROW(row_s) const float sc = ((const float*)(ws + wsl::GATES))[(size_t)row_s * 24 + head * 3 + 1] / fmaxf(l, 1e-30f);
#pragma unroll
        for (int db = 0; db < 2; ++db)
#pragma unroll
            for (int r = 0; r < 16; ++r) TOT[(db * 16 + r) * 512] += o[db][r] * sc;
    }
    {
        f32x16 o[2]; o[0] = zero16(); o[1] = zero16(); m = MINIT; l = 0.f;
        run_branch<1, VAR>(lds, kw, vw, t0w, qb + 1, nullptr, nullptr, 0, 0, gK, gV, tid, kst, vst, vl0, qr, r32, hi, qb, iq, 0ull, m, l, o);
        l += other32(l, hi);
        ATT_COLD_ROW(row_w) const float sc = ((const float*)(ws + wsl::GATES))[(size_t)row_w * 24 + head * 3 + 2] / fmaxf(l, 1e-30f);
#pragma unroll
        for (int db = 0; db < 2; ++db)
#pragma unroll
            for (int r = 0; r < 16; ++r) o[db][r] = TOT[(db * 16 + r) * 512] + o[db][r] * sc;
        oc[0] = o[0]; oc[1] = o[1];
    }
    {
        ATT_COLD_ROW(row_o) bf16_t* orow = (bf16_t*)(ws + wsl::MIX) + (size_t)row_o * MIXP + head * 64;
        float sq = 0.f;
#pragma unroll
        for (int db = 0; db < 2; ++db)
#pragma unroll
            for (int k = 0; k < 4; ++k) { const float x0 = oc[db][4 * k], x1 = oc[db][4 * k + 1], x2 = oc[db][4 * k + 2], x3 = oc[db][4 * k + 3];
                sq += (x0 * x0 + x1 * x1) + (x2 * x2 + x3 * x3);
                pg8::u32x2 wv; wv.x = pg8::cvt_pk_bf16(x0, x1); wv.y = pg8::cvt_pk_bf16(x2, x3);
                *(pg8::u32x2*)(orow + 32 * db + 8 * k + 4 * hi) = wv; }
        sq += other32(sq, hi);
        if (hi == 0) SSQP[hr * 64 + iq] = sq;
        __syncthreads();
        if (tid < 64) ((float*)(ws + wsl::SSQA))[(size_t)(b * T + 64 * qb + tid) * 2 + g] = ((SSQP[tid] + SSQP[64 + tid]) + SSQP[128 + tid]) + SSQP[192 + tid];
        __syncthreads();
    }
}
}
template <int VAR> __device__ __forceinline__ void attn_phase(Frame& F, const Args& a) {
    const int G = F.G, bx = (int)blockIdx.x;
    for (int v0 = (G % 8 == 0) ? (bx % 8) * (G / 8) + bx / 8 : bx; v0 < 256; v0 += G) {
        const int bgi = v0 >> 4, s = v0 & 15;
#pragma unroll 1
        for (int i = 0; i < 4; ++i) { const int qb = i == 0 ? 63 - s : (i == 1 ? 32 + s : (i == 2 ? 31 - s : s)); att::attn_unit<VAR>(F.lds, a, bgi >> 1, bgi & 1, qb, F.wave); }
    }
}
constexpr int CW_BAR = 4096;
enum Feat { F_FFN1 = 1, F_WIN = 2, F_CMP = 4, F_S5 = 8, F_GLU = 16, F_ATT = 32, F_WOUT = 64, F_FFN2 = 128, F_ALL = 255 };
constexpr int NPHASE = 12;

__global__ void __launch_bounds__(NWAVES * 64, 2) mk_fwd(Args args, int feat) {
    using namespace cfg;
    extern __shared__ __attribute__((aligned(16))) unsigned char lds_raw[];
    Frame F;
    F.lds = (LAS unsigned char*)lds_raw;
    F.wave = __builtin_amdgcn_readfirstlane(threadIdx.x >> 6);
    F.G = gridDim.x; F.gw = blockIdx.x * NWAVES + F.wave; F.NGW = F.G * NWAVES;
    volatile LAS unsigned* MISC = (volatile LAS unsigned*)(F.lds + MISC_OFF);
    for (int u = F.tid(); u < (LDS_BYTES - LDSCTL_OFF) / 4; u += NWAVES * 64) ((LAS unsigned*)(F.lds + LDSCTL_OFF))[u] = 0u;
    __syncthreads();
    unsigned char* ws = args.ws; const float* const* in = args.in;
    const int lo = args.ph_lo, hi = args.ph_hi; const bool multi = (hi - lo) > 1;
    XcdBarrier bar; bar.bar = (unsigned*)(ws + wsl::CTL) + CW_BAR; bar.x = 0; bar.st = nullptr; bar.w0 = 0;
    if (multi) bar = xcd_barrier_post((unsigned*)(ws + wsl::CTL) + CW_BAR, MISC + 8);
#ifndef PH_MASK
#define PH_MASK 0xFFF
#endif
#define IN(k) (((PH_MASK >> (k)) & 1) && lo <= (k) && (k) < hi)
#ifndef REP_PH
#define REP_PH -1
#endif
#ifndef REP_N
#define REP_N 1
#endif
#ifndef REP_MASK
#define REP_MASK 0
#endif
#define REP(k) for (int rp_ = 0; rp_ < (((REP_PH) == (k) || (((REP_MASK) >> (k)) & 1)) ? (REP_N) : 1); ++rp_)
#ifdef PROBE_A
#define STAMP(i) do { if (blockIdx.x == 0 && F.tid() == 0) ((unsigned long long*)(ws + wsl::CTL + 65536))[i] = __builtin_amdgcn_s_memrealtime(); } while (0)
#else
#define STAMP(i) do {} while (0)
#endif
#define SEAM(k) do { if (IN(k) && IN((k) + 1)) { xcd_barrier(bar); STAMP((k) + 1); } } while (0)
    bf16_t* XB = (bf16_t*)(ws + wsl::XB); bf16_t* Hh = (bf16_t*)(ws + wsl::H);
    float* SSQ1 = (float*)(ws + wsl::SSQ1); float* SSQ2 = (float*)(ws + wsl::SSQ2); float* SSQ3 = (float*)(ws + wsl::SSQ3);
    float* SSQS = (float*)(ws + wsl::SSQS); float* SSQA = (float*)(ws + wsl::SSQA);
    bf16_t* MIX = (bf16_t*)(ws + wsl::MIX); bf16_t* YG = (bf16_t*)(ws + wsl::YG);
    MixBufs mb{(bf16_t*)(ws + wsl::Q), (bf16_t*)(ws + wsl::KV), (float*)(ws + wsl::GATES), (bf16_t*)(ws + wsl::UX), in[7]};
    const int cu = (int)blockIdx.x;

    STAMP(0);
    if (IN(0)) REP(0) { p0_prologue(F, args); }
    SEAM(0);
    if (IN(1) && (feat & F_FFN1)) REP(1) {
        pg8::Gemm g{XB, (const bf16_t*)(ws + wsl::W1A), M, 2 * FF, D, D, D, 0, 0}; pg8::StaticOrder S; S.init(M, 2 * FF, F.G, cu);
        pg8::EpiSwiGLU E{Hh, false, pg8::RowScaleTable{nullptr, -1, -1, nullptr}};
        pg8::gemm_phase<pg8::EpiSwiGLU, pg8::StaticOrder, true, true>(F.lds, g, S, E, F.wave);
    }
    SEAM(1);
    if (IN(2) && (feat & F_FFN1)) REP(2) {
        pg8::Gemm g{Hh, (const bf16_t*)(ws + wsl::W1D), M, D, FF, FF, FF, 0, 0}; pg8::StaticOrder S; S.init(M, D, F.G, cu);
        pg8::EpiResid<0> E{in[0], XB, SSQ1, nullptr, nullptr};
        pg8::gemm_phase<pg8::EpiResid<0>, pg8::StaticOrder, true, true>(F.lds, g, S, E, F.wave);
    }
    SEAM(2);
    if (IN(3) && (feat & F_WIN)) REP(3) {
        pg8::Gemm g{XB, (const bf16_t*)(ws + wsl::WIN), M, INC_PAD, D, D, D, 0, 0}; pg8::StaticOrder S; S.init(M, INC_PAD, F.G, cu);
        const pg8::RowScaleTable rt = pg8::make_row_scale_table((LAS float*)(F.lds + BIAS_OFF), SSQ1, S, F.tid());
        pg8::EpiWin E{mb, rt};
        pg8::gemm_phase<pg8::EpiWin, pg8::StaticOrder, true, true>(F.lds, g, S, E, F.wave);
    }
    SEAM(3);
    if (IN(4)) REP(4) {
        if (feat & F_CMP) {
            float* PART = (float*)(ws + wsl::YG);
            { pg8::Gemm g{mb.KV, (const bf16_t*)(ws + wsl::CW1K), 4096, 1024, 512, 1024, 2048, 0, 512}; pg8::StaticOrder S; S.init(4096, 1024, F.G, cu);
              pg8::EpiPart E{PART};
              pg8::gemm_phase<pg8::EpiPart, pg8::StaticOrder, true, true>(F.lds, g, S, E, F.wave); }
            { pg8::Gemm g{mb.KV + KVPART, (const bf16_t*)(ws + wsl::CW1V), 4096, 1024, 512, 1024, 2048, 0, 512}; pg8::StaticOrder S; S.init(4096, 1024, F.G, (cu + F.G - 64) % F.G);
              pg8::EpiPart E{PART + (size_t)4 * 4096 * 256};
              pg8::gemm_phase<pg8::EpiPart, pg8::StaticOrder, true, true>(F.lds, g, S, E, F.wave); }
        }
        if (feat & F_S5) {
            pg8::Gemm g{mb.UX, (const bf16_t*)(ws + wsl::BTS), SGRP * 2048, 256, 256, 384, 256, 8, 0}; pg8::StaticOrder S; S.init(SGRP * 2048, 256, F.G, (cu + F.G - 128) % F.G);
            pg8::EpiS5S E{(float*)(ws + wsl::S)};
            pg8::gemm_phase<pg8::EpiS5S, pg8::StaticOrder, true, true>(F.lds, g, S, E, F.wave);
        }
    }
    SEAM(4);
    if (IN(5)) REP(5) {
        LAS float* bias = (LAS float*)(F.lds + BIAS_OFF);
        if (feat & F_CMP) { const int t_ = F.tid(), ten = t_ >> 8, n = t_ & 255; const float* cbp = (const float*)(ws + WS_CBP) + ten * 16 * 256 + n; float s = (ten ? in[14] : in[11])[n];
#pragma unroll
            for (int k = 0; k < 16; ++k) s += cbp[k * 256];
            bias[ten * 256 + n] = s; }
        __syncthreads();
        if (F.wave == 0) { if (feat & F_S5) for (int bg = cu; bg < BATCH * SGRP; bg += F.G) s5_scan_task(args, bg, lane_id()); }
        else if (feat & F_CMP) {
            const float* PART = (const float*)(ws + wsl::YG);
            for (int tk = cu * (NWAVES - 1) + F.wave - 1; tk < 512; tk += F.G * (NWAVES - 1)) {
                if (tk < 256) cmp_out_task(PART, bias, (const bf16_t*)(ws + wsl::CW2K), (bf16_t*)(ws + wsl::KC), tk, lane_id());
                else cmp_out_task(PART + (size_t)4 * 4096 * 256, bias + 256, (const bf16_t*)(ws + wsl::CW2V), (bf16_t*)(ws + wsl::VC), tk - 256, lane_id());
            }
        }
    }
    SEAM(5);
    if (IN(6) && (feat & F_S5)) REP(6) {
        pg8::Gemm g{mb.UX, (const bf16_t*)(ws + wsl::BTY), SGRP * 2048, 256, 384, 384, 384, 8, 0}; pg8::StaticOrder S; S.init(SGRP * 2048, 256, F.G, cu);
        pg8::EpiS5Y E{YG};
        pg8::gemm_phase<pg8::EpiS5Y, pg8::StaticOrder, true, true>(F.lds, g, S, E, F.wave);
    }
    SEAM(6);
    if (IN(7)) {
#ifndef NO_GLU
        if (feat & F_GLU) REP(7) {
            pg8::Gemm g{YG, (const bf16_t*)(ws + wsl::GLUW), M, 512, 512, 512, 512, 0, 0}; pg8::StaticOrder S; S.init(M, 512, F.G, cu);
            pg8::EpiGLU E{YG, in[25], MIX + 512, SSQS};
            pg8::gemm_phase<pg8::EpiGLU, pg8::StaticOrder, true, true>(F.lds, g, S, E, F.wave);
        }
#endif
#ifdef HAVE_FAST_ATTN
#ifdef SHADOW_VAR
        if (feat & F_ATT) { attn_phase<SHADOW_VAR>(F, args); __syncthreads(); }
#endif
        if (feat & F_ATT) REP(12) attn_phase<0>(F, args);
#endif
    }
    SEAM(7);
    if (IN(8) && (feat & F_WOUT)) {
        pg8::Gemm g{MIX, (const bf16_t*)(ws + wsl::WOUT), M, D, D, D, D, 0, 0}; pg8::StaticOrder S; S.init(M, D, F.G, cu);
        pg8::EpiResid<1> E{nullptr, XB, SSQ2, SSQA, SSQS};
        pg8::gemm_phase<pg8::EpiResid<1>, pg8::StaticOrder, true, true>(F.lds, g, S, E, F.wave);
    }
    SEAM(8);
    if (IN(9) && (feat & F_FFN2)) REP(9) {
        pg8::Gemm g{XB, (const bf16_t*)(ws + wsl::W2A), M, 2 * FF, D, D, D, 0, 0}; pg8::StaticOrder S; S.init(M, 2 * FF, F.G, cu);
        const pg8::RowScaleTable rt = pg8::make_row_scale_table((LAS float*)(F.lds + BIAS_OFF), SSQ2, S, F.tid());
        pg8::EpiSwiGLU E{Hh, true, rt};
        pg8::gemm_phase<pg8::EpiSwiGLU, pg8::StaticOrder, true, true>(F.lds, g, S, E, F.wave);
    }
    SEAM(9);
    if (IN(10) && (feat & F_FFN2)) {
        pg8::Gemm g{Hh, (const bf16_t*)(ws + wsl::W2D), M, D, FF, FF, FF, 0, 0}; pg8::StaticOrder S; S.init(M, D, F.G, cu);
        pg8::EpiResid<2> E{nullptr, XB, SSQ3, nullptr, nullptr};
        pg8::gemm_phase<pg8::EpiResid<2>, pg8::StaticOrder, true, true>(F.lds, g, S, E, F.wave);
    }
    SEAM(10);
    if (IN(11) && (feat & F_FFN2)) {
        for (int m = F.gw; m < M; m += F.NGW) {
            const GAS unsigned long long* xr = (const GAS unsigned long long*)(XB + (size_t)m * D) + lane_id(); GAS f32x4* orow = (GAS f32x4*)(args.out + (size_t)m * D) + lane_id(); const GAS f32x4* gr = (const GAS f32x4*)in[33] + lane_id();
            float r = rsqrtf(pg8::sum16(SSQ3 + (size_t)m * 16) * (1.f / D) + EPS);
#ifdef PROBE_A
            { const unsigned long long* ts = (const unsigned long long*)(ws + wsl::CTL + 65536);
              const float ta = floorf((float)(ts[PROBE_A + 1] - ts[PROBE_A]) * 0.01f * 0.125f + 0.5f) * 8.f;
              r *= 1.f + sqrtf(ta * 2e-6f); }
#endif
#pragma unroll
            for (int j = 0; j < 4; ++j) { const unsigned long long w = xr[64 * j]; const f32x4 gq = gr[64 * j]; const unsigned lo = (unsigned)w, hi = (unsigned)(w >> 32);
                const f32x4 v = (f32x4){__uint_as_float(lo << 16), __uint_as_float(lo & 0xffff0000u), __uint_as_float(hi << 16), __uint_as_float(hi & 0xffff0000u)};
                orow[64 * j] = v * gq * r; }
        }
    }
#undef IN
#undef SEAM
}
extern "C" void kernel_launch(void* const* d_in, const int* in_sizes, int n_in, void* d_out, int out_size, void* d_ws, size_t ws_size, hipStream_t stream) {
    using namespace cfg;
    if (n_in != 34 || out_size != M * D || ws_size < wsl::END) { fprintf(stderr, "kernel_launch: built for 34 inputs, %d outputs, >= %zu bytes of workspace; got n_in %d out %d ws %zu; nothing launched\n", M * D, (size_t)wsl::END, n_in, out_size, ws_size); return; }
    static int grid = 0;
    if (grid == 0) {
        int dev = 0, cus = 0, per_cu = 0;
        if (hipGetDevice(&dev) != hipSuccess || hipDeviceGetAttribute(&cus, hipDeviceAttributeMultiprocessorCount, dev) != hipSuccess) { fprintf(stderr, "kernel_launch: device query failed; nothing launched\n"); grid = -1; return; }
        if (hipFuncSetAttribute((const void*)mk_fwd, hipFuncAttributeMaxDynamicSharedMemorySize, LDS_BYTES) != hipSuccess) { fprintf(stderr, "kernel_launch: hipFuncSetAttribute(%d B dynamic LDS) failed; nothing launched\n", LDS_BYTES); grid = -1; return; }
        if (hipOccupancyMaxActiveBlocksPerMultiprocessor(&per_cu, (const void*)mk_fwd, NWAVES * 64, LDS_BYTES) != hipSuccess || per_cu < 1) { fprintf(stderr, "kernel_launch: the occupancy query reports %d workgroups per CU for %d threads + %d B LDS; nothing launched\n", per_cu, NWAVES * 64, LDS_BYTES); (void)hipGetLastError(); grid = -1; return; }
        grid = cus;
    }
    if (grid < 0) return;
    (void)hipMemsetAsync((unsigned char*)d_ws + wsl::CTL, 0, wsl::CTL_BYTES, stream);
    Args a{};
    for (int i = 0; i < 34; ++i) a.in[i] = (const float*)d_in[i];
    a.out = (float*)d_out; a.ws = (unsigned char*)d_ws; a.ph_lo = 0; a.ph_hi = NPHASE;
    int feat = F_ALL; void* kargs[] = {&a, &feat};
    const hipError_t e = hipLaunchCooperativeKernel((const void*)mk_fwd, dim3(grid), dim3(NWAVES * 64), kargs, LDS_BYTES, stream);
    if (e != hipSuccess) fprintf(stderr, "kernel_launch: cooperative launch failed: %s (grid %d x %d threads, %d B LDS)\n", hipGetErrorString(e), grid, NWAVES * 64, LDS_BYTES);
}
```

```cpp
#include <hip/hip_runtime.h>
#include <cstdio>
#include <cstdint>
#include <cmath>

namespace cfg {
constexpr int BATCH = 8, T = 4096, D = 1024, M = BATCH * T, FF = 2816, INC = 1816, INC_PAD = 2048;
constexpr int NH = 8, NKV = 2, HD = 64, NC = 255, NB = 64, SEL_TOPK = 16, WINDOW = 512, CMP_LEN = 32;
constexpr int SGRP = 32, SCH = 16, SST = 64;
constexpr int LCH = 16, NCHUNK = T / LCH;
constexpr float EPS = 1e-6f;
constexpr float C2 = 0.125f * 1.4426950408889634f;
constexpr int MIXP = 1024;
constexpr size_t KVPART = (size_t)BATCH * NKV * T * HD;
}
typedef unsigned short bf16_t;

__device__ __forceinline__ float bf2f(bf16_t v) { return __uint_as_float(((unsigned)v) << 16); }
__device__ __forceinline__ unsigned f2bf_u(float f) { unsigned u = __float_as_uint(f); return (u + 0x7fffu + ((u >> 16) & 1u)) >> 16; }
__device__ __forceinline__ bf16_t f2bf(float f) { return (bf16_t)f2bf_u(f); }
__device__ __forceinline__ unsigned pk2(float lo, float hi) { return f2bf_u(lo) | (f2bf_u(hi) << 16); }
__device__ __forceinline__ float gelu_tanh(float x) { const float u = 0.7978845608028654f * (x + 0.044715f * x * x * x); return 0.5f * x * (1.f + tanhf(u)); }

__device__ __forceinline__ int lane_id() { int r; asm volatile("v_mbcnt_lo_u32_b32 %0, -1, 0\n\tv_mbcnt_hi_u32_b32 %0, -1, %0" : "=v"(r)); return r; }

struct MixBufs { bf16_t* Q; bf16_t* KV; float* GATES; bf16_t* UX; const float* gate_bias; };
namespace wsl {
constexpr size_t MiB = 1u << 20;
constexpr size_t CTL = 0, CTL_BYTES = 1 * MiB;
constexpr size_t W1A = 1 * MiB;
constexpr size_t W1D = 12 * MiB;
constexpr size_t W2A = 18 * MiB;
constexpr size_t W2D = 29 * MiB;
constexpr size_t WIN = 35 * MiB;
constexpr size_t WOUT = 39 * MiB;
constexpr size_t CW1K = 41 * MiB;
constexpr size_t CW1V = 42 * MiB;
constexpr size_t GLUW = 43 * MiB;
constexpr size_t CW2K = 43 * MiB + 512 * 1024;
constexpr size_t CW2V = CW2K + 64 * 1024;
constexpr size_t CB1K = CW2V + 64 * 1024;
constexpr size_t CB1V = CB1K + 4096;
constexpr size_t BTS = 44 * MiB;
constexpr size_t BTY = 48 * MiB;
constexpr size_t S5A = 54 * MiB;
constexpr size_t XB = 56 * MiB;
constexpr size_t H = 120 * MiB;
constexpr size_t Q = 120 * MiB;
constexpr size_t KV = 152 * MiB;
constexpr size_t UX = 200 * MiB;
constexpr size_t S = 248 * MiB;
constexpr size_t HIDK = 280 * MiB, HIDV = 282 * MiB;
constexpr size_t KC = 284 * MiB, VC = 284 * MiB + 512 * 1024;
constexpr size_t YG = 296 * MiB;
constexpr size_t MIX = 328 * MiB;
constexpr size_t GATES = 392 * MiB;
constexpr size_t SSQ1 = 395 * MiB, SSQ2 = 397 * MiB, SSQ3 = 399 * MiB;
constexpr size_t SSQS = 401 * MiB;
constexpr size_t SSQA = 402 * MiB;
constexpr size_t END = 403 * MiB;
}
#define GAS __attribute__((address_space(1)))
#define LAS __attribute__((address_space(3)))
typedef unsigned v4u __attribute__((ext_vector_type(4)));
typedef float f32x4 __attribute__((ext_vector_type(4)));
typedef short bf16x8 __attribute__((ext_vector_type(8)));
typedef GAS unsigned gu32;
typedef GAS unsigned long long gu64;
#define RLX_AGENT __ATOMIC_RELAXED, __HIP_MEMORY_SCOPE_AGENT
#define LDS_WAIT() asm volatile("s_waitcnt lgkmcnt(0)" ::: "memory")
#define VM_WAIT() asm volatile("s_waitcnt vmcnt(0)" ::: "memory")
__device__ __forceinline__ unsigned long long rt() { return __builtin_amdgcn_s_memrealtime(); }
#define XB_TMO      128
#define XB_XCNT(j)  (256  + 64 * (j))
#define XB_XSUB(j)  (1280 + 64 * (j))
#define XB_XGEN(j)  (2304 + 64 * (j))
#define XB_TOP      3328
#define XB_TOPGEN   3392
#define XCD_BAR_WORDS 3456
#define XB_SPIN_CAP (1u << 18)

__device__ __forceinline__ unsigned xb_ld(unsigned* p)              { return __hip_atomic_load(p, __ATOMIC_RELAXED, __HIP_MEMORY_SCOPE_AGENT); }
__device__ __forceinline__ unsigned xb_add(unsigned* p, unsigned v) { return __hip_atomic_fetch_add(p, v, __ATOMIC_RELAXED, __HIP_MEMORY_SCOPE_AGENT); }
__device__ __forceinline__ unsigned xb_xcc_id() { return (unsigned)__builtin_amdgcn_s_getreg((3 << 11) | 20) & 0xFu; }
#define XB_SPIN(cond, bar) do { unsigned _sp = 0; while (cond) { __builtin_amdgcn_s_sleep(1); \
    if ((++_sp & 255u) == 0u) { if (xb_ld(&(bar)[XB_TMO])) break; if (_sp > XB_SPIN_CAP) { atomicAdd(&(bar)[XB_TMO], 1u); break; } } } } while (0)

struct XcdBarrier {
    unsigned* bar; unsigned x; unsigned w0;
    volatile LAS unsigned* st;
};

__device__ __forceinline__ XcdBarrier xcd_barrier_post(unsigned* bar, volatile LAS unsigned* st) {
    XcdBarrier b; b.bar = bar; b.x = xb_xcc_id(); b.st = st; b.w0 = (__builtin_amdgcn_readfirstlane(threadIdx.x) < 64u) ? 1u : 0u;
    if (b.w0 && lane_id() == 0) (void)xb_add(&bar[XB_XCNT(b.x)], 1u);
    return b;
}
__device__ __forceinline__ void xcd_barrier_complete(unsigned* bar, unsigned x, unsigned& nloc, unsigned& nx) {
    const unsigned G = gridDim.x * gridDim.y * gridDim.z;
    unsigned sum, cnt, mine, sp = 0u;
    for (;;) {
        sum = 0u; cnt = 0u; mine = 0u;
#pragma unroll
        for (unsigned j = 0; j < 16; ++j) { const unsigned c = xb_ld(&bar[XB_XCNT(j)]); sum += c; cnt += (c > 0u) ? 1u : 0u; mine = (j == x) ? c : mine; }
        if (sum == G) break;
        __builtin_amdgcn_s_sleep(1);
        if ((++sp & 255u) == 0u) { if (xb_ld(&bar[XB_TMO])) break; if (sp > XB_SPIN_CAP) { atomicAdd(&bar[XB_TMO], 1u); break; } }
    }
    nloc = mine > 0u ? mine : 1u; nx = cnt > 0u ? cnt : 1u;
}

__device__ __forceinline__ void xcd_barrier(const XcdBarrier& b) {
    asm volatile("s_waitcnt vmcnt(0)" ::: "memory");
    __syncthreads();
    if (b.w0 && lane_id() == 0) {
        unsigned* bar = b.bar;
        __builtin_amdgcn_s_waitcnt(0);
        unsigned nloc = b.st[0], nx = b.st[1];
        if (nloc == 0u) { xcd_barrier_complete(bar, b.x, nloc, nx); b.st[0] = nloc; b.st[1] = nx; }
        const unsigned old = xb_add(&bar[XB_XSUB(b.x)], 1u);
        const unsigned gen = old / nloc;
        if (old + 1u == (gen + 1u) * nloc) {
            __builtin_amdgcn_fence(__ATOMIC_RELEASE, "agent");
            asm volatile("s_waitcnt vmcnt(0)" ::: "memory");
            const unsigned og = xb_add(&bar[XB_TOP], 1u);
            const unsigned tg = og / nx;
            if (og + 1u == (tg + 1u) * nx) xb_add(&bar[XB_TOPGEN], 1u);
            else XB_SPIN(xb_ld(&bar[XB_TOPGEN]) == tg, bar);
            __builtin_amdgcn_fence(__ATOMIC_ACQUIRE, "agent");
            xb_add(&bar[XB_XGEN(b.x)], 1u);
            asm volatile("s_waitcnt vmcnt(0)" ::: "memory");
        } else {
            XB_SPIN(xb_ld(&bar[XB_XGEN(b.x)]) == gen, bar);
            __builtin_amdgcn_fence(__ATOMIC_ACQUIRE, "agent");
            asm volatile("s_waitcnt vmcnt(0)" ::: "memory");
        }
    }
    __syncthreads();
}
namespace pg8 {
#define PG8_LAS __attribute__((address_space(3)))
typedef unsigned short bf16_t;
typedef short bf16x8 __attribute__((ext_vector_type(8)));
typedef float f32x4 __attribute__((ext_vector_type(4)));
typedef unsigned u32x4 __attribute__((ext_vector_type(4)));
constexpr int BM = 256, BK = 64, HALF = 128, HTB = HALF * BK * 2  , STAGE_BYTES = 8 * HTB, NXCD = 8, WGM = 8;

__host__ __device__ __forceinline__ int lds_byte(int r, int c) { const int st = (r >> 4) * 2 + (c >> 5), rr = r & 15, cc = c & 31, ob = rr * 64 + cc * 2; return st * 1024 + (ob ^ (((ob >> 9) & 1) << 5)); }
__host__ __device__ __forceinline__ void stage_rc(int b, int& R, int& C) { const int st = b / 1024, sb = b % 1024, swz = sb ^ (((sb >> 9) & 1) << 5); R = (st >> 1) * 16 + swz / 64; C = (st & 1) * 32 + (swz % 64) / 2; }
__host__ __device__ __forceinline__ int perm32(int rho) { const int n = rho >> 4, i = rho & 15; return 8 * (i >> 2) + 4 * n + (i & 3); }

struct Unit { int pm, pn; };
struct Gemm { const bf16_t* A; const bf16_t* Bt; int M, N, K, lda, ldb, bdiv, kslice; };

struct OneUnit {
    int pm, pn;
    __host__ __device__ bool next(int i, Unit& u) const { if (i) return false; u.pm = pm; u.pn = pn; return true; }
    __device__ __forceinline__ void a_ready(const Unit&) const {}
    __device__ __forceinline__ void done(const Unit&) const {}
};
struct StaticOrder {
    int nM, nN, nwg, G, c, rev = 0;
    __host__ __device__ void init(int M, int N, int G_, int c_) { nM = M / BM; nN = N / BM; nwg = nM * nN; G = G_; c = c_; }
    __host__ __device__ bool next(int i, Unit& u) const {
        const long L = (long)i * G + c; if (L >= nwg) return false;
        int wgid = (int)L; { const int q = nwg / NXCD, r = nwg % NXCD, xcd = wgid % NXCD, off = wgid / NXCD; wgid = (xcd < r ? xcd * (q + 1) : r * (q + 1) + (xcd - r) * q) + off; }
        const int nig = WGM * nN, gid = wgid / nig, fm = gid * WGM, gsz = (nM - fm) < WGM ? (nM - fm) : WGM;
        u.pm = fm + ((wgid % nig) % gsz); u.pn = (wgid % nig) / gsz; if (rev) u.pm = nM - 1 - u.pm; return true;
    }
    __device__ __forceinline__ void a_ready(const Unit&) const {}
    __device__ __forceinline__ void done(const Unit&) const {}
};


template <class Epi, class Sched, bool ALIGN_EPI = false, bool SP2 = false>
__device__ __forceinline__ void gemm_phase(PG8_LAS unsigned char* lds, const Gemm g, const Sched& S, const Epi& E, const int wid) {
    const int lane = lane_id(), tid = wid * 64 + lane, wr = wid >> 2, wc = wid & 3, fr = lane & 15, fq = lane >> 4;
    int nt = g.K / BK; asm volatile("" : "+s"(nt));
    unsigned voffA[2], voffB[2];
#pragma unroll
    for (int i = 0; i < 2; ++i) { int R, C; stage_rc(tid * 16 + i * 8192, R, C); const int Rb = Epi::PERM ? ((R & ~31) + perm32(R & 31)) : R;
        voffA[i] = (unsigned)(R * g.lda + C) * 2u; voffB[i] = (unsigned)(Rb * g.ldb + C) * 2u; }
    const size_t kstep = (size_t)(BK * 2);
    const size_t hstepA = (size_t)HALF * g.lda * 2, hstepB = (size_t)HALF * g.ldb * 2;
    const size_t tstepA = 2 * hstepA, tstepB = 2 * hstepB;
#define PG8_BT(u) ((size_t)(g.kslice > 0 ? 0 : (g.bdiv > 0 ? (u).pm / g.bdiv : (u).pn)))
#define PG8_KO(u) ((size_t)(g.kslice > 0 ? (u).pn * g.kslice * 2 : 0))
    const unsigned ldsw = (unsigned)wid * 1024u;
    const int aoff = lds_byte(wr * 64 + fr, fq * 8), boff = lds_byte(wc * 32 + fr, fq * 8);
#define PG8_SA(b, h) (((b) * 2 + (h)) * HTB)
#define PG8_SB(b, h) ((4 + (b) * 2 + (h)) * HTB)
#define PG8_STAGE(bufoff, gbase, voff) do { _Pragma("unroll") for (int _i = 0; _i < 2; ++_i) \
        __builtin_amdgcn_global_load_lds((const unsigned*)((const char*)(gbase) + (voff)[_i]), (PG8_LAS unsigned*)(lds + (bufoff) + ldsw + _i * 8192), 16, 0, 0); } while (0)
#define PG8_LDA(dst, b, h) do { _Pragma("unroll") for (int m = 0; m < 4; ++m) _Pragma("unroll") for (int k = 0; k < 2; ++k) dst[m][k] = *(const PG8_LAS bf16x8*)(lds + PG8_SA(b, h) + aoff + m * 2048 + k * 1024); } while (0)
#define PG8_LDB(dst, b, h) do { _Pragma("unroll") for (int n = 0; n < 2; ++n) _Pragma("unroll") for (int k = 0; k < 2; ++k) dst[n][k] = *(const PG8_LAS bf16x8*)(lds + PG8_SB(b, h) + boff + n * 2048 + k * 1024); } while (0)
#define PG8_MMA(ai, bj, At, Bt) do { __builtin_amdgcn_s_setprio(1); _Pragma("unroll") for (int m = 0; m < 4; ++m) _Pragma("unroll") for (int n = 0; n < 2; ++n) _Pragma("unroll") for (int k = 0; k < 2; ++k) \
        acc[ai][bj][m][n] = __builtin_amdgcn_mfma_f32_16x16x32_bf16(Bt[n][k], At[m][k], acc[ai][bj][m][n], 0, 0, 0); __builtin_amdgcn_s_setprio(0); } while (0)
#define PG8_WAIT_V(n) asm volatile("s_waitcnt vmcnt(" #n ")" ::: "memory")
#define PG8_WAIT_L(n) asm volatile("s_waitcnt lgkmcnt(" #n ")" ::: "memory")
#define PG8_BAR __builtin_amdgcn_s_barrier()
#define PG8_SCHED __builtin_amdgcn_sched_barrier(0)
    Unit cur, nxt; int ui = 0;
    if (!S.next(0, cur)) return;
    f32x4 acc[2][2][4][2];
    typename Epi::Pre pre;
    if constexpr (Epi::HAS_PRE) E.prefetch(pre, cur, wr, fr);
    if constexpr (Epi::HAS_INIT) E.init(acc, cur, wr, wc, fr, fq);
    else {
#pragma unroll
    for (int a = 0; a < 2; ++a)
#pragma unroll
        for (int b = 0; b < 2; ++b)
#pragma unroll
            for (int m = 0; m < 4; ++m)
#pragma unroll
                for (int n = 0; n < 2; ++n) acc[a][b][m][n] = (f32x4){0.f, 0.f, 0.f, 0.f};
    }
    bf16x8 At[4][2], B0[2][2], B1[2][2];
    const char* cA = (const char*)g.A + (size_t)cur.pm * tstepA + PG8_KO(cur); const char* cB = (const char*)g.Bt + PG8_BT(cur) * tstepB + PG8_KO(cur);
    S.a_ready(cur);
    if constexpr (SP2) {
        PG8_STAGE(PG8_SB(0, 0), cB, voffB); PG8_STAGE(PG8_SB(0, 1), cB + hstepB, voffB); PG8_STAGE(PG8_SA(0, 0), cA, voffA); PG8_STAGE(PG8_SA(0, 1), cA + hstepA, voffA);
        if (wr == 1) PG8_BAR;
        PG8_WAIT_V(2); PG8_BAR;
        PG8_STAGE(PG8_SB(1, 0), cB + kstep, voffB); PG8_STAGE(PG8_SA(1, 0), cA + kstep, voffA); PG8_STAGE(PG8_SB(1, 1), cB + hstepB + kstep, voffB);
        PG8_WAIT_V(6); PG8_BAR;
    } else {
        PG8_STAGE(PG8_SB(0, 0), cB, voffB); PG8_STAGE(PG8_SA(0, 0), cA, voffA); PG8_STAGE(PG8_SB(0, 1), cB + hstepB, voffB); PG8_STAGE(PG8_SA(0, 1), cA + hstepA, voffA);
        if (wr == 1) PG8_BAR;
        PG8_WAIT_V(4); PG8_BAR;
        PG8_STAGE(PG8_SB(1, 0), cB + kstep, voffB); PG8_STAGE(PG8_SA(1, 0), cA + kstep, voffA); PG8_STAGE(PG8_SB(1, 1), cB + hstepB + kstep, voffB);
        PG8_WAIT_V(6); PG8_BAR;
    }
    for (;;) {
        const bool has_next = S.next(ui + 1, nxt);
        const char* nA = has_next ? (const char*)g.A + (size_t)nxt.pm * tstepA + PG8_KO(nxt) : cA; const char* nB = has_next ? (const char*)g.Bt + PG8_BT(nxt) * tstepB + PG8_KO(nxt) : cB;
        for (int t = 0; t < nt; t += 2) {
            const bool last = (t == nt - 2);
            if constexpr (Epi::MIDK) { if (t == (nt >> 1)) E.midk(acc, cur, wr, fr); }
            const char* a1 = cA + (size_t)(t + 1) * kstep;
            const char* a2 = last ? nA : cA + (size_t)(t + 2) * kstep; const char* b2 = last ? nB : cB + (size_t)(t + 2) * kstep;
            const char* a3 = a2 + kstep; const char* b3 = b2 + kstep;
            if (last && has_next) S.a_ready(nxt);
            if constexpr (SP2) {
            PG8_LDB(B0, 0, 0); PG8_LDB(B1, 0, 1); PG8_SCHED; PG8_LDA(At, 0, 0); PG8_STAGE(PG8_SA(1, 1), a1 + hstepA, voffA);
            PG8_WAIT_V(8); PG8_WAIT_L(0); PG8_BAR; PG8_MMA(0, 0, At, B0); PG8_MMA(0, 1, At, B1); PG8_BAR; PG8_SCHED;
            PG8_LDA(At, 0, 1); PG8_STAGE(PG8_SB(0, 0), b2, voffB); PG8_STAGE(PG8_SB(0, 1), b2 + hstepB, voffB); PG8_STAGE(PG8_SA(0, 0), a2, voffA);
            PG8_WAIT_V(8); PG8_WAIT_L(0); PG8_BAR; PG8_MMA(1, 0, At, B0); PG8_MMA(1, 1, At, B1); PG8_BAR; PG8_SCHED;
            PG8_LDB(B0, 1, 0); PG8_LDB(B1, 1, 1); PG8_SCHED; PG8_LDA(At, 1, 0); PG8_STAGE(PG8_SA(0, 1), a2 + hstepA, voffA);
            PG8_WAIT_V(8); PG8_WAIT_L(0); PG8_BAR; PG8_MMA(0, 0, At, B0); PG8_MMA(0, 1, At, B1); PG8_BAR; PG8_SCHED;
            PG8_LDA(At, 1, 1); PG8_STAGE(PG8_SB(1, 0), b3, voffB); PG8_STAGE(PG8_SB(1, 1), b3 + hstepB, voffB); PG8_STAGE(PG8_SA(1, 0), a3, voffA);
            PG8_WAIT_V(8); PG8_WAIT_L(0); PG8_BAR; PG8_MMA(1, 0, At, B0); PG8_MMA(1, 1, At, B1); PG8_BAR; PG8_SCHED;
            } else {
            PG8_LDB(B0, 0, 0); PG8_SCHED; PG8_LDA(At, 0, 0); PG8_STAGE(PG8_SA(1, 1), a1 + hstepA, voffA);
            PG8_WAIT_L(8); PG8_BAR; PG8_WAIT_L(0); PG8_MMA(0, 0, At, B0); PG8_BAR; PG8_SCHED;
            PG8_LDB(B1, 0, 1); PG8_STAGE(PG8_SB(0, 0), b2, voffB);
            PG8_BAR; PG8_WAIT_L(0); PG8_MMA(0, 1, At, B1); PG8_BAR;
            PG8_LDA(At, 0, 1); PG8_STAGE(PG8_SA(0, 0), a2, voffA);
            PG8_BAR; PG8_WAIT_L(0); PG8_MMA(1, 0, At, B0); PG8_BAR; PG8_SCHED;
            PG8_STAGE(PG8_SB(0, 1), b2 + hstepB, voffB);
            PG8_WAIT_V(6); PG8_BAR; PG8_MMA(1, 1, At, B1); PG8_BAR;
            PG8_LDB(B0, 1, 0); PG8_SCHED; PG8_LDA(At, 1, 0); PG8_STAGE(PG8_SA(0, 1), a2 + hstepA, voffA);
            PG8_WAIT_L(8); PG8_BAR; PG8_WAIT_L(0); PG8_MMA(0, 0, At, B0); PG8_BAR; PG8_SCHED;
            PG8_LDB(B1, 1, 1); PG8_STAGE(PG8_SB(1, 0), b3, voffB);
            PG8_BAR; PG8_WAIT_L(0); PG8_MMA(0, 1, At, B1); PG8_BAR;
            PG8_LDA(At, 1, 1); PG8_STAGE(PG8_SA(1, 0), a3, voffA);
            PG8_BAR; PG8_WAIT_L(0); PG8_MMA(1, 0, At, B0); PG8_BAR; PG8_SCHED;
            PG8_STAGE(PG8_SB(1, 1), b3 + hstepB, voffB);
            PG8_WAIT_V(6); PG8_BAR; PG8_MMA(1, 1, At, B1); PG8_BAR;
            }
        }
        if constexpr (ALIGN_EPI) { if (wr == 0) PG8_BAR; }
        if constexpr (!Epi::AFTER_DRAIN) { if constexpr (Epi::HAS_PRE) E(acc, cur, wr, wc, fr, fq, pre); else E(acc, cur, wr, wc, fr, fq); S.done(cur); }
        if (!has_next) break;
        if constexpr (Epi::HAS_PRE) E.prefetch(pre, nxt, wr, fr);
        if constexpr (Epi::HAS_INIT) E.init(acc, nxt, wr, wc, fr, fq);
        else {
#pragma unroll
        for (int a = 0; a < 2; ++a)
#pragma unroll
            for (int b = 0; b < 2; ++b)
#pragma unroll
                for (int m = 0; m < 4; ++m)
#pragma unroll
                    for (int n = 0; n < 2; ++n) acc[a][b][m][n] = (f32x4){0.f, 0.f, 0.f, 0.f};
        }
        cur = nxt; cA = nA; cB = nB; ++ui;
        if constexpr (ALIGN_EPI) { if (wr == 1) PG8_BAR; }
    }
    PG8_WAIT_V(0);
    if constexpr (!ALIGN_EPI) { if (wr == 0) PG8_BAR; }
    PG8_BAR;
    if constexpr (Epi::AFTER_DRAIN) { E.fused(acc, cur, wr, wc, fr, fq, lds, wid, lane); S.done(cur); }
#undef PG8_BT
#undef PG8_KO
#undef PG8_SA
#undef PG8_SB
#undef PG8_STAGE
#undef PG8_LDA
#undef PG8_LDB
#undef PG8_MMA
#undef PG8_WAIT_V
#undef PG8_WAIT_L
#undef PG8_BAR
#undef PG8_SCHED
}
}
namespace pg8 {
typedef float f32x2 __attribute__((ext_vector_type(2)));
typedef unsigned u32x2 __attribute__((ext_vector_type(2)));
__device__ __forceinline__ unsigned cvt_pk_bf16(float lo, float hi) { unsigned r; asm volatile("v_cvt_pk_bf16_f32 %0, %1, %2" : "=v"(r) : "v"(lo), "v"(hi)); return r; }
__device__ __forceinline__ u32x4 pack8(const f32x4 a, const f32x4 b) { u32x4 w; w.x = cvt_pk_bf16(a[0], a[1]); w.y = cvt_pk_bf16(a[2], a[3]); w.z = cvt_pk_bf16(b[0], b[1]); w.w = cvt_pk_bf16(b[2], b[3]); return w; }
__device__ __forceinline__ float fast_sigmoid(float x) { return __builtin_amdgcn_rcpf(1.f + __builtin_amdgcn_exp2f(-1.4426950408889634f * x)); }
__device__ __forceinline__ float fast_gelu_tanh(float x) { const float u2 = 1.5957691216057308f * (x + 0.044715f * x * x * x); return x * fast_sigmoid(u2); }
__device__ __forceinline__ float sum16(const float* p) { const f32x4 a = *(const f32x4*)p, b = *(const f32x4*)(p + 4), c = *(const f32x4*)(p + 8), d = *(const f32x4*)(p + 12);
    return ((a[0] + a[1]) + (a[2] + a[3])) + ((b[0] + b[1]) + (b[2] + b[3])) + ((c[0] + c[1]) + (c[2] + c[3])) + ((d[0] + d[1]) + (d[2] + d[3])); }
__device__ __forceinline__ float sum8(const float* p) { const f32x4 a = *(const f32x4*)p, b = *(const f32x4*)(p + 4); return ((a[0] + a[1]) + (a[2] + a[3])) + ((b[0] + b[1]) + (b[2] + b[3])); }
__device__ __forceinline__ float dot4(const f32x4 x) { return (x[0] * x[0] + x[1] * x[1]) + (x[2] * x[2] + x[3] * x[3]); }

struct RowScaleTable {
    const PG8_LAS float* tab; int pmA, pmB; const float* ssq;
    __device__ __forceinline__ float get(int pm, int row) const {
        if (pm == pmA) return tab[row & 255];
        if (pm == pmB) return tab[256 + (row & 255)];
        return __builtin_amdgcn_rsqf(sum16(ssq + (size_t)row * 16) * (1.f / cfg::D) + cfg::EPS);
    }
};
template <class Sched> __device__ __forceinline__ RowScaleTable make_row_scale_table(PG8_LAS float* tab, const float* ssq, const Sched& S, int tid) {
    RowScaleTable T; T.tab = tab; T.ssq = ssq; T.pmA = -1; T.pmB = -1;
    Unit u;
    for (int i = 0; S.next(i, u); ++i) { if (T.pmA < 0) T.pmA = u.pm; else if (u.pm != T.pmA && T.pmB < 0) T.pmB = u.pm; }
    const int pm = (tid < 256) ? T.pmA : T.pmB;
    if (pm >= 0) { const int row = pm * 256 + (tid & 255); tab[tid] = __builtin_amdgcn_rsqf(sum16(ssq + (size_t)row * 16) * (1.f / cfg::D) + cfg::EPS); }
    __syncthreads();
    return T;
}
struct EpiSwiGLU {
    static constexpr bool PERM = true, AFTER_DRAIN = false, MIDK = false, HAS_INIT = false, HAS_PRE = false; struct Pre {};
    bf16_t* Hh; bool scaled; RowScaleTable rt;
    __device__ __forceinline__ void operator()(const f32x4 (&acc)[2][2][4][2], const Unit& u, int wr, int wc, int fr, int fq) const {
        const int row0 = u.pm * BM + wr * 64 + fr, hcol = u.pn * 128 + wc * 32 + 8 * fq;
#pragma unroll
        for (int ai = 0; ai < 2; ++ai)
#pragma unroll
            for (int m = 0; m < 4; ++m) {
                const int row = row0 + ai * HALF + m * 16;
                const float rs = scaled ? rt.get(u.pm, row) : 1.f;
                f32x4 h0, h1;
#pragma unroll
                for (int n = 0; n < 2; ++n)
#pragma unroll
                    for (int i = 0; i < 4; i += 2) {
                        const f32x2 g = (f32x2){acc[ai][0][m][n][i], acc[ai][0][m][n][i + 1]} * rs, uu = (f32x2){acc[ai][1][m][n][i], acc[ai][1][m][n][i + 1]} * rs;
                        const f32x2 t = g * (-1.4426950408889634f);
                        f32x2 e; e.x = __builtin_amdgcn_exp2f(t.x); e.y = __builtin_amdgcn_exp2f(t.y);
                        const f32x2 d = e + 1.0f;
                        f32x2 r; r.x = __builtin_amdgcn_rcpf(d.x); r.y = __builtin_amdgcn_rcpf(d.y);
                        const f32x2 h = (g * uu) * r;
                        if (n == 0) { h0[i] = h.x; h0[i + 1] = h.y; } else { h1[i] = h.x; h1[i + 1] = h.y; }
                    }
                *(u32x4*)(Hh + (size_t)row * cfg::FF + hcol) = pack8(h0, h1);
            }
    }
};
template <int MODE> struct EpiResid {
    static constexpr bool PERM = true, AFTER_DRAIN = false, MIDK = (MODE == 1), HAS_INIT = true, HAS_PRE = false; struct Pre {};
    const float* resid32; bf16_t* XBp; float* ssq; const float* ssq_a; const float* ssq_s;
    __device__ __forceinline__ float rs_of(int row) const { return __builtin_amdgcn_rsqf(sum8(ssq_s + (size_t)row * 8) * (1.f / 512) + cfg::EPS); }
    __device__ __forceinline__ void midk(f32x4 (&acc)[2][2][4][2], const Unit& u, int wr, int fr) const {
        const int row0 = u.pm * BM + wr * 64 + fr;
#pragma unroll
        for (int ai = 0; ai < 2; ++ai)
#pragma unroll
            for (int m = 0; m < 4; ++m) {
                int row = row0 + ai * HALF + m * 16; asm volatile("" : "+v"(row));
                const f32x2 sa = *(const f32x2*)(ssq_a + (size_t)row * 2);
                const float ra = __builtin_amdgcn_rsqf((sa[0] + sa[1]) * (1.f / 512) + cfg::EPS);
                const float rho = ra * __builtin_amdgcn_rcpf(rs_of(row));
#pragma unroll
                for (int bj = 0; bj < 2; ++bj)
#pragma unroll
                    for (int n = 0; n < 2; ++n) acc[ai][bj][m][n] = acc[ai][bj][m][n] * rho;
            }
    }
    __device__ __forceinline__ void init(f32x4 (&acc)[2][2][4][2], const Unit& u, int wr, int wc, int fr, int fq) const {
        const int row0 = u.pm * BM + wr * 64 + fr, col0 = u.pn * BM + wc * 32 + 8 * fq;
#pragma unroll
        for (int ai = 0; ai < 2; ++ai)
#pragma unroll
            for (int m = 0; m < 4; ++m) {
                const int row = row0 + ai * HALF + m * 16;
                float s0 = 2.f;
                if (MODE == 1) { const f32x2 sa = *(const f32x2*)(ssq_a + (size_t)row * 2); s0 = __builtin_amdgcn_sqrtf((sa[0] + sa[1]) * (1.f / 512) + cfg::EPS); }
#pragma unroll
                for (int bj = 0; bj < 2; ++bj) {
                    const size_t off = (size_t)row * cfg::D + col0 + bj * HALF;
                    if (MODE == 0) { acc[ai][bj][m][0] = *(const f32x4*)(resid32 + off) * s0; acc[ai][bj][m][1] = *(const f32x4*)(resid32 + off + 4) * s0; }
                    else { const u32x4 w = *(const u32x4*)(XBp + off);
                        acc[ai][bj][m][0] = (f32x4){__uint_as_float(w.x << 16), __uint_as_float(w.x & 0xffff0000u), __uint_as_float(w.y << 16), __uint_as_float(w.y & 0xffff0000u)} * s0;
                        acc[ai][bj][m][1] = (f32x4){__uint_as_float(w.z << 16), __uint_as_float(w.z & 0xffff0000u), __uint_as_float(w.w << 16), __uint_as_float(w.w & 0xffff0000u)} * s0; }
                }
            }
    }
    __device__ __forceinline__ void operator()(const f32x4 (&acc)[2][2][4][2], const Unit& u, int wr, int wc, int fr, int fq) const {
        const int row0 = u.pm * BM + wr * 64 + fr, col0 = u.pn * BM + wc * 32 + 8 * fq;
#pragma unroll
        for (int ai = 0; ai < 2; ++ai)
#pragma unroll
            for (int m = 0; m < 4; ++m) {
                int row = row0 + ai * HALF + m * 16; if (MODE == 1) asm volatile("" : "+v"(row));
                const float sc = MODE == 1 ? rs_of(row) : 0.5f;
                float sq = 0.f;
#pragma unroll
                for (int bj = 0; bj < 2; ++bj) {
                    const f32x4 x0 = acc[ai][bj][m][0] * sc, x1 = acc[ai][bj][m][1] * sc;
                    sq += dot4(x0) + dot4(x1);
                    *(u32x4*)(XBp + (size_t)row * cfg::D + col0 + bj * HALF) = pack8(x0, x1);
                }
                sq += __shfl_xor(sq, 16); sq += __shfl_xor(sq, 32);
                if (fq == 0) ssq[(size_t)row * 16 + u.pn * 4 + wc] = sq;
            }
    }
};
struct EpiWin {
    static constexpr bool PERM = true, AFTER_DRAIN = false, MIDK = false, HAS_INIT = false, HAS_PRE = false; struct Pre {};
    MixBufs mb; RowScaleTable rt;
    __device__ __forceinline__ void operator()(const f32x4 (&acc)[2][2][4][2], const Unit& u, int wr, int wc, int fr, int fq) const {
        using namespace cfg;
        const int row0 = u.pm * BM + wr * 64 + fr, colb = u.pn * BM + wc * 32 + 8 * fq;
#pragma unroll
        for (int ai = 0; ai < 2; ++ai)
#pragma unroll
            for (int m = 0; m < 4; ++m) {
                const int row = row0 + ai * HALF + m * 16, b = row >> 12, t = row & (T - 1);
                const float rs = rt.get(u.pm, row);
#pragma unroll
                for (int bj = 0; bj < 2; ++bj) {
                    const int col = colb + bj * HALF;
                    f32x4 v0 = acc[ai][bj][m][0] * rs, v1 = acc[ai][bj][m][1] * rs;
                    if (col < 512) { const int h = col >> 6, d = col & 63; *(u32x4*)(mb.Q + (((size_t)(b * NH + h)) * T + t) * 64 + d) = pack8(v0 * C2, v1 * C2); }
                    else if (col < 1280) { const int c = col - 512, part = c >> 7, g = (c >> 6) & 1, d = c & 63; *(u32x4*)(mb.KV + (size_t)part * KVPART + (((size_t)(b * 2 + g)) * T + t) * 64 + d) = pack8(v0, v1); }
                    else if (col < 1304) { const int c = col - 1280; const f32x4 b0 = *(const f32x4*)(mb.gate_bias + c), b1 = *(const f32x4*)(mb.gate_bias + c + 4);
#pragma unroll
                        for (int i = 0; i < 4; ++i) { v0[i] = fast_sigmoid(v0[i] + b0[i]); v1[i] = fast_sigmoid(v1[i] + b1[i]); }
                        *(f32x4*)(mb.GATES + (size_t)row * 24 + c) = v0; *(f32x4*)(mb.GATES + (size_t)row * 24 + c + 4) = v1; }
                    else if (col < INC) { const int c = col - 1304, g = c >> 4, h = c & 15; *(u32x4*)(mb.UX + ((size_t)(g * 2048 + b * 256 + (t >> 4))) * 384 + (t & 15) * 16 + h) = pack8(v0, v1); }
                }
            }
    }
};
struct EpiPart {
    static constexpr bool PERM = false, AFTER_DRAIN = false, MIDK = false, HAS_INIT = false, HAS_PRE = false; struct Pre {};
    float* PART;
    __device__ __forceinline__ void operator()(const f32x4 (&acc)[2][2][4][2], const Unit& u, int wr, int wc, int fr, int fq) const {
        const int row0 = u.pm * BM + wr * 64 + fr, col0 = wc * 32 + 4 * fq; float* P = PART + (size_t)u.pn * 4096 * 256;
#pragma unroll
        for (int ai = 0; ai < 2; ++ai)
#pragma unroll
            for (int m = 0; m < 4; ++m)
#pragma unroll
                for (int bj = 0; bj < 2; ++bj)
#pragma unroll
                    for (int n = 0; n < 2; ++n) *(f32x4*)(P + (size_t)(row0 + ai * HALF + m * 16) * 256 + col0 + bj * HALF + n * 16) = acc[ai][bj][m][n];
    }
};
struct EpiS5S {
    static constexpr bool PERM = false, AFTER_DRAIN = false, MIDK = false, HAS_INIT = false, HAS_PRE = false; struct Pre {};
    float* S;
    __device__ __forceinline__ void operator()(const f32x4 (&acc)[2][2][4][2], const Unit& u, int wr, int wc, int fr, int fq) const {
        const int row0 = u.pm * BM + wr * 64 + fr, col0 = wc * 32 + 4 * fq;
#pragma unroll
        for (int ai = 0; ai < 2; ++ai)
#pragma unroll
            for (int m = 0; m < 4; ++m)
#pragma unroll
                for (int n = 0; n < 2; ++n) *(f32x4*)(S + (size_t)(row0 + ai * HALF + m * 16) * 128 + col0 + n * 16) = acc[ai][0][m][n];
    }
};
struct EpiS5Y {
    static constexpr bool PERM = true, AFTER_DRAIN = false, MIDK = false, HAS_INIT = false, HAS_PRE = false; struct Pre {};
    bf16_t* YG;
    __device__ __forceinline__ void operator()(const f32x4 (&acc)[2][2][4][2], const Unit& u, int wr, int wc, int fr, int fq) const {
        const int row0 = u.pm * BM + wr * 64 + fr, colb = wc * 32 + 8 * fq;
#pragma unroll
        for (int ai = 0; ai < 2; ++ai)
#pragma unroll
            for (int m = 0; m < 4; ++m) {
                int R = row0 + ai * HALF + m * 16; asm volatile("" : "+v"(R));
                const int g = R >> 11, rr = R & 2047, b = rr >> 8, c = rr & 255;
#pragma unroll
                for (int bj = 0; bj < 2; ++bj) {
                    const int col = colb + bj * HALF, tl = col >> 4, h = col & 15;
                    f32x4 v0 = acc[ai][bj][m][0], v1 = acc[ai][bj][m][1];
#pragma unroll
                    for (int i = 0; i < 4; ++i) { v0[i] = fast_gelu_tanh(v0[i]); v1[i] = fast_gelu_tanh(v1[i]); }
                    *(u32x4*)(YG + ((size_t)(b * cfg::T + c * 16 + tl)) * 512 + g * 16 + h) = pack8(v0, v1);
                }
                __builtin_amdgcn_sched_barrier(0);
            }
    }
};
struct EpiGLU {
    static constexpr bool PERM = true, AFTER_DRAIN = false, MIDK = false, HAS_INIT = false, HAS_PRE = false; struct Pre {};
    const bf16_t* YG; const float* bias; bf16_t* SSM; float* ssq;
    __device__ __forceinline__ void operator()(const f32x4 (&acc)[2][2][4][2], const Unit& u, int wr, int wc, int fr, int fq) const {
        const int row0 = u.pm * BM + wr * 64 + fr, colb = u.pn * BM + wc * 32 + 8 * fq;
#pragma unroll
        for (int ai = 0; ai < 2; ++ai)
#pragma unroll
            for (int m = 0; m < 4; ++m) {
                const int row = row0 + ai * HALF + m * 16; float sq = 0.f;
#pragma unroll
                for (int bj = 0; bj < 2; ++bj) {
                    const int col = colb + bj * HALF;
                    const f32x4 b0 = *(const f32x4*)(bias + col), b1 = *(const f32x4*)(bias + col + 4);
                    const u32x4 yw = *(const u32x4*)(YG + (size_t)row * 512 + col);
                    f32x4 y0, y1;
                    y0[0] = __uint_as_float(yw.x << 16); y0[1] = __uint_as_float(yw.x & 0xffff0000u); y0[2] = __uint_as_float(yw.y << 16); y0[3] = __uint_as_float(yw.y & 0xffff0000u);
                    y1[0] = __uint_as_float(yw.z << 16); y1[1] = __uint_as_float(yw.z & 0xffff0000u); y1[2] = __uint_as_float(yw.w << 16); y1[3] = __uint_as_float(yw.w & 0xffff0000u);
                    f32x4 v0, v1;
#pragma unroll
                    for (int i = 0; i < 4; ++i) { v0[i] = y0[i] * fast_sigmoid(acc[ai][bj][m][0][i] + b0[i]); v1[i] = y1[i] * fast_sigmoid(acc[ai][bj][m][1][i] + b1[i]); }
                    sq += dot4(v0) + dot4(v1);
                    *(u32x4*)(SSM + (size_t)row * cfg::MIXP + col) = pack8(v0, v1);
                }
                sq += __shfl_xor(sq, 16); sq += __shfl_xor(sq, 32);
                if (fq == 0) ssq[(size_t)row * 8 + u.pn * 4 + wc] = sq;
            }
    }
};
}
constexpr int NWAVES = 8;
constexpr int RING_BYTES = 131072;
constexpr int LDSCTL_OFF = RING_BYTES, MISC_OFF = LDSCTL_OFF + 320;
constexpr int BIAS_OFF = RING_BYTES + 1024;
constexpr int LDS_BYTES = 147456;
constexpr size_t WS_CBP = wsl::S5A + 64 * 1024;

struct Args { const float* in[34]; float* out; unsigned char* ws; int ph_lo, ph_hi; };

struct Frame { LAS unsigned char* lds; int wave, G, gw, NGW; __device__ __forceinline__ int tid() const { return wave * 64 + lane_id(); } };

__device__ __forceinline__ float wave_sum(float v) {
#pragma unroll
    for (int o = 1; o < 64; o <<= 1) v += __shfl_xor(v, o);
    return v;
}
__device__ __forceinline__ void tr_item(const float* __restrict__ W, int N, int Npad, const float* __restrict__ gain, bf16_t* WT, int ldt, int mode, LAS float* scr, int item, int lane) {
    const int nblk = Npad / 32, kb = item / nblk, nb = item % nblk, k0 = 64 * kb, n0 = 32 * nb;
    const int kk8 = lane >> 3, n4 = (lane & 7) * 4; const bool ok = (n0 + n4) < N;
    f32x4 v[8];
#pragma unroll
    for (int i = 0; i < 8; ++i) v[i] = ok ? *(const GAS f32x4*)(W + (size_t)(k0 + 8 * i + kk8) * N + n0 + n4) : (f32x4){0.f, 0.f, 0.f, 0.f};
#pragma unroll
    for (int i = 0; i < 8; ++i) { const int kk = 8 * i + kk8; const float gk = gain ? gain[k0 + kk] : 1.f; LAS float* d = scr + kk * 33 + n4;
        d[0] = v[i].x * gk; d[1] = v[i].y * gk; d[2] = v[i].z * gk; d[3] = v[i].w * gk; }
    LDS_WAIT(); asm volatile("" ::: "memory");
    const int c = lane & 7;
#pragma unroll
    for (int j = 0; j < 4; ++j) { const int nl = (lane >> 3) + 8 * j, n = n0 + nl; const LAS float* s = scr + (8 * c) * 33 + nl;
        const int row = mode == 0 ? n : ((n >> 7) * 256 + (mode == 2 ? 128 : 0) + (n & 127));
        v4u o; o.x = pk2(s[0 * 33], s[1 * 33]); o.y = pk2(s[2 * 33], s[3 * 33]); o.z = pk2(s[4 * 33], s[5 * 33]); o.w = pk2(s[6 * 33], s[7 * 33]);
        *(GAS v4u*)(WT + (size_t)row * ldt + k0 + 8 * c) = o; }
    LDS_WAIT(); asm volatile("" ::: "memory");
}
struct S5P { float xr, xi, fr, fi; };
__device__ __forceinline__ S5P s5_param(const float* const* in, int g, int p) {
    const float dt = expf(in[18][g]), lr = in[16][g * 64 + p], li = in[17][g * 64 + p];
    S5P q; q.xr = lr * dt; q.xi = li * dt;
    const float mag = expf(q.xr), ar = mag * cosf(q.xi), ai = mag * sinf(q.xi), nr = ar - 1.f, den = lr * lr + li * li;
    q.fr = (nr * lr + ai * li) / den; q.fi = (ai * lr - nr * li) / den; return q;
}
__device__ __forceinline__ void cpow(const S5P& q, int n, float& re, float& im) { const float mag = expf(n * q.xr), ang = n * q.xi; re = mag * cosf(ang); im = mag * sinf(ang); }

__device__ __forceinline__ void p0_prologue(Frame& F, const Args& a) {
    using namespace cfg;
    unsigned char* ws = a.ws; const float* const* in = a.in;
    LAS float* scr = (LAS float*)(F.lds + F.wave * 16384);
    const int lane = lane_id();
    bf16_t* BTS = (bf16_t*)(ws + wsl::BTS); bf16_t* BTY = (bf16_t*)(ws + wsl::BTY);
    constexpr int N_KT = SGRP * 31, N_V = SGRP * 16, N_S = SGRP * 16, N_Z = SGRP * 8, N_A = SGRP, N_CB = 2 * 4 * 16;
    constexpr int NS5 = N_KT + N_V + N_S + N_Z + N_A + N_CB;
    for (int it = F.gw; it < NS5; it += F.NGW) {
        int r = it;
        if (r < N_KT) {
            const int g = r / 31, tau = r % 31 - 15; bf16_t* Bg = BTY + (size_t)g * 256 * 384;
            if (tau < 0) {
                for (int t = 0; t <= 15 + tau; ++t) { const int s = t - tau;
#pragma unroll
                    for (int e = 0; e < 4; ++e) { const int idx = lane + 64 * e, h = idx >> 4, h2 = idx & 15; Bg[(size_t)(t * 16 + h) * 384 + s * 16 + h2] = 0; } }
                continue;
            }
            const int p = lane; const S5P q = s5_param(in, g, p); float pr, pi; cpow(q, tau, pr, pi);
            float car[16], cai[16];
#pragma unroll
            for (int h = 0; h < 16; ++h) { const float cr = in[21][(size_t)(g * 16 + h) * 64 + p], ci = in[22][(size_t)(g * 16 + h) * 64 + p]; car[h] = cr * pr - ci * pi; cai[h] = cr * pi + ci * pr; }
            float keep[4] = {0.f, 0.f, 0.f, 0.f};
#pragma unroll 1
            for (int h2 = 0; h2 < 16; ++h2) {
                const float br = in[19][(size_t)(g * 64 + p) * 16 + h2], bi = in[20][(size_t)(g * 64 + p) * 16 + h2];
                const float bbr = q.fr * br - q.fi * bi, bbi = q.fr * bi + q.fi * br;
#pragma unroll
                for (int h = 0; h < 16; ++h) { const float v = wave_sum(car[h] * bbr - cai[h] * bbi); if ((((h & 3) << 4) | h2) == lane) keep[h >> 2] = v; }
            }
#pragma unroll
            for (int e = 0; e < 4; ++e) { const int idx = lane + 64 * e, h = idx >> 4, h2 = idx & 15;
                const float v = keep[e] + ((tau == 0 && h == h2) ? in[23][g * 16 + h] : 0.f); const bf16_t w = f2bf(v);
                for (int t = tau; t < 16; ++t) Bg[(size_t)(t * 16 + h) * 384 + (t - tau) * 16 + h2] = w; }
            continue;
        } r -= N_KT;
        if (r < N_V) {
            const int g = r >> 4, t = r & 15, p = lane; const S5P q = s5_param(in, g, p); float pr, pi; cpow(q, t + 1, pr, pi);
            bf16_t* Bg = BTY + (size_t)g * 256 * 384;
#pragma unroll
            for (int h = 0; h < 16; ++h) { const float cr = in[21][(size_t)(g * 16 + h) * 64 + p], ci = in[22][(size_t)(g * 16 + h) * 64 + p];
                Bg[(size_t)(t * 16 + h) * 384 + 256 + p] = f2bf(cr * pr - ci * pi); Bg[(size_t)(t * 16 + h) * 384 + 320 + p] = f2bf(-(cr * pi + ci * pr)); }
            continue;
        } r -= N_V;
        if (r < N_S) {
            const int g = r >> 4, s = r & 15, p = lane; const S5P q = s5_param(in, g, p); float pr, pi; cpow(q, 15 - s, pr, pi);
            bf16_t* Bg = BTS + (size_t)g * 256 * 256;
#pragma unroll
            for (int h = 0; h < 16; ++h) { const float br = in[19][(size_t)(g * 64 + p) * 16 + h], bi = in[20][(size_t)(g * 64 + p) * 16 + h];
                const float bbr = q.fr * br - q.fi * bi, bbi = q.fr * bi + q.fi * br;
                Bg[(size_t)p * 256 + s * 16 + h] = f2bf(pr * bbr - pi * bbi); Bg[(size_t)(64 + p) * 256 + s * 16 + h] = f2bf(pr * bbi + pi * bbr); }
            continue;
        } r -= N_S;
        if (r < N_Z) {
            const int g = r >> 3, blk = r & 7; GAS v4u* z = (GAS v4u*)(BTS + (size_t)g * 256 * 256 + (size_t)(128 + 16 * blk) * 256);
            for (int i = lane; i < 16 * 256 * 2 / 16; i += 64) z[i] = (v4u){0u, 0u, 0u, 0u};
            continue;
        } r -= N_Z;
        if (r < N_A) { const int g = r, p = lane; const S5P q = s5_param(in, g, p); float pr, pi; cpow(q, LCH, pr, pi); float* A16 = (float*)(ws + wsl::S5A); A16[(g * 64 + p) * 2] = pr; A16[(g * 64 + p) * 2 + 1] = pi; continue; } r -= N_A;
        {
            const int ten = r >> 6, nb = (r >> 4) & 3, ks = r & 15, n = nb * 64 + lane; const float* pos = ten ? in[9] : in[8]; const float* w1 = ten ? in[13] : in[10];
            float acc = 0.f;
            for (int kk = ks * 128; kk < ks * 128 + 128; ++kk) acc += pos[kk] * w1[(size_t)kk * 256 + n];
            ((float*)(ws + WS_CBP))[(ten * 16 + ks) * 256 + n] = acc;
        }
    }
    constexpr int I_GU = 16 * 88, I_DN = 44 * 32, I_WIN = 16 * 64, I_WO = 8 * 32, I_C1 = 32 * 8, I_C2 = 4 * 2, I_GLU = 8 * 16;
    constexpr int NTR = 2 * (2 * I_GU + I_DN) + I_WIN + 2 * I_WO + 2 * I_C1 + 2 * I_C2 + I_GLU;
    for (int it = F.gw; it < NTR; it += F.NGW) {
        int r = it;
        if (r < I_GU) { tr_item(in[2], FF, FF, in[1], (bf16_t*)(ws + wsl::W1A), D, 1, scr, r, lane); continue; } r -= I_GU;
        if (r < I_GU) { tr_item(in[3], FF, FF, in[1], (bf16_t*)(ws + wsl::W1A), D, 2, scr, r, lane); continue; } r -= I_GU;
        if (r < I_DN) { tr_item(in[4], D, D, nullptr, (bf16_t*)(ws + wsl::W1D), FF, 0, scr, r, lane); continue; } r -= I_DN;
        if (r < I_GU) { tr_item(in[30], FF, FF, in[29], (bf16_t*)(ws + wsl::W2A), D, 1, scr, r, lane); continue; } r -= I_GU;
        if (r < I_GU) { tr_item(in[31], FF, FF, in[29], (bf16_t*)(ws + wsl::W2A), D, 2, scr, r, lane); continue; } r -= I_GU;
        if (r < I_DN) { tr_item(in[32], D, D, nullptr, (bf16_t*)(ws + wsl::W2D), FF, 0, scr, r, lane); continue; } r -= I_DN;
        if (r < I_WIN) { tr_item(in[6], INC, INC_PAD, in[5], (bf16_t*)(ws + wsl::WIN), D, 0, scr, r, lane); continue; } r -= I_WIN;
        if (r < I_WO) { tr_item(in[28], D, D, in[26], (bf16_t*)(ws + wsl::WOUT), D, 0, scr, r, lane); continue; } r -= I_WO;
        if (r < I_WO) { tr_item(in[28] + (size_t)512 * D, D, D, in[27], (bf16_t*)(ws + wsl::WOUT) + 512, D, 0, scr, r, lane); continue; } r -= I_WO;
        if (r < I_C1) { tr_item(in[10], 256, 256, nullptr, (bf16_t*)(ws + wsl::CW1K), 2048, 0, scr, r, lane); continue; } r -= I_C1;
        if (r < I_C1) { tr_item(in[13], 256, 256, nullptr, (bf16_t*)(ws + wsl::CW1V), 2048, 0, scr, r, lane); continue; } r -= I_C1;
        if (r < I_C2) { tr_item(in[12], 64, 64, nullptr, (bf16_t*)(ws + wsl::CW2K), 256, 0, scr, r, lane); continue; } r -= I_C2;
        if (r < I_C2) { tr_item(in[15], 64, 64, nullptr, (bf16_t*)(ws + wsl::CW2V), 256, 0, scr, r, lane); continue; } r -= I_C2;
        tr_item(in[24], 512, 512, nullptr, (bf16_t*)(ws + wsl::GLUW), 512, 0, scr, r, lane);
    }
    for (int m = F.gw; m < M; m += 2 * F.NGW) {
        const int m2 = m + F.NGW;
        const GAS f32x4* xr = (const GAS f32x4*)(in[0] + (size_t)m * D) + lane; const GAS f32x4* xr2 = (const GAS f32x4*)(in[0] + (size_t)(m2 < M ? m2 : m) * D) + lane;
        f32x4 v[4], w[4]; float s = 0.f, s2 = 0.f;
#pragma unroll
        for (int j = 0; j < 4; ++j) { v[j] = xr[64 * j]; w[j] = xr2[64 * j]; }
#pragma unroll
        for (int j = 0; j < 4; ++j) { s += (v[j].x * v[j].x + v[j].y * v[j].y) + (v[j].z * v[j].z + v[j].w * v[j].w); s2 += (w[j].x * w[j].x + w[j].y * w[j].y) + (w[j].z * w[j].z + w[j].w * w[j].w); }
        const float r = rsqrtf(wave_sum(s) * (1.f / D) + EPS), r2 = rsqrtf(wave_sum(s2) * (1.f / D) + EPS);
        GAS unsigned long long* o8 = (GAS unsigned long long*)((bf16_t*)(ws + wsl::XB) + (size_t)m * D) + lane;
#pragma unroll
        for (int j = 0; j < 4; ++j) o8[64 * j] = (unsigned long long)pk2(v[j].x * r, v[j].y * r) | ((unsigned long long)pk2(v[j].z * r, v[j].w * r) << 32);
        if (m2 < M) { GAS unsigned long long* p8 = (GAS unsigned long long*)((bf16_t*)(ws + wsl::XB) + (size_t)m2 * D) + lane;
#pragma unroll
            for (int j = 0; j < 4; ++j) p8[64 * j] = (unsigned long long)pk2(w[j].x * r2, w[j].y * r2) | ((unsigned long long)pk2(w[j].z * r2, w[j].w * r2) << 32); }
    }
}
__device__ __forceinline__ void s5_scan_task(const Args& a, int bg, int lane) {
    using namespace cfg;
    const int g = bg & 31, b = bg >> 5, p = lane;
    const float* A16 = (const float*)(a.ws + wsl::S5A); const float ar = A16[(g * 64 + p) * 2], ai = A16[(g * 64 + p) * 2 + 1];
    const float* S = (const float*)(a.ws + wsl::S) + ((size_t)(g * 2048 + b * 256)) * 128; bf16_t* UX = (bf16_t*)(a.ws + wsl::UX) + ((size_t)(g * 2048 + b * 256)) * 384 + 256;
    float xr = 0.f, xi = 0.f;
    for (int c0 = 0; c0 < NCHUNK; c0 += 16) {
        float sr[16], si[16];
#pragma unroll
        for (int j = 0; j < 16; ++j) { sr[j] = S[(size_t)(c0 + j) * 128 + p]; si[j] = S[(size_t)(c0 + j) * 128 + 64 + p]; }
#pragma unroll
        for (int j = 0; j < 16; ++j) {
            UX[(size_t)(c0 + j) * 384 + p] = f2bf(xr); UX[(size_t)(c0 + j) * 384 + 64 + p] = f2bf(xi);
            const float nr = ar * xr - ai * xi + sr[j], ni = ar * xi + ai * xr + si[j]; xr = nr; xi = ni;
        }
    }
}
__device__ __forceinline__ void cmp_out_task(const float* __restrict__ PART, const LAS float* bias, const bf16_t* __restrict__ W2t, bf16_t* OUT, int task, int lane) {
    const int row0 = task * 16, fr = lane & 15, fq = lane >> 4;
    f32x4 acc[4];
#pragma unroll
    for (int nb = 0; nb < 4; ++nb) acc[nb] = (f32x4){0.f, 0.f, 0.f, 0.f};
#pragma unroll 2
    for (int ks = 0; ks < 8; ++ks) {
        const int c0 = ks * 32 + 8 * fq; const float* pp = PART + (size_t)(row0 + fr) * 256 + c0;
        f32x4 h0 = (f32x4){bias[c0], bias[c0 + 1], bias[c0 + 2], bias[c0 + 3]}, h1 = (f32x4){bias[c0 + 4], bias[c0 + 5], bias[c0 + 6], bias[c0 + 7]};
#pragma unroll
        for (int sl = 0; sl < 4; ++sl) { h0 = h0 + *(const f32x4*)(pp + (size_t)sl * 4096 * 256); h1 = h1 + *(const f32x4*)(pp + (size_t)sl * 4096 * 256 + 4); }
#pragma unroll
        for (int i = 0; i < 4; ++i) { h0[i] = pg8::fast_gelu_tanh(h0[i]); h1[i] = pg8::fast_gelu_tanh(h1[i]); }
        const bf16x8 af = __builtin_bit_cast(bf16x8, pg8::pack8(h0, h1));
#pragma unroll
        for (int nb = 0; nb < 4; ++nb) { const bf16x8 bfr = *(const bf16x8*)(W2t + (size_t)(nb * 16 + fr) * 256 + ks * 32 + 8 * fq); acc[nb] = __builtin_amdgcn_mfma_f32_16x16x32_bf16(af, bfr, acc[nb], 0, 0, 0); }
    }
#pragma unroll
    for (int nb = 0; nb < 4; ++nb)
#pragma unroll
        for (int i = 0; i < 4; ++i) OUT[(size_t)(row0 + 4 * fq + i) * 64 + nb * 16 + fr] = f2bf(acc[nb][i]);
}
#define HAVE_FAST_ATTN 1
namespace att {
typedef float f32x16 __attribute__((ext_vector_type(16)));
typedef short v4i16 __attribute__((ext_vector_type(4)));
constexpr int KOFF = 0, VOFF = 16384, IMPP_OFF = 32768, SC_OFF = 98304, MASK_OFF = 114688, SSQP_OFF = 115200;
constexpr float THR = 8.f, MINIT = -1e30f;
__device__ __forceinline__ int crow(int r, int hi) { return (r & 3) + 8 * (r >> 2) + 4 * hi; }
__device__ __forceinline__ f32x16 zero16() { f32x16 z;
#pragma unroll
    for (int i = 0; i < 16; ++i) z[i] = 0.f; return z; }
__device__ __forceinline__ void qk_tile(const LAS unsigned char* Kb, const bf16x8 (&qr)[4], int r32, int hi, f32x16& p0, f32x16& p1) {
    p0 = zero16(); p1 = zero16();
    bf16x8 a0[4], a1[4];
#pragma unroll
    for (int d0 = 0; d0 < 4; ++d0) { const int off = r32 * 128 + (((2 * d0 + hi) ^ ((r32 >> 1) & 7)) << 4); a0[d0] = *(const LAS bf16x8*)(Kb + off); a1[d0] = *(const LAS bf16x8*)(Kb + 4096 + off); }
    __builtin_amdgcn_sched_barrier(0);
#pragma unroll
    for (int d0 = 0; d0 < 4; ++d0) {
        p0 = __builtin_amdgcn_mfma_f32_32x32x16_bf16(a0[d0], qr[d0], p0, 0, 0, 0);
        p1 = __builtin_amdgcn_mfma_f32_32x32x16_bf16(a1[d0], qr[d0], p1, 0, 0, 0);
    }
}
__device__ __forceinline__ bf16x8 pack_p(const f32x16& p, int s) {
    pg8::u32x4 w; w.x = pg8::cvt_pk_bf16(p[8 * s], p[8 * s + 1]); w.y = pg8::cvt_pk_bf16(p[8 * s + 2], p[8 * s + 3]); w.z = pg8::cvt_pk_bf16(p[8 * s + 4], p[8 * s + 5]); w.w = pg8::cvt_pk_bf16(p[8 * s + 6], p[8 * s + 7]);
    return __builtin_bit_cast(bf16x8, w);
}
__device__ __forceinline__ v4i16 vtr(const LAS unsigned char* p) { return __builtin_amdgcn_ds_read_tr16_b64_v4i16((LAS v4i16*)p); }
__device__ __forceinline__ void pv_tile(const LAS unsigned char* Vb, int vl0, const f32x16& p0, const f32x16& p1, f32x16 (&o)[2]) {
    bf16x8 pf[4];
#pragma unroll
    for (int i = 0; i < 4; ++i) pf[i] = pack_p((i >> 1) ? p1 : p0, i & 1);
#pragma unroll
    for (int db = 0; db < 2; ++db) {
        v4i16 lo[4], hi4[4];
#pragma unroll
        for (int i = 0; i < 4; ++i) { const LAS unsigned char* vp = Vb + (vl0 ^ (db * 64)) + (i >> 1) * 4096 + (i & 1) * 2048; lo[i] = vtr(vp); hi4[i] = vtr(vp + 1024); }
        __builtin_amdgcn_sched_barrier(0);
#pragma unroll
        for (int i = 0; i < 4; ++i) { const bf16x8 vf = (bf16x8){lo[i][0], lo[i][1], lo[i][2], lo[i][3], hi4[i][0], hi4[i][1], hi4[i][2], hi4[i][3]};
            o[db] = __builtin_amdgcn_mfma_f32_32x32x16_bf16(vf, pf[i], o[db], 0, 0, 0); }
    }
}
__device__ __forceinline__ float other32(float x, int hi) { const auto rr = __builtin_amdgcn_permlane32_swap(__float_as_uint(x), __float_as_uint(x), false, false); return __uint_as_float(hi ? rr[0] : rr[1]); }
__device__ __forceinline__ unsigned dpp_or8(unsigned x) {
    x |= (unsigned)__builtin_amdgcn_update_dpp(0, (int)x, 0xB1, 0xF, 0xF, true); x |= (unsigned)__builtin_amdgcn_update_dpp(0, (int)x, 0x4E, 0xF, 0xF, true); x |= (unsigned)__builtin_amdgcn_update_dpp(0, (int)x, 0x141, 0xF, 0xF, true); return x; }
__device__ __forceinline__ float max3f(float a, float b, float c) { float r; asm("v_max3_f32 %0, %1, %2, %3" : "=v"(r) : "v"(a), "v"(b), "v"(c)); return r; }
__device__ __forceinline__ float max2f(float a, float b) { float r; asm("v_max_f32_e32 %0, %1, %2" : "=v"(r) : "v"(a), "v"(b)); return r; }
__device__ __forceinline__ float max32(const f32x16& p, const f32x16& q) {
    float a = max3f(p[0], p[1], q[0]), b = max3f(p[2], p[3], q[1]); a = max3f(a, q[2], q[3]);
#pragma unroll
    for (int r = 4; r < 16; r += 4) { a = max3f(a, p[r], p[r + 1]); b = max3f(b, p[r + 2], p[r + 3]); a = max3f(a, q[r], q[r + 1]); b = max3f(b, q[r + 2], q[r + 3]); }
    return max2f(a, b);
}
__device__ __forceinline__ float max16(const f32x16& p) { float a = max3f(p[0], p[1], p[2]), b = max3f(p[3], p[4], p[5]); a = max3f(a, p[6], p[7]); b = max3f(b, p[8], p[9]); a = max3f(a, p[10], p[11]); b = max3f(b, p[12], p[13]); a = max3f(a, p[14], p[15]); return max2f(a, b); }
__device__ __forceinline__ float sum16v(const f32x16& p) { return (((p[0] + p[1]) + (p[2] + p[3])) + ((p[4] + p[5]) + (p[6] + p[7]))) + (((p[8] + p[9]) + (p[10] + p[11])) + ((p[12] + p[13]) + (p[14] + p[15]))); }
__device__ __forceinline__ void mask_range(f32x16& p, int sub, int hi, int lo, int hi_) {
    const int base = 32 * sub + 4 * hi;
#pragma unroll
    for (int r = 0; r < 16; ++r) { const int k = base + (r & 3) + 8 * (r >> 2); if (k < lo || k > hi_) p[r] = -INFINITY; }
}
__device__ __forceinline__ void softmax_pv(const LAS unsigned char* Vb, int vl0, f32x16& p0, f32x16& p1, float& m, float& l, f32x16 (&o)[2]) {
    float tmax = fmaxf(max16(p0), max16(p1)); tmax = fmaxf(tmax, __shfl_xor(tmax, 32));
    if (__any(tmax > m + THR)) { const float mn = fmaxf(m, tmax), f = __builtin_amdgcn_exp2f(m - mn); o[0] = o[0] * f; o[1] = o[1] * f; l *= f; m = mn; }
#pragma unroll
    for (int r = 0; r < 16; ++r) { p0[r] = __builtin_amdgcn_exp2f(p0[r] - m); p1[r] = __builtin_amdgcn_exp2f(p1[r] - m); }
    l += sum16v(p0) + sum16v(p1);
    pv_tile(Vb, vl0, p0, p1, o);
}

#define ATT_GLD(P, t) (*(const v4u*)((P) + (size_t)(t) * 4096 + tid * 8))
#define ATT_SEQ_LOAD(i_) do { const int i__ = (i_); if (i__ < te_) { gK = ATT_GLD(Kg_, i__); gV = ATT_GLD(Vg_, i__); } \
        else if (NKg_ && ntb_ + (i__ - te_) < nte_) { gK = ATT_GLD(NKg_, ntb_ + (i__ - te_)); gV = ATT_GLD(NVg_, ntb_ + (i__ - te_)); } } while (0)
#define ATT_LOOP_BEGIN(Kg, Vg, tbeg, tend, NKg, NVg, ntb, nte) { const bf16_t* Kg_ = (Kg); const bf16_t* Vg_ = (Vg); const bf16_t* NKg_ = (NKg); const bf16_t* NVg_ = (NVg); const int tb_ = (tbeg), te_ = (tend), ntb_ = (ntb), nte_ = (nte); \
    *(LAS v4u*)(lds + KOFF + kst) = gK; *(LAS v4u*)(lds + VOFF + vst) = gV; \
    __syncthreads(); \
    for (int jt = tb_; jt < te_; ++jt) { const int bufo_ = ((jt - tb_) & 1) * 8192; const bool more_ = jt + 1 < te_; \
        ATT_SEQ_LOAD(jt + 1); \
        { const LAS unsigned char* Kb = lds + KOFF + bufo_; const LAS unsigned char* Vb = lds + VOFF + bufo_;
#define ATT_LOOP_END } \
        if (more_) { *(LAS v4u*)(lds + KOFF + (bufo_ ^ 8192) + kst) = gK; *(LAS v4u*)(lds + VOFF + (bufo_ ^ 8192) + vst) = gV; } \
        __syncthreads(); } }

template <int MODE, bool EDGE, int VAR> __device__ __forceinline__ void tile_body(const LAS unsigned char* Kb, const LAS unsigned char* Vb, int vl0, const bf16x8 (&qr)[4], int r32, int hi, int jt, int qb, int iq,
                                                                         unsigned long long selm, float& m, float& l, f32x16 (&o)[2]) {
    f32x16 p0, p1; if (VAR & 16) { p0 = zero16(); p1 = zero16(); asm volatile("" : "+v"(p0), "+v"(p1)); } else qk_tile(Kb, qr, r32, hi, p0, p1);
    asm volatile("s_nop 15\n\ts_nop 7" : "+v"(p0), "+v"(p1));
    const bool sel = MODE == 0 ? (bool)((selm >> jt) & 1ull) : true;
    if (EDGE) {
        if (jt == qb) { mask_range(p0, 0, hi, 0, iq); mask_range(p1, 1, hi, 0, iq); }
        else if (MODE == 1 && jt == qb - 8) { mask_range(p0, 0, hi, iq + 1, 63); mask_range(p1, 1, hi, iq + 1, 63); }
    }
    float tmax = (VAR & 4) ? 0.f : max32(p0, p1); if (!(VAR & 4)) tmax = max2f(tmax, other32(tmax, hi));
    if (MODE == 0) tmax = sel ? tmax : -INFINITY;
    if (!(VAR & 4) && __any(tmax > m + THR)) { const float mn = fmaxf(m, tmax), f = __builtin_amdgcn_exp2f(m - mn); o[0] = o[0] * f; o[1] = o[1] * f; l *= f; m = mn; }
    const float mref = (MODE == 0) ? (sel ? m : 1e30f) : m;
    if (!(VAR & 2)) {
#pragma unroll
    for (int r = 0; r < 16; ++r) { p0[r] = __builtin_amdgcn_exp2f(p0[r] - mref); p1[r] = __builtin_amdgcn_exp2f(p1[r] - mref); }
    l += sum16v(p0) + sum16v(p1);
    }
    if (!(VAR & 1)) pv_tile(Vb, vl0, p0, p1, o); else { asm volatile("" :: "v"(p0), "v"(p1)); }
}
template <int MODE, int VAR> __device__ __forceinline__ void run_branch(LAS unsigned char* lds, const bf16_t* Kg_, const bf16_t* Vg_, const int t0, const int te_, const bf16_t* NKg_, const bf16_t* NVg_, const int ntb_, const int nte_,
                                                               v4u& gK, v4u& gV, const int tid, const int kst, const int vst, const int vl0,
                                                               const bf16x8 (&qr)[4], const int r32, const int hi, const int qb, const int iq, const unsigned long long selm, float& m, float& l, f32x16 (&o)[2]) {
#define ATT_TILE(EDGE, jt_) do { const int j_ = (jt_); const int bo_ = ((j_ - t0) & 1) * 8192; const bool more_ = j_ + 1 < te_; \
        ATT_SEQ_LOAD(j_ + 1); \
        tile_body<MODE, EDGE, VAR>(lds + KOFF + bo_, lds + VOFF + bo_, vl0, qr, r32, hi, j_, qb, iq, selm, m, l, o); \
        if (more_) { *(LAS v4u*)(lds + KOFF + (bo_ ^ 8192) + kst) = gK; *(LAS v4u*)(lds + VOFF + (bo_ ^ 8192) + vst) = gV; } \
        if (!(VAR & 8)) __syncthreads(); } while (0)
    *(LAS v4u*)(lds + KOFF + kst) = gK; *(LAS v4u*)(lds + VOFF + vst) = gV;
    __syncthreads();
    ATT_TILE(true, t0);
#pragma unroll 1
    for (int jt = t0 + 1; jt < te_ - 1; ++jt) ATT_TILE(false, jt);
    if (te_ - 1 > t0) ATT_TILE(true, te_ - 1);
#undef ATT_TILE
}

template <int VAR> __device__ __forceinline__ void attn_unit(LAS unsigned char* lds, const Args& a, int b, int g, int qb, const int w) {
    using namespace cfg;
    int tid = w * 64 + lane_id(); asm volatile("" : "+v"(tid));
    const int lane = tid & 63, r32 = lane & 31, hi = lane >> 5, hr = w >> 1, qh = w & 1;
    const int head = g * 4 + hr, iq = 32 * qh + r32, tq = 64 * qb + iq, row = b * T + tq;
    unsigned char* ws = a.ws;
    const size_t bg = (size_t)(b * 2 + g);
    const bf16_t* KV = (const bf16_t*)(ws + wsl::KV);
    const bf16_t* kc = (const bf16_t*)(ws + wsl::KC) + bg * 256 * 64; const bf16_t* vc = (const bf16_t*)(ws + wsl::VC) + bg * 256 * 64;
    const bf16_t* ks = KV + 2 * KVPART + bg * T * 64; const bf16_t* vs = KV + 3 * KVPART + bg * T * 64;
    const bf16_t* kw = KV + 4 * KVPART + bg * T * 64; const bf16_t* vw = KV + 5 * KVPART + bg * T * 64;
    const int srow = tid >> 3, sch = tid & 7;
    const int kst = srow * 128 + ((sch ^ ((srow >> 1) & 7)) << 4), vst = srow * 128 + ((sch << 4) ^ (((srow >> 1) & 1) << 6));
    const int tq4 = (lane & 15) >> 2, tp = lane & 3, tblk = (lane >> 4) & 1;
    const int vl0 = hi * 512 + tq4 * 128 + ((tblk * 32 + tp * 8) ^ (((tq4 >> 1) & 1) << 6));
    bf16x8 qr[4];
    { const bf16_t* Qp = (const bf16_t*)(ws + wsl::Q) + (((size_t)(b * NH + head)) * T + tq) * 64 + 8 * hi;
#pragma unroll
      for (int d0 = 0; d0 < 4; ++d0) qr[d0] = *(const bf16x8*)(Qp + 16 * d0); }
#define ATT_COLD_ROW(rowv) int rowv; { int t2_ = w * 64 + lane_id(); asm volatile("" : "+v"(t2_)); rowv = b * T + 64 * qb + 32 * qh + (t2_ & 31); }
    LAS float* IMPP = (LAS float*)(lds + IMPP_OFF);
    LAS float* TOT = IMPP + tid;
    LAS float* SC = (LAS float*)(lds + SC_OFF);
    LAS unsigned* MASK = (LAS unsigned*)(lds + MASK_OFF);
    LAS float* SSQP = (LAS float*)(lds + SSQP_OFF);

    int ntc = (4 * qb + 3 + 63) >> 6; if (ntc > 4) ntc = 4;
    int nvq = tq >= 31 ? ((tq - 31) >> 4) + 1 : 0; if (nvq > NC) nvq = NC;
    float m = MINIT, l = 0.f;
    const int t0w = qb >= 8 ? qb - 8 : 0;
    v4u gK = ATT_GLD(kc, 0), gV = ATT_GLD(vc, 0);
    if (!(VAR & 32)) {
    ATT_LOOP_BEGIN(kc, vc, 0, ntc, kc, vc, 0, ntc)
        f32x16 p0, p1; qk_tile(Kb, qr, r32, hi, p0, p1);
        const int lim = nvq - 1 - 64 * jt;
        mask_range(p0, 0, hi, 0, lim); mask_range(p1, 1, hi, 0, lim);
        asm volatile("s_nop 15\n\ts_nop 7" : "+v"(p0), "+v"(p1));
        const float tmax = max32(p0, p1);
        if (tmax > m) { l *= __builtin_amdgcn_exp2f(m - tmax); m = tmax; }
        float s = 0.f;
#pragma unroll
        for (int r = 0; r < 16; ++r) s += __builtin_amdgcn_exp2f(p0[r] - m) + __builtin_amdgcn_exp2f(p1[r] - m);
        l += s;
    ATT_LOOP_END
    }
    { const float mo = other32(m, hi), lo_ = other32(l, hi), mt = fmaxf(m, mo);
      l = l * __builtin_amdgcn_exp2f(m - mt) + lo_ * __builtin_amdgcn_exp2f(mo - mt); m = mt; }
    const float inv_c = 1.f / fmaxf(l, 1e-30f);
    f32x16 oc[2]; oc[0] = zero16(); oc[1] = zero16();
    {
        float carry = 0.f;
        ATT_LOOP_BEGIN(kc, vc, 0, ntc, ks, vs, 0, qb + 1)
            f32x16 p0, p1; qk_tile(Kb, qr, r32, hi, p0, p1);
            const int lim = nvq - 1 - 64 * jt;
            mask_range(p0, 0, hi, 0, lim); mask_range(p1, 1, hi, 0, lim);
#pragma unroll
            for (int r = 0; r < 16; ++r) { p0[r] = __builtin_amdgcn_exp2f(p0[r] - m) * inv_c; p1[r] = __builtin_amdgcn_exp2f(p1[r] - m) * inv_c; }
            int ib = IMPP_OFF + (((hr * 64 + iq) * 64 + hi + 16 * jt) << 2); asm volatile("" : "+v"(ib));
#pragma unroll
            for (int sub = 0; sub < 2; ++sub) {
                float gs[4], recv[4];
#pragma unroll
                for (int k = 0; k < 4; ++k) { const float x0 = sub ? p1[4 * k] : p0[4 * k], x1 = sub ? p1[4 * k + 1] : p0[4 * k + 1], x2 = sub ? p1[4 * k + 2] : p0[4 * k + 2], x3 = sub ? p1[4 * k + 3] : p0[4 * k + 3];
                    gs[k] = (x0 + x1) + (x2 + x3); recv[k] = other32(x3, hi); }
#pragma unroll
                for (int k = 0; k < 4; ++k) { const float add = hi ? recv[k] : (k > 0 ? recv[k - 1] : carry);
                    *(LAS float*)(lds + ib + (8 * sub + 2 * k) * 4) = gs[k] + add; }
                carry = recv[3];
            }
            pv_tile(Vb, vl0, p0, p1, oc);
        ATT_LOOP_END
    }
    if (qb < SEL_TOPK) {
        if (tid < 64) { MASK[tid * 2] = (2u << qb) - 1u; MASK[tid * 2 + 1] = 0u; }
        __syncthreads();
    } else
    {
        const int q = tid >> 3, jc = tid & 7;
        unsigned long long mine[8];
#pragma unroll
        for (int e = 0; e < 8; ++e) { const int j = 8 * jc + e; float sc;
            if (j == 0 || j == qb || j == qb - 1) sc = INFINITY;
            else if (j <= qb) sc = ((IMPP[(0 * 64 + q) * 64 + j] + IMPP[(1 * 64 + q) * 64 + j]) + IMPP[(2 * 64 + q) * 64 + j]) + IMPP[(3 * 64 + q) * 64 + j];
            else sc = 0.f;
            mine[e] = ((unsigned long long)__float_as_uint(sc) << 8) | (unsigned)(255 - j); }
        __syncthreads();
        LAS unsigned long long* KEY = (LAS unsigned long long*)IMPP;
#pragma unroll
        for (int e = 0; e < 8; ++e) KEY[q * 64 + 8 * jc + e] = mine[e];
        __syncthreads();
        int rank[8];
#pragma unroll
        for (int e = 0; e < 8; ++e) rank[e] = 0;
        const int nj = (VAR & 64) ? 1 : qb + 1;
#pragma unroll 2
        for (int j2 = 0; j2 < nj; ++j2) { const unsigned long long o = KEY[q * 64 + j2];
#pragma unroll
            for (int e = 0; e < 8; ++e) rank[e] += (o > mine[e]) ? 1 : 0; }
        unsigned bits = 0u;
#pragma unroll
        for (int e = 0; e < 8; ++e) if (rank[e] < SEL_TOPK && 8 * jc + e <= qb) bits |= 1u << e;
        unsigned lo32 = jc < 4 ? bits << (8 * jc) : 0u, hi32 = jc >= 4 ? bits << (8 * (jc - 4)) : 0u;
        lo32 = dpp_or8(lo32); hi32 = dpp_or8(hi32);
        if (jc == 0) { MASK[q * 2] = lo32; MASK[q * 2 + 1] = hi32; }
        __syncthreads();
    }
    {
        ATT_COLD_ROW(row_c) const float g_cmp = ((const float*)(ws + wsl::GATES))[(size_t)row_c * 24 + head * 3];
#pragma unroll
        for (int db = 0; db < 2; ++db)
#pragma unroll
            for (int r = 0; r < 16; ++r) TOT[(db * 16 + r) * 512] = oc[db][r] * g_cmp;
    }
    {
        const unsigned long long selm = (unsigned long long)MASK[iq * 2] | ((unsigned long long)MASK[iq * 2 + 1] << 32);
        f32x16 o[2]; o[0] = zero16(); o[1] = zero16(); m = MINIT; l = 0.f;
        run_branch<0, VAR>(lds, ks, vs, 0, qb + 1, kw, vw, t0w, qb + 1, gK, gV, tid, kst, vst, vl0, qr, r32, hi, qb, iq, selm, m, l, o);
        l += other32(l, hi);
        ATT_COLD_ROW(row_s) const float sc = ((const float*)(ws + wsl::GATES))[(size_t)row_s * 24 + head * 3 + 1] / fmaxf(l, 1e-30f);
#pragma unroll
        for (int db = 0; db < 2; ++db)
#pragma unroll
            for (int r = 0; r < 16; ++r) TOT[(db * 16 + r) * 512] += o[db][r] * sc;
    }
    {
        f32x16 o[2]; o[0] = zero16(); o[1] = zero16(); m = MINIT; l = 0.f;
        run_branch<1, VAR>(lds, kw, vw, t0w, qb + 1, nullptr, nullptr, 0, 0, gK, gV, tid, kst, vst, vl0, qr, r32, hi, qb, iq, 0ull, m, l, o);
        l += other32(l, hi);
        ATT_COLD_ROW(row_w) const float sc = ((const float*)(ws + wsl::GATES))[(size_t)row_w * 24 + head * 3 + 2] / fmaxf(l, 1e-30f);
#pragma unroll
        for (int db = 0; db < 2; ++db)
#pragma unroll
            for (int r = 0; r < 16; ++r) o[db][r] = TOT[(db * 16 + r) * 512] + o[db][r] * sc;
        oc[0] = o[0]; oc[1] = o[1];
    }
    {
        ATT_COLD_ROW(row_o) bf16_t* orow = (bf16_t*)(ws + wsl::MIX) + (size_t)row_o * MIXP + head * 64;
        float sq = 0.f;
#pragma unroll
        for (int db = 0; db < 2; ++db)
#pragma unroll
            for (int k = 0; k < 4; ++k) { const float x0 = oc[db][4 * k], x1 = oc[db][4 * k + 1], x2 = oc[db][4 * k + 2], x3 = oc[db][4 * k + 3];
                sq += (x0 * x0 + x1 * x1) + (x2 * x2 + x3 * x3);
                pg8::u32x2 wv; wv.x = pg8::cvt_pk_bf16(x0, x1); wv.y = pg8::cvt_pk_bf16(x2, x3);
                *(pg8::u32x2*)(orow + 32 * db + 8 * k + 4 * hi) = wv; }
        sq += other32(sq, hi);
        if (hi == 0) SSQP[hr * 64 + iq] = sq;
        __syncthreads();
        if (tid < 64) ((float*)(ws + wsl::SSQA))[(size_t)(b * T + 64 * qb + tid) * 2 + g] = ((SSQP[tid] + SSQP[64 + tid]) + SSQP[128 + tid]) + SSQP[192 + tid];
        __syncthreads();
    }
}
}
template <int VAR> __device__ __forceinline__ void attn_phase(Frame& F, const Args& a) {
    const int G = F.G, bx = (int)blockIdx.x;
    for (int v0 = (G % 8 == 0) ? (bx % 8) * (G / 8) + bx / 8 : bx; v0 < 256; v0 += G) {
        const int bgi = v0 >> 4, s = v0 & 15;
#pragma unroll 1
        for (int i = 0; i < 4; ++i) { const int qb = i == 0 ? 63 - s : (i == 1 ? 32 + s : (i == 2 ? 31 - s : s)); att::attn_unit<VAR>(F.lds, a, bgi >> 1, bgi & 1, qb, F.wave); }
    }
}
constexpr int CW_BAR = 4096;
enum Feat { F_FFN1 = 1, F_WIN = 2, F_CMP = 4, F_S5 = 8, F_GLU = 16, F_ATT = 32, F_WOUT = 64, F_FFN2 = 128, F_ALL = 255 };
constexpr int NPHASE = 12;

__global__ void __launch_bounds__(NWAVES * 64, 2) mk_fwd(Args args, int feat) {
    using namespace cfg;
    extern __shared__ __attribute__((aligned(16))) unsigned char lds_raw[];
    Frame F;
    F.lds = (LAS unsigned char*)lds_raw;
    F.wave = __builtin_amdgcn_readfirstlane(threadIdx.x >> 6);
    F.G = gridDim.x; F.gw = blockIdx.x * NWAVES + F.wave; F.NGW = F.G * NWAVES;
    volatile LAS unsigned* MISC = (volatile LAS unsigned*)(F.lds + MISC_OFF);
    for (int u = F.tid(); u < (LDS_BYTES - LDSCTL_OFF) / 4; u += NWAVES * 64) ((LAS unsigned*)(F.lds + LDSCTL_OFF))[u] = 0u;
    __syncthreads();
    unsigned char* ws = args.ws; const float* const* in = args.in;
    const int lo = args.ph_lo, hi = args.ph_hi; const bool multi = (hi - lo) > 1;
    XcdBarrier bar; bar.bar = (unsigned*)(ws + wsl::CTL) + CW_BAR; bar.x = 0; bar.st = nullptr; bar.w0 = 0;
    if (multi) bar = xcd_barrier_post((unsigned*)(ws + wsl::CTL) + CW_BAR, MISC + 8);
#ifndef PH_MASK
#define PH_MASK 0xFFF
#endif
#define IN(k) (((PH_MASK >> (k)) & 1) && lo <= (k) && (k) < hi)
#ifndef REP_PH
#define REP_PH -1
#endif
#ifndef REP_N
#define REP_N 1
#endif
#ifndef REP_MASK
#define REP_MASK 0
#endif
#define REP(k) for (int rp_ = 0; rp_ < (((REP_PH) == (k) || (((REP_MASK) >> (k)) & 1)) ? (REP_N) : 1); ++rp_)
#ifdef PROBE_A
#define STAMP(i) do { if (blockIdx.x == 0 && F.tid() == 0) ((unsigned long long*)(ws + wsl::CTL + 65536))[i] = __builtin_amdgcn_s_memrealtime(); } while (0)
#else
#define STAMP(i) do {} while (0)
#endif
#define SEAM(k) do { if (IN(k) && IN((k) + 1)) { xcd_barrier(bar); STAMP((k) + 1); } } while (0)
    bf16_t* XB = (bf16_t*)(ws + wsl::XB); bf16_t* Hh = (bf16_t*)(ws + wsl::H);
    float* SSQ1 = (float*)(ws + wsl::SSQ1); float* SSQ2 = (float*)(ws + wsl::SSQ2); float* SSQ3 = (float*)(ws + wsl::SSQ3);
    float* SSQS = (float*)(ws + wsl::SSQS); float* SSQA = (float*)(ws + wsl::SSQA);
    bf16_t* MIX = (bf16_t*)(ws + wsl::MIX); bf16_t* YG = (bf16_t*)(ws + wsl::YG);
    MixBufs mb{(bf16_t*)(ws + wsl::Q), (bf16_t*)(ws + wsl::KV), (float*)(ws + wsl::GATES), (bf16_t*)(ws + wsl::UX), in[7]};
    const int cu = (int)blockIdx.x;

    STAMP(0);
    if (IN(0)) REP(0) { p0_prologue(F, args); }
    SEAM(0);
    if (IN(1) && (feat & F_FFN1)) REP(1) {
        pg8::Gemm g{XB, (const bf16_t*)(ws + wsl::W1A), M, 2 * FF, D, D, D, 0, 0}; pg8::StaticOrder S; S.init(M, 2 * FF, F.G, cu);
        pg8::EpiSwiGLU E{Hh, false, pg8::RowScaleTable{nullptr, -1, -1, nullptr}};
        pg8::gemm_phase<pg8::EpiSwiGLU, pg8::StaticOrder, true, true>(F.lds, g, S, E, F.wave);
    }
    SEAM(1);
    if (IN(2) && (feat & F_FFN1)) REP(2) {
        pg8::Gemm g{Hh, (const bf16_t*)(ws + wsl::W1D), M, D, FF, FF, FF, 0, 0}; pg8::StaticOrder S; S.init(M, D, F.G, cu);
        pg8::EpiResid<0> E{in[0], XB, SSQ1, nullptr, nullptr};
        pg8::gemm_phase<pg8::EpiResid<0>, pg8::StaticOrder, true, true>(F.lds, g, S, E, F.wave);
    }
    SEAM(2);
    if (IN(3) && (feat & F_WIN)) REP(3) {
        pg8::Gemm g{XB, (const bf16_t*)(ws + wsl::WIN), M, INC_PAD, D, D, D, 0, 0}; pg8::StaticOrder S; S.init(M, INC_PAD, F.G, cu);
        const pg8::RowScaleTable rt = pg8::make_row_scale_table((LAS float*)(F.lds + BIAS_OFF), SSQ1, S, F.tid());
        pg8::EpiWin E{mb, rt};
        pg8::gemm_phase<pg8::EpiWin, pg8::StaticOrder, true, true>(F.lds, g, S, E, F.wave);
    }
    SEAM(3);
    if (IN(4)) REP(4) {
        if (feat & F_CMP) {
            float* PART = (float*)(ws + wsl::YG);
            { pg8::Gemm g{mb.KV, (const bf16_t*)(ws + wsl::CW1K), 4096, 1024, 512, 1024, 2048, 0, 512}; pg8::StaticOrder S; S.init(4096, 1024, F.G, cu);
              pg8::EpiPart E{PART};
              pg8::gemm_phase<pg8::EpiPart, pg8::StaticOrder, true, true>(F.lds, g, S, E, F.wave); }
            { pg8::Gemm g{mb.KV + KVPART, (const bf16_t*)(ws + wsl::CW1V), 4096, 1024, 512, 1024, 2048, 0, 512}; pg8::StaticOrder S; S.init(4096, 1024, F.G, (cu + F.G - 64) % F.G);
              pg8::EpiPart E{PART + (size_t)4 * 4096 * 256};
              pg8::gemm_phase<pg8::EpiPart, pg8::StaticOrder, true, true>(F.lds, g, S, E, F.wave); }
        }
        if (feat & F_S5) {
            pg8::Gemm g{mb.UX, (const bf16_t*)(ws + wsl::BTS), SGRP * 2048, 256, 256, 384, 256, 8, 0}; pg8::StaticOrder S; S.init(SGRP * 2048, 256, F.G, (cu + F.G - 128) % F.G);
            pg8::EpiS5S E{(float*)(ws + wsl::S)};
            pg8::gemm_phase<pg8::EpiS5S, pg8::StaticOrder, true, true>(F.lds, g, S, E, F.wave);
        }
    }
    SEAM(4);
    if (IN(5)) REP(5) {
        LAS float* bias = (LAS float*)(F.lds + BIAS_OFF);
        if (feat & F_CMP) { const int t_ = F.tid(), ten = t_ >> 8, n = t_ & 255; const float* cbp = (const float*)(ws + WS_CBP) + ten * 16 * 256 + n; float s = (ten ? in[14] : in[11])[n];
#pragma unroll
            for (int k = 0; k < 16; ++k) s += cbp[k * 256];
            bias[ten * 256 + n] = s; }
        __syncthreads();
        if (F.wave == 0) { if (feat & F_S5) for (int bg = cu; bg < BATCH * SGRP; bg += F.G) s5_scan_task(args, bg, lane_id()); }
        else if (feat & F_CMP) {
            const float* PART = (const float*)(ws + wsl::YG);
            for (int tk = cu * (NWAVES - 1) + F.wave - 1; tk < 512; tk += F.G * (NWAVES - 1)) {
                if (tk < 256) cmp_out_task(PART, bias, (const bf16_t*)(ws + wsl::CW2K), (bf16_t*)(ws + wsl::KC), tk, lane_id());
                else cmp_out_task(PART + (size_t)4 * 4096 * 256, bias + 256, (const bf16_t*)(ws + wsl::CW2V), (bf16_t*)(ws + wsl::VC), tk - 256, lane_id());
            }
        }
    }
    SEAM(5);
    if (IN(6) && (feat & F_S5)) REP(6) {
        pg8::Gemm g{mb.UX, (const bf16_t*)(ws + wsl::BTY), SGRP * 2048, 256, 384, 384, 384, 8, 0}; pg8::StaticOrder S; S.init(SGRP * 2048, 256, F.G, cu);
        pg8::EpiS5Y E{YG};
        pg8::gemm_phase<pg8::EpiS5Y, pg8::StaticOrder, true, true>(F.lds, g, S, E, F.wave);
    }
    SEAM(6);
    if (IN(7)) {
#ifndef NO_GLU
        if (feat & F_GLU) REP(7) {
            pg8::Gemm g{YG, (const bf16_t*)(ws + wsl::GLUW), M, 512, 512, 512, 512, 0, 0}; pg8::StaticOrder S; S.init(M, 512, F.G, cu);
            pg8::EpiGLU E{YG, in[25], MIX + 512, SSQS};
            pg8::gemm_phase<pg8::EpiGLU, pg8::StaticOrder, true, true>(F.lds, g, S, E, F.wave);
        }
#endif
#ifdef HAVE_FAST_ATTN
#ifdef SHADOW_VAR
        if (feat & F_ATT) { attn_phase<SHADOW_VAR>(F, args); __syncthreads(); }
#endif
        if (feat & F_ATT) REP(12) attn_phase<0>(F, args);
#endif
    }
    SEAM(7);
    if (IN(8) && (feat & F_WOUT)) {
        pg8::Gemm g{MIX, (const bf16_t*)(ws + wsl::WOUT), M, D, D, D, D, 0, 0}; pg8::StaticOrder S; S.init(M, D, F.G, cu);
        pg8::EpiResid<1> E{nullptr, XB, SSQ2, SSQA, SSQS};
        pg8::gemm_phase<pg8::EpiResid<1>, pg8::StaticOrder, true, true>(F.lds, g, S, E, F.wave);
    }
    SEAM(8);
    if (IN(9) && (feat & F_FFN2)) REP(9) {
        pg8::Gemm g{XB, (const bf16_t*)(ws + wsl::W2A), M, 2 * FF, D, D, D, 0, 0}; pg8::StaticOrder S; S.init(M, 2 * FF, F.G, cu);
        const pg8::RowScaleTable rt = pg8::make_row_scale_table((LAS float*)(F.lds + BIAS_OFF), SSQ2, S, F.tid());
        pg8::EpiSwiGLU E{Hh, true, rt};
        pg8::gemm_phase<pg8::EpiSwiGLU, pg8::StaticOrder, true, true>(F.lds, g, S, E, F.wave);
    }
    SEAM(9);
    if (IN(10) && (feat & F_FFN2)) {
        pg8::Gemm g{Hh, (const bf16_t*)(ws + wsl::W2D), M, D, FF, FF, FF, 0, 0}; pg8::StaticOrder S; S.init(M, D, F.G, cu);
        pg8::EpiResid<2> E{nullptr, XB, SSQ3, nullptr, nullptr};
        pg8::gemm_phase<pg8::EpiResid<2>, pg8::StaticOrder, true, true>(F.lds, g, S, E, F.wave);
    }
    SEAM(10);
    if (IN(11) && (feat & F_FFN2)) {
        for (int m = F.gw; m < M; m += F.NGW) {
            const GAS unsigned long long* xr = (const GAS unsigned long long*)(XB + (size_t)m * D) + lane_id(); GAS f32x4* orow = (GAS f32x4*)(args.out + (size_t)m * D) + lane_id(); const GAS f32x4* gr = (const GAS f32x4*)in[33] + lane_id();
            float r = rsqrtf(pg8::sum16(SSQ3 + (size_t)m * 16) * (1.f / D) + EPS);
#ifdef PROBE_A
            { const unsigned long long* ts = (const unsigned long long*)(ws + wsl::CTL + 65536);
              const float ta = floorf((float)(ts[PROBE_A + 1] - ts[PROBE_A]) * 0.01f * 0.125f + 0.5f) * 8.f;
              r *= 1.f + sqrtf(ta * 2e-6f); }
#endif
#pragma unroll
            for (int j = 0; j < 4; ++j) { const unsigned long long w = xr[64 * j]; const f32x4 gq = gr[64 * j]; const unsigned lo = (unsigned)w, hi = (unsigned)(w >> 32);
                const f32x4 v = (f32x4){__uint_as_float(lo << 16), __uint_as_float(lo & 0xffff0000u), __uint_as_float(hi << 16), __uint_as_float(hi & 0xffff0000u)};
                orow[64 * j] = v * gq * r; }
        }
    }
#undef IN
#undef SEAM
}
extern "C" void kernel_launch(void* const* d_in, const int* in_sizes, int n_in, void* d_out, int out_size, void* d_ws, size_t ws_size, hipStream_t stream) {
    using namespace cfg;
    if (n_in != 34 || out_size != M * D || ws_size < wsl::END) { fprintf(stderr, "kernel_launch: built for 34 inputs, %d outputs, >= %zu bytes of workspace; got n_in %d out %d ws %zu; nothing launched\n", M * D, (size_t)wsl::END, n_in, out_size, ws_size); return; }
    static int grid = 0;
    if (grid == 0) {
        int dev = 0, cus = 0, per_cu = 0;
        if (hipGetDevice(&dev) != hipSuccess || hipDeviceGetAttribute(&cus, hipDeviceAttributeMultiprocessorCount, dev) != hipSuccess) { fprintf(stderr, "kernel_launch: device query failed; nothing launched\n"); grid = -1; return; }
        if (hipFuncSetAttribute((const void*)mk_fwd, hipFuncAttributeMaxDynamicSharedMemorySize, LDS_BYTES) != hipSuccess) { fprintf(stderr, "kernel_launch: hipFuncSetAttribute(%d B dynamic LDS) failed; nothing launched\n", LDS_BYTES); grid = -1; return; }
        if (hipOccupancyMaxActiveBlocksPerMultiprocessor(&per_cu, (const void*)mk_fwd, NWAVES * 64, LDS_BYTES) != hipSuccess || per_cu < 1) { fprintf(stderr, "kernel_launch: the occupancy query reports %d workgroups per CU for %d threads + %d B LDS; nothing launched\n", per_cu, NWAVES * 64, LDS_BYTES); (void)hipGetLastError(); grid = -1; return; }
        grid = cus;
    }
    if (grid < 0) return;
    (void)hipMemsetAsync((unsigned char*)d_ws + wsl::CTL, 0, wsl::CTL_BYTES, stream);
    Args a{};
    for (int i = 0; i < 34; ++i) a.in[i] = (const float*)d_in[i];
    a.out = (float*)d_out; a.ws = (unsigned char*)d_ws; a.ph_lo = 0; a.ph_hi = NPHASE;
    int feat = F_ALL; void* kargs[] = {&a, &feat};
    const hipError_t e = hipLaunchCooperativeKernel((const void*)mk_fwd, dim3(grid), dim3(NWAVES * 64), kargs, LDS_BYTES, stream);
    if (e != hipSuccess) fprintf(stderr, "kernel_launch: cooperative launch failed: %s (grid %d x %d threads, %d B LDS)\n", hipGetErrorString(e), grid, NWAVES * 64, LDS_BYTES);
}
```

```cpp
#include <hip/hip_runtime.h>
#include <cstdio>
#include <cstdint>
#include <cmath>

namespace cfg {
constexpr int BATCH = 8, T = 4096, D = 1024, M = BATCH * T, FF = 2816, INC = 1816, INC_PAD = 2048;
constexpr int NH = 8, NKV = 2, HD = 64, NC = 255, NB = 64, SEL_TOPK = 16, WINDOW = 512, CMP_LEN = 32;
constexpr int SGRP = 32, SCH = 16, SST = 64;
constexpr int LCH = 16, NCHUNK = T / LCH;
constexpr float EPS = 1e-6f;
constexpr float C2 = 0.125f * 1.4426950408889634f;
constexpr int MIXP = 1024;
constexpr size_t KVPART = (size_t)BATCH * NKV * T * HD;
}
typedef unsigned short bf16_t;

__device__ __forceinline__ float bf2f(bf16_t v) { return __uint_as_float(((unsigned)v) << 16); }
__device__ __forceinline__ unsigned f2bf_u(float f) { unsigned u = __float_as_uint(f); return (u + 0x7fffu + ((u >> 16) & 1u)) >> 16; }
__device__ __forceinline__ bf16_t f2bf(float f) { return (bf16_t)f2bf_u(f); }
__device__ __forceinline__ unsigned pk2(float lo, float hi) { return f2bf_u(lo) | (f2bf_u(hi) << 16); }
__device__ __forceinline__ float gelu_tanh(float x) { const float u = 0.7978845608028654f * (x + 0.044715f * x * x * x); return 0.5f * x * (1.f + tanhf(u)); }

__device__ __forceinline__ int lane_id() { int r; asm volatile("v_mbcnt_lo_u32_b32 %0, -1, 0\n\tv_mbcnt_hi_u32_b32 %0, -1, %0" : "=v"(r)); return r; }

struct MixBufs { bf16_t* Q; bf16_t* KV; float* GATES; bf16_t* UX; const float* gate_bias; };
namespace wsl {
constexpr size_t MiB = 1u << 20;
constexpr size_t CTL = 0, CTL_BYTES = 1 * MiB;
constexpr size_t W1A = 1 * MiB;
constexpr size_t W1D = 12 * MiB;
constexpr size_t W2A = 18 * MiB;
constexpr size_t W2D = 29 * MiB;
constexpr size_t WIN = 35 * MiB;
constexpr size_t WOUT = 39 * MiB;
constexpr size_t CW1K = 41 * MiB;
constexpr size_t CW1V = 42 * MiB;
constexpr size_t GLUW = 43 * MiB;
constexpr size_t CW2K = 43 * MiB + 512 * 1024;
constexpr size_t CW2V = CW2K + 64 * 1024;
constexpr size_t CB1K = CW2V + 64 * 1024;
constexpr size_t CB1V = CB1K + 4096;
constexpr size_t BTS = 44 * MiB;
constexpr size_t BTY = 48 * MiB;
constexpr size_t S5A = 54 * MiB;
constexpr size_t XB = 56 * MiB;
constexpr size_t H = 120 * MiB;
constexpr size_t Q = 120 * MiB;
constexpr size_t KV = 152 * MiB;
constexpr size_t UX = 200 * MiB;
constexpr size_t S = 248 * MiB;
constexpr size_t HIDK = 280 * MiB, HIDV = 282 * MiB;
constexpr size_t KC = 284 * MiB, VC = 284 * MiB + 512 * 1024;
constexpr size_t YG = 296 * MiB;
constexpr size_t MIX = 328 * MiB;
constexpr size_t GATES = 392 * MiB;
constexpr size_t SSQ1 = 395 * MiB, SSQ2 = 397 * MiB, SSQ3 = 399 * MiB;
constexpr size_t SSQS = 401 * MiB;
constexpr size_t SSQA = 402 * MiB;
constexpr size_t END = 403 * MiB;
}
#define GAS __attribute__((address_space(1)))
#define LAS __attribute__((address_space(3)))
typedef unsigned v4u __attribute__((ext_vector_type(4)));
typedef float f32x4 __attribute__((ext_vector_type(4)));
typedef short bf16x8 __attribute__((ext_vector_type(8)));
typedef GAS unsigned gu32;
typedef GAS unsigned long long gu64;
#define RLX_AGENT __ATOMIC_RELAXED, __HIP_MEMORY_SCOPE_AGENT
#define LDS_WAIT() asm volatile("s_waitcnt lgkmcnt(0)" ::: "memory")
#define VM_WAIT() asm volatile("s_waitcnt vmcnt(0)" ::: "memory")
__device__ __forceinline__ unsigned long long rt() { return __builtin_amdgcn_s_memrealtime(); }
#define XB_TMO      128
#define XB_XCNT(j)  (256  + 64 * (j))
#define XB_XSUB(j)  (1280 + 64 * (j))
#define XB_XGEN(j)  (2304 + 64 * (j))
#define XB_TOP      3328
#define XB_TOPGEN   3392
#define XCD_BAR_WORDS 3456
#define XB_SPIN_CAP (1u << 18)

__device__ __forceinline__ unsigned xb_ld(unsigned* p)              { return __hip_atomic_load(p, __ATOMIC_RELAXED, __HIP_MEMORY_SCOPE_AGENT); }
__device__ __forceinline__ unsigned xb_add(unsigned* p, unsigned v) { return __hip_atomic_fetch_add(p, v, __ATOMIC_RELAXED, __HIP_MEMORY_SCOPE_AGENT); }
__device__ __forceinline__ unsigned xb_xcc_id() { return (unsigned)__builtin_amdgcn_s_getreg((3 << 11) | 20) & 0xFu; }
#define XB_SPIN(cond, bar) do { unsigned _sp = 0; while (cond) { __builtin_amdgcn_s_sleep(1); \
    if ((++_sp & 255u) == 0u) { if (xb_ld(&(bar)[XB_TMO])) break; if (_sp > XB_SPIN_CAP) { atomicAdd(&(bar)[XB_TMO], 1u); break; } } } } while (0)

struct XcdBarrier {
    unsigned* bar; unsigned x; unsigned w0;
    volatile LAS unsigned* st;
};

__device__ __forceinline__ XcdBarrier xcd_barrier_post(unsigned* bar, volatile LAS unsigned* st) {
    XcdBarrier b; b.bar = bar; b.x = xb_xcc_id(); b.st = st; b.w0 = (__builtin_amdgcn_readfirstlane(threadIdx.x) < 64u) ? 1u : 0u;
    if (b.w0 && lane_id() == 0) (void)xb_add(&bar[XB_XCNT(b.x)], 1u);
    return b;
}
__device__ __forceinline__ void xcd_barrier_complete(unsigned* bar, unsigned x, unsigned& nloc, unsigned& nx) {
    const unsigned G = gridDim.x * gridDim.y * gridDim.z;
    unsigned sum, cnt, mine, sp = 0u;
    for (;;) {
        sum = 0u; cnt = 0u; mine = 0u;
#pragma unroll
        for (unsigned j = 0; j < 16; ++j) { const unsigned c = xb_ld(&bar[XB_XCNT(j)]); sum += c; cnt += (c > 0u) ? 1u : 0u; mine = (j == x) ? c : mine; }
        if (sum == G) break;
        __builtin_amdgcn_s_sleep(1);
        if ((++sp & 255u) == 0u) { if (xb_ld(&bar[XB_TMO])) break; if (sp > XB_SPIN_CAP) { atomicAdd(&bar[XB_TMO], 1u); break; } }
    }
    nloc = mine > 0u ? mine : 1u; nx = cnt > 0u ? cnt : 1u;
}

__device__ __forceinline__ void xcd_barrier(const XcdBarrier& b) {
    asm volatile("s_waitcnt vmcnt(0)" ::: "memory");
    __syncthreads();
    if (b.w0 && lane_id() == 0) {
        unsigned* bar = b.bar;
        __builtin_amdgcn_s_waitcnt(0);
        unsigned nloc = b.st[0], nx = b.st[1];
        if (nloc == 0u) { xcd_barrier_complete(bar, b.x, nloc, nx); b.st[0] = nloc; b.st[1] = nx; }
        const unsigned old = xb_add(&bar[XB_XSUB(b.x)], 1u);
        const unsigned gen = old / nloc;
        if (old + 1u == (gen + 1u) * nloc) {
            __builtin_amdgcn_fence(__ATOMIC_RELEASE, "agent");
            asm volatile("s_waitcnt vmcnt(0)" ::: "memory");
            const unsigned og = xb_add(&bar[XB_TOP], 1u);
            const unsigned tg = og / nx;
            if (og + 1u == (tg + 1u) * nx) xb_add(&bar[XB_TOPGEN], 1u);
            else XB_SPIN(xb_ld(&bar[XB_TOPGEN]) == tg, bar);
            __builtin_amdgcn_fence(__ATOMIC_ACQUIRE, "agent");
            xb_add(&bar[XB_XGEN(b.x)], 1u);
            asm volatile("s_waitcnt vmcnt(0)" ::: "memory");
        } else {
            XB_SPIN(xb_ld(&bar[XB_XGEN(b.x)]) == gen, bar);
            __builtin_amdgcn_fence(__ATOMIC_ACQUIRE, "agent");
            asm volatile("s_waitcnt vmcnt(0)" ::: "memory");
        }
    }
    __syncthreads();
}
namespace pg8 {
#define PG8_LAS __attribute__((address_space(3)))
typedef unsigned short bf16_t;
typedef short bf16x8 __attribute__((ext_vector_type(8)));
typedef float f32x4 __attribute__((ext_vector_type(4)));
typedef unsigned u32x4 __attribute__((ext_vector_type(4)));
constexpr int BM = 256, BK = 64, HALF = 128, HTB = HALF * BK * 2  , STAGE_BYTES = 8 * HTB, NXCD = 8, WGM = 8;

__host__ __device__ __forceinline__ int lds_byte(int r, int c) { const int st = (r >> 4) * 2 + (c >> 5), rr = r & 15, cc = c & 31, ob = rr * 64 + cc * 2; return st * 1024 + (ob ^ (((ob >> 9) & 1) << 5)); }
__host__ __device__ __forceinline__ void stage_rc(int b, int& R, int& C) { const int st = b / 1024, sb = b % 1024, swz = sb ^ (((sb >> 9) & 1) << 5); R = (st >> 1) * 16 + swz / 64; C = (st & 1) * 32 + (swz % 64) / 2; }
__host__ __device__ __forceinline__ int perm32(int rho) { const int n = rho >> 4, i = rho & 15; return 8 * (i >> 2) + 4 * n + (i & 3); }

struct Unit { int pm, pn; };
struct Gemm { const bf16_t* A; const bf16_t* Bt; int M, N, K, lda, ldb, bdiv, kslice; };

struct OneUnit {
    int pm, pn;
    __host__ __device__ bool next(int i, Unit& u) const { if (i) return false; u.pm = pm; u.pn = pn; return true; }
    __device__ __forceinline__ void a_ready(const Unit&) const {}
    __device__ __forceinline__ void done(const Unit&) const {}
};
struct StaticOrder {
    int nM, nN, nwg, G, c, rev = 0;
    __host__ __device__ void init(int M, int N, int G_, int c_) { nM = M / BM; nN = N / BM; nwg = nM * nN; G = G_; c = c_; }
    __host__ __device__ bool next(int i, Unit& u) const {
        const long L = (long)i * G + c; if (L >= nwg) return false;
        int wgid = (int)L; { const int q = nwg / NXCD, r = nwg % NXCD, xcd = wgid % NXCD, off = wgid / NXCD; wgid = (xcd < r ? xcd * (q + 1) : r * (q + 1) + (xcd - r) * q) + off; }
        const int nig = WGM * nN, gid = wgid / nig, fm = gid * WGM, gsz = (nM - fm) < WGM ? (nM - fm) : WGM;
        u.pm = fm + ((wgid % nig) % gsz); u.pn = (wgid % nig) / gsz; if (rev) u.pm = nM - 1 - u.pm; return true;
    }
    __device__ __forceinline__ void a_ready(const Unit&) const {}
    __device__ __forceinline__ void done(const Unit&) const {}
};


template <class Epi, class Sched, bool ALIGN_EPI = false, bool SP2 = false>
__device__ __forceinline__ void gemm_phase(PG8_LAS unsigned char* lds, const Gemm g, const Sched& S, const Epi& E, const int wid) {
    const int lane = lane_id(), tid = wid * 64 + lane, wr = wid >> 2, wc = wid & 3, fr = lane & 15, fq = lane >> 4;
    int nt = g.K / BK; asm volatile("" : "+s"(nt));
    unsigned voffA[2], voffB[2];
#pragma unroll
    for (int i = 0; i < 2; ++i) { int R, C; stage_rc(tid * 16 + i * 8192, R, C); const int Rb = Epi::PERM ? ((R & ~31) + perm32(R & 31)) : R;
        voffA[i] = (unsigned)(R * g.lda + C) * 2u; voffB[i] = (unsigned)(Rb * g.ldb + C) * 2u; }
    const size_t kstep = (size_t)(BK * 2);
    const size_t hstepA = (size_t)HALF * g.lda * 2, hstepB = (size_t)HALF * g.ldb * 2;
    const size_t tstepA = 2 * hstepA, tstepB = 2 * hstepB;
#define PG8_BT(u) ((size_t)(g.kslice > 0 ? 0 : (g.bdiv > 0 ? (u).pm / g.bdiv : (u).pn)))
#define PG8_KO(u) ((size_t)(g.kslice > 0 ? (u).pn * g.kslice * 2 : 0))
    const unsigned ldsw = (unsigned)wid * 1024u;
    const int aoff = lds_byte(wr * 64 + fr, fq * 8), boff = lds_byte(wc * 32 + fr, fq * 8);
#define PG8_SA(b, h) (((b) * 2 + (h)) * HTB)
#define PG8_SB(b, h) ((4 + (b) * 2 + (h)) * HTB)
#define PG8_STAGE(bufoff, gbase, voff) do { _Pragma("unroll") for (int _i = 0; _i < 2; ++_i) \
        __builtin_amdgcn_global_load_lds((const unsigned*)((const char*)(gbase) + (voff)[_i]), (PG8_LAS unsigned*)(lds + (bufoff) + ldsw + _i * 8192), 16, 0, 0); } while (0)
#define PG8_LDA(dst, b, h) do { _Pragma("unroll") for (int m = 0; m < 4; ++m) _Pragma("unroll") for (int k = 0; k < 2; ++k) dst[m][k] = *(const PG8_LAS bf16x8*)(lds + PG8_SA(b, h) + aoff + m * 2048 + k * 1024); } while (0)
#define PG8_LDB(dst, b, h) do { _Pragma("unroll") for (int n = 0; n < 2; ++n) _Pragma("unroll") for (int k = 0; k < 2; ++k) dst[n][k] = *(const PG8_LAS bf16x8*)(lds + PG8_SB(b, h) + boff + n * 2048 + k * 1024); } while (0)
#define PG8_MMA(ai, bj, At, Bt) do { __builtin_amdgcn_s_setprio(1); _Pragma("unroll") for (int m = 0; m < 4; ++m) _Pragma("unroll") for (int n = 0; n < 2; ++n) _Pragma("unroll") for (int k = 0; k < 2; ++k) \
        acc[ai][bj][m][n] = __builtin_amdgcn_mfma_f32_16x16x32_bf16(Bt[n][k], At[m][k], acc[ai][bj][m][n], 0, 0, 0); __builtin_amdgcn_s_setprio(0); } while (0)
#define PG8_WAIT_V(n) asm volatile("s_waitcnt vmcnt(" #n ")" ::: "memory")
#define PG8_WAIT_L(n) asm volatile("s_waitcnt lgkmcnt(" #n ")" ::: "memory")
#define PG8_BAR __builtin_amdgcn_s_barrier()
#define PG8_SCHED __builtin_amdgcn_sched_barrier(0)
    Unit cur, nxt; int ui = 0;
    if (!S.next(0, cur)) return;
    f32x4 acc[2][2][4][2];
    typename Epi::Pre pre;
    if constexpr (Epi::HAS_PRE) E.prefetch(pre, cur, wr, fr);
    if constexpr (Epi::HAS_INIT) E.init(acc, cur, wr, wc, fr, fq);
    else {
#pragma unroll
    for (int a = 0; a < 2; ++a)
#pragma unroll
        for (int b = 0; b < 2; ++b)
#pragma unroll
            for (int m = 0; m < 4; ++m)
#pragma unroll
                for (int n = 0; n < 2; ++n) acc[a][b][m][n] = (f32x4){0.f, 0.f, 0.f, 0.f};
    }
    bf16x8 At[4][2], B0[2][2], B1[2][2];
    const char* cA = (const char*)g.A + (size_t)cur.pm * tstepA + PG8_KO(cur); const char* cB = (const char*)g.Bt + PG8_BT(cur) * tstepB + PG8_KO(cur);
    S.a_ready(cur);
    if constexpr (SP2) {
        PG8_STAGE(PG8_SB(0, 0), cB, voffB); PG8_STAGE(PG8_SB(0, 1), cB + hstepB, voffB); PG8_STAGE(PG8_SA(0, 0), cA, voffA); PG8_STAGE(PG8_SA(0, 1), cA + hstepA, voffA);
        if (wr == 1) PG8_BAR;
        PG8_WAIT_V(2); PG8_BAR;
        PG8_STAGE(PG8_SB(1, 0), cB + kstep, voffB); PG8_STAGE(PG8_SA(1, 0), cA + kstep, voffA); PG8_STAGE(PG8_SB(1, 1), cB + hstepB + kstep, voffB);
        PG8_WAIT_V(6); PG8_BAR;
    } else {
        PG8_STAGE(PG8_SB(0, 0), cB, voffB); PG8_STAGE(PG8_SA(0, 0), cA, voffA); PG8_STAGE(PG8_SB(0, 1), cB + hstepB, voffB); PG8_STAGE(PG8_SA(0, 1), cA + hstepA, voffA);
        if (wr == 1) PG8_BAR;
        PG8_WAIT_V(4); PG8_BAR;
        PG8_STAGE(PG8_SB(1, 0), cB + kstep, voffB); PG8_STAGE(PG8_SA(1, 0), cA + kstep, voffA); PG8_STAGE(PG8_SB(1, 1), cB + hstepB + kstep, voffB);
        PG8_WAIT_V(6); PG8_BAR;
    }
    for (;;) {
        const bool has_next = S.next(ui + 1, nxt);
        const char* nA = has_next ? (const char*)g.A + (size_t)nxt.pm * tstepA + PG8_KO(nxt) : cA; const char* nB = has_next ? (const char*)g.Bt + PG8_BT(nxt) * tstepB + PG8_KO(nxt) : cB;
        for (int t = 0; t < nt; t += 2) {
            const bool last = (t == nt - 2);
            if constexpr (Epi::MIDK) { if (t == (nt >> 1)) E.midk(acc, cur, wr, fr); }
            const char* a1 = cA + (size_t)(t + 1) * kstep;
            const char* a2 = last ? nA : cA + (size_t)(t + 2) * kstep; const char* b2 = last ? nB : cB + (size_t)(t + 2) * kstep;
            const char* a3 = a2 + kstep; const char* b3 = b2 + kstep;
            if (last && has_next) S.a_ready(nxt);
            if constexpr (SP2) {
            PG8_LDB(B0, 0, 0); PG8_LDB(B1, 0, 1); PG8_SCHED; PG8_LDA(At, 0, 0); PG8_STAGE(PG8_SA(1, 1), a1 + hstepA, voffA);
            PG8_WAIT_V(8); PG8_WAIT_L(0); PG8_BAR; PG8_MMA(0, 0, At, B0); PG8_MMA(0, 1, At, B1); PG8_BAR; PG8_SCHED;
            PG8_LDA(At, 0, 1); PG8_STAGE(PG8_SB(0, 0), b2, voffB); PG8_STAGE(PG8_SB(0, 1), b2 + hstepB, voffB); PG8_STAGE(PG8_SA(0, 0), a2, voffA);
            PG8_WAIT_V(8); PG8_WAIT_L(0); PG8_BAR; PG8_MMA(1, 0, At, B0); PG8_MMA(1, 1, At, B1); PG8_BAR; PG8_SCHED;
            PG8_LDB(B0, 1, 0); PG8_LDB(B1, 1, 1); PG8_SCHED; PG8_LDA(At, 1, 0); PG8_STAGE(PG8_SA(0, 1), a2 + hstepA, voffA);
            PG8_WAIT_V(8); PG8_WAIT_L(0); PG8_BAR; PG8_MMA(0, 0, At, B0); PG8_MMA(0, 1, At, B1); PG8_BAR; PG8_SCHED;
            PG8_LDA(At, 1, 1); PG8_STAGE(PG8_SB(1, 0), b3, voffB); PG8_STAGE(PG8_SB(1, 1), b3 + hstepB, voffB); PG8_STAGE(PG8_SA(1, 0), a3, voffA);
            PG8_WAIT_V(8); PG8_WAIT_L(0); PG8_BAR; PG8_MMA(1, 0, At, B0); PG8_MMA(1, 1, At, B1); PG8_BAR; PG8_SCHED;
            } else {
            PG8_LDB(B0, 0, 0); PG8_SCHED; PG8_LDA(At, 0, 0); PG8_STAGE(PG8_SA(1, 1), a1 + hstepA, voffA);
            PG8_WAIT_L(8); PG8_BAR; PG8_WAIT_L(0); PG8_MMA(0, 0, At, B0); PG8_BAR; PG8_SCHED;
            PG8_LDB(B1, 0, 1); PG8_STAGE(PG8_SB(0, 0), b2, voffB);
            PG8_BAR; PG8_WAIT_L(0); PG8_MMA(0, 1, At, B1); PG8_BAR;
            PG8_LDA(At, 0, 1); PG8_STAGE(PG8_SA(0, 0), a2, voffA);
            PG8_BAR; PG8_WAIT_L(0); PG8_MMA(1, 0, At, B0); PG8_BAR; PG8_SCHED;
            PG8_STAGE(PG8_SB(0, 1), b2 + hstepB, voffB);
            PG8_WAIT_V(6); PG8_BAR; PG8_MMA(1, 1, At, B1); PG8_BAR;
            PG8_LDB(B0, 1, 0); PG8_SCHED; PG8_LDA(At, 1, 0); PG8_STAGE(PG8_SA(0, 1), a2 + hstepA, voffA);
            PG8_WAIT_L(8); PG8_BAR; PG8_WAIT_L(0); PG8_MMA(0, 0, At, B0); PG8_BAR; PG8_SCHED;
            PG8_LDB(B1, 1, 1); PG8_STAGE(PG8_SB(1, 0), b3, voffB);
            PG8_BAR; PG8_WAIT_L(0); PG8_MMA(0, 1, At, B1); PG8_BAR;
            PG8_LDA(At, 1, 1); PG8_STAGE(PG8_SA(1, 0), a3, voffA);
            PG8_BAR; PG8_WAIT_L(0); PG8_MMA(1, 0, At, B0); PG8_BAR; PG8_SCHED;
            PG8_STAGE(PG8_SB(1, 1), b3 + hstepB, voffB);
            PG8_WAIT_V(6); PG8_BAR; PG8_MMA(1, 1, At, B1); PG8_BAR;
            }
        }
        if constexpr (ALIGN_EPI) { if (wr == 0) PG8_BAR; }
        if constexpr (!Epi::AFTER_DRAIN) { if constexpr (Epi::HAS_PRE) E(acc, cur, wr, wc, fr, fq, pre); else E(acc, cur, wr, wc, fr, fq); S.done(cur); }
        if (!has_next) break;
        if constexpr (Epi::HAS_PRE) E.prefetch(pre, nxt, wr, fr);
        if constexpr (Epi::HAS_INIT) E.init(acc, nxt, wr, wc, fr, fq);
        else {
#pragma unroll
        for (int a = 0; a < 2; ++a)
#pragma unroll
            for (int b = 0; b < 2; ++b)
#pragma unroll
                for (int m = 0; m < 4; ++m)
#pragma unroll
                    for (int n = 0; n < 2; ++n) acc[a][b][m][n] = (f32x4){0.f, 0.f, 0.f, 0.f};
        }
        cur = nxt; cA = nA; cB = nB; ++ui;
        if constexpr (ALIGN_EPI) { if (wr == 1) PG8_BAR; }
    }
    PG8_WAIT_V(0);
    if constexpr (!ALIGN_EPI) { if (wr == 0) PG8_BAR; }
    PG8_BAR;
    if constexpr (Epi::AFTER_DRAIN) { E.fused(acc, cur, wr, wc, fr, fq, lds, wid, lane); S.done(cur); }
#undef PG8_BT
#undef PG8_KO
#undef PG8_SA
#undef PG8_SB
#undef PG8_STAGE
#undef PG8_LDA
#undef PG8_LDB
#undef PG8_MMA
#undef PG8_WAIT_V
#undef PG8_WAIT_L
#undef PG8_BAR
#undef PG8_SCHED
}
}
namespace pg8 {
typedef float f32x2 __attribute__((ext_vector_type(2)));
typedef unsigned u32x2 __attribute__((ext_vector_type(2)));
__device__ __forceinline__ unsigned cvt_pk_bf16(float lo, float hi) { unsigned r; asm volatile("v_cvt_pk_bf16_f32 %0, %1, %2" : "=v"(r) : "v"(lo), "v"(hi)); return r; }
__device__ __forceinline__ u32x4 pack8(const f32x4 a, const f32x4 b) { u32x4 w; w.x = cvt_pk_bf16(a[0], a[1]); w.y = cvt_pk_bf16(a[2], a[3]); w.z = cvt_pk_bf16(b[0], b[1]); w.w = cvt_pk_bf16(b[2], b[3]); return w; }
__device__ __forceinline__ float fast_sigmoid(float x) { return __builtin_amdgcn_rcpf(1.f + __builtin_amdgcn_exp2f(-1.4426950408889634f * x)); }
__device__ __forceinline__ float fast_gelu_tanh(float x) { const float u2 = 1.5957691216057308f * (x + 0.044715f * x * x * x); return x * fast_sigmoid(u2); }
__device__ __forceinline__ float sum16(const float* p) { const f32x4 a = *(const f32x4*)p, b = *(const f32x4*)(p + 4), c = *(const f32x4*)(p + 8), d = *(const f32x4*)(p + 12);
    return ((a[0] + a[1]) + (a[2] + a[3])) + ((b[0] + b[1]) + (b[2] + b[3])) + ((c[0] + c[1]) + (c[2] + c[3])) + ((d[0] + d[1]) + (d[2] + d[3])); }
__device__ __forceinline__ float sum8(const float* p) { const f32x4 a = *(const f32x4*)p, b = *(const f32x4*)(p + 4); return ((a[0] + a[1]) + (a[2] + a[3])) + ((b[0] + b[1]) + (b[2] + b[3])); }
__device__ __forceinline__ float dot4(const f32x4 x) { return (x[0] * x[0] + x[1] * x[1]) + (x[2] * x[2] + x[3] * x[3]); }

struct RowScaleTable {
    const PG8_LAS float* tab; int pmA, pmB; const float* ssq;
    __device__ __forceinline__ float get(int pm, int row) const {
        if (pm == pmA) return tab[row & 255];
        if (pm == pmB) return tab[256 + (row & 255)];
        return __builtin_amdgcn_rsqf(sum16(ssq + (size_t)row * 16) * (1.f / cfg::D) + cfg::EPS);
    }
};
template <class Sched> __device__ __forceinline__ RowScaleTable make_row_scale_table(PG8_LAS float* tab, const float* ssq, const Sched& S, int tid) {
    RowScaleTable T; T.tab = tab; T.ssq = ssq; T.pmA = -1; T.pmB = -1;
    Unit u;
    for (int i = 0; S.next(i, u); ++i) { if (T.pmA < 0) T.pmA = u.pm; else if (u.pm != T.pmA && T.pmB < 0) T.pmB = u.pm; }
    const int pm = (tid < 256) ? T.pmA : T.pmB;
    if (pm >= 0) { const int row = pm * 256 + (tid & 255); tab[tid] = __builtin_amdgcn_rsqf(sum16(ssq + (size_t)row * 16) * (1.f / cfg::D) + cfg::EPS); }
    __syncthreads();
    return T;
}
struct EpiSwiGLU {
    static constexpr bool PERM = true, AFTER_DRAIN = false, MIDK = false, HAS_INIT = false, HAS_PRE = false; struct Pre {};
    bf16_t* Hh; bool scaled; RowScaleTable rt;
    __device__ __forceinline__ void operator()(const f32x4 (&acc)[2][2][4][2], const Unit& u, int wr, int wc, int fr, int fq) const {
        const int row0 = u.pm * BM + wr * 64 + fr, hcol = u.pn * 128 + wc * 32 + 8 * fq;
#pragma unroll
        for (int ai = 0; ai < 2; ++ai)
#pragma unroll
            for (int m = 0; m < 4; ++m) {
                const int row = row0 + ai * HALF + m * 16;
                const float rs = scaled ? rt.get(u.pm, row) : 1.f;
                f32x4 h0, h1;
#pragma unroll
                for (int n = 0; n < 2; ++n)
#pragma unroll
                    for (int i = 0; i < 4; i += 2) {
                        const f32x2 g = (f32x2){acc[ai][0][m][n][i], acc[ai][0][m][n][i + 1]} * rs, uu = (f32x2){acc[ai][1][m][n][i], acc[ai][1][m][n][i + 1]} * rs;
                        const f32x2 t = g * (-1.4426950408889634f);
                        f32x2 e; e.x = __builtin_amdgcn_exp2f(t.x); e.y = __builtin_amdgcn_exp2f(t.y);
                        const f32x2 d = e + 1.0f;
                        f32x2 r; r.x = __builtin_amdgcn_rcpf(d.x); r.y = __builtin_amdgcn_rcpf(d.y);
                        const f32x2 h = (g * uu) * r;
                        if (n == 0) { h0[i] = h.x; h0[i + 1] = h.y; } else { h1[i] = h.x; h1[i + 1] = h.y; }
                    }
                *(u32x4*)(Hh + (size_t)row * cfg::FF + hcol) = pack8(h0, h1);
            }
    }
};
template <int MODE> struct EpiResid {
    static constexpr bool PERM = true, AFTER_DRAIN = false, MIDK = (MODE == 1), HAS_INIT = true, HAS_PRE = false; struct Pre {};
    const float* resid32; bf16_t* XBp; float* ssq; const float* ssq_a; const float* ssq_s;
    __device__ __forceinline__ float rs_of(int row) const { return __builtin_amdgcn_rsqf(sum8(ssq_s + (size_t)row * 8) * (1.f / 512) + cfg::EPS); }
    __device__ __forceinline__ void midk(f32x4 (&acc)[2][2][4][2], const Unit& u, int wr, int fr) const {
        const int row0 = u.pm * BM + wr * 64 + fr;
#pragma unroll
        for (int ai = 0; ai < 2; ++ai)
#pragma unroll
            for (int m = 0; m < 4; ++m) {
                int row = row0 + ai * HALF + m * 16; asm volatile("" : "+v"(row));
                const f32x2 sa = *(const f32x2*)(ssq_a + (size_t)row * 2);
                const float ra = __builtin_amdgcn_rsqf((sa[0] + sa[1]) * (1.f / 512) + cfg::EPS);
                const float rho = ra * __builtin_amdgcn_rcpf(rs_of(row));
#pragma unroll
                for (int bj = 0; bj < 2; ++bj)
#pragma unroll
                    for (int n = 0; n < 2; ++n) acc[ai][bj][m][n] = acc[ai][bj][m][n] * rho;
            }
    }
    __device__ __forceinline__ void init(f32x4 (&acc)[2][2][4][2], const Unit& u, int wr, int wc, int fr, int fq) const {
        const int row0 = u.pm * BM + wr * 64 + fr, col0 = u.pn * BM + wc * 32 + 8 * fq;
#pragma unroll
        for (int ai = 0; ai < 2; ++ai)
#pragma unroll
            for (int m = 0; m < 4; ++m) {
                const int row = row0 + ai * HALF + m * 16;
                float s0 = 2.f;
                if (MODE == 1) { const f32x2 sa = *(const f32x2*)(ssq_a + (size_t)row * 2); s0 = __builtin_amdgcn_sqrtf((sa[0] + sa[1]) * (1.f / 512) + cfg::EPS); }
#pragma unroll
                for (int bj = 0; bj < 2; ++bj) {
                    const size_t off = (size_t)row * cfg::D + col0 + bj * HALF;
                    if (MODE == 0) { acc[ai][bj][m][0] = *(const f32x4*)(resid32 + off) * s0; acc[ai][bj][m][1] = *(const f32x4*)(resid32 + off + 4) * s0; }
                    else { const u32x4 w = *(const u32x4*)(XBp + off);
                        acc[ai][bj][m][0] = (f32x4){__uint_as_float(w.x << 16), __uint_as_float(w.x & 0xffff0000u), __uint_as_float(w.y << 16), __uint_as_float(w.y & 0xffff0000u)} * s0;
                        acc[ai][bj][m][1] = (f32x4){__uint_as_float(w.z << 16), __uint_as_float(w.z & 0xffff0000u), __uint_as_float(w.w << 16), __uint_as_float(w.w & 0xffff0000u)} * s0; }
                }
            }
    }
    __device__ __forceinline__ void operator()(const f32x4 (&acc)[2][2][4][2], const Unit& u, int wr, int wc, int fr, int fq) const {
        const int row0 = u.pm * BM + wr * 64 + fr, col0 = u.pn * BM + wc * 32 + 8 * fq;
#pragma unroll
        for (int ai = 0; ai < 2; ++ai)
#pragma unroll
            for (int m = 0; m < 4; ++m) {
                int row = row0 + ai * HALF + m * 16; if (MODE == 1) asm volatile("" : "+v"(row));
                const float sc = MODE == 1 ? rs_of(row) : 0.5f;
                float sq = 0.f;
#pragma unroll
                for (int bj = 0; bj < 2; ++bj) {
                    const f32x4 x0 = acc[ai][bj][m][0] * sc, x1 = acc[ai][bj][m][1] * sc;
                    sq += dot4(x0) + dot4(x1);
                    *(u32x4*)(XBp + (size_t)row * cfg::D + col0 + bj * HALF) = pack8(x0, x1);
                }
                sq += __shfl_xor(sq, 16); sq += __shfl_xor(sq, 32);
                if (fq == 0) ssq[(size_t)row * 16 + u.pn * 4 + wc] = sq;
            }
    }
};
struct EpiWin {
    static constexpr bool PERM = true, AFTER_DRAIN = false, MIDK = false, HAS_INIT = false, HAS_PRE = false; struct Pre {};
    MixBufs mb; RowScaleTable rt;
    __device__ __forceinline__ void operator()(const f32x4 (&acc)[2][2][4][2], const Unit& u, int wr, int wc, int fr, int fq) const {
        using namespace cfg;
        const int row0 = u.pm * BM + wr * 64 + fr, colb = u.pn * BM + wc * 32 + 8 * fq;
#pragma unroll
        for (int ai = 0; ai < 2; ++ai)
#pragma unroll
            for (int m = 0; m < 4; ++m) {
                const int row = row0 + ai * HALF + m * 16, b = row >> 12, t = row & (T - 1);
                const float rs = rt.get(u.pm, row);
#pragma unroll
                for (int bj = 0; bj < 2; ++bj) {
                    const int col = colb + bj * HALF;
                    f32x4 v0 = acc[ai][bj][m][0] * rs, v1 = acc[ai][bj][m][1] * rs;
                    if (col < 512) { const int h = col >> 6, d = col & 63; *(u32x4*)(mb.Q + (((size_t)(b * NH + h)) * T + t) * 64 + d) = pack8(v0 * C2, v1 * C2); }
                    else if (col < 1280) { const int c = col - 512, part = c >> 7, g = (c >> 6) & 1, d = c & 63; *(u32x4*)(mb.KV + (size_t)part * KVPART + (((size_t)(b * 2 + g)) * T + t) * 64 + d) = pack8(v0, v1); }
                    else if (col < 1304) { const int c = col - 1280; const f32x4 b0 = *(const f32x4*)(mb.gate_bias + c), b1 = *(const f32x4*)(mb.gate_bias + c + 4);
#pragma unroll
                        for (int i = 0; i < 4; ++i) { v0[i] = fast_sigmoid(v0[i] + b0[i]); v1[i] = fast_sigmoid(v1[i] + b1[i]); }
                        *(f32x4*)(mb.GATES + (size_t)row * 24 + c) = v0; *(f32x4*)(mb.GATES + (size_t)row * 24 + c + 4) = v1; }
                    else if (col < INC) { const int c = col - 1304, g = c >> 4, h = c & 15; *(u32x4*)(mb.UX + ((size_t)(g * 2048 + b * 256 + (t >> 4))) * 384 + (t & 15) * 16 + h) = pack8(v0, v1); }
                }
            }
    }
};
struct EpiPart {
    static constexpr bool PERM = false, AFTER_DRAIN = false, MIDK = false, HAS_INIT = false, HAS_PRE = false; struct Pre {};
    float* PART;
    __device__ __forceinline__ void operator()(const f32x4 (&acc)[2][2][4][2], const Unit& u, int wr, int wc, int fr, int fq) const {
        const int row0 = u.pm * BM + wr * 64 + fr, col0 = wc * 32 + 4 * fq; float* P = PART + (size_t)u.pn * 4096 * 256;
#pragma unroll
        for (int ai = 0; ai < 2; ++ai)
#pragma unroll
            for (int m = 0; m < 4; ++m)
#pragma unroll
                for (int bj = 0; bj < 2; ++bj)
#pragma unroll
                    for (int n = 0; n < 2; ++n) *(f32x4*)(P + (size_t)(row0 + ai * HALF + m * 16) * 256 + col0 + bj * HALF + n * 16) = acc[ai][bj][m][n];
    }
};
struct EpiS5S {
    static constexpr bool PERM = false, AFTER_DRAIN = false, MIDK = false, HAS_INIT = false, HAS_PRE = false; struct Pre {};
    float* S;
    __device__ __forceinline__ void operator()(const f32x4 (&acc)[2][2][4][2], const Unit& u, int wr, int wc, int fr, int fq) const {
        const int row0 = u.pm * BM + wr * 64 + fr, col0 = wc * 32 + 4 * fq;
#pragma unroll
        for (int ai = 0; ai < 2; ++ai)
#pragma unroll
            for (int m = 0; m < 4; ++m)
#pragma unroll
                for (int n = 0; n < 2; ++n) *(f32x4*)(S + (size_t)(row0 + ai * HALF + m * 16) * 128 + col0 + n * 16) = acc[ai][0][m][n];
    }
};
struct EpiS5Y {
    static constexpr bool PERM = true, AFTER_DRAIN = false, MIDK = false, HAS_INIT = false, HAS_PRE = false; struct Pre {};
    bf16_t* YG;
    __device__ __forceinline__ void operator()(const f32x4 (&acc)[2][2][4][2], const Unit& u, int wr, int wc, int fr, int fq) const {
        const int row0 = u.pm * BM + wr * 64 + fr, colb = wc * 32 + 8 * fq;
#pragma unroll
        for (int ai = 0; ai < 2; ++ai)
#pragma unroll
            for (int m = 0; m < 4; ++m) {
                int R = row0 + ai * HALF + m * 16; asm volatile("" : "+v"(R));
                const int g = R >> 11, rr = R & 2047, b = rr >> 8, c = rr & 255;
#pragma unroll
                for (int bj = 0; bj < 2; ++bj) {
                    const int col = colb + bj * HALF, tl = col >> 4, h = col & 15;
                    f32x4 v0 = acc[ai][bj][m][0], v1 = acc[ai][bj][m][1];
#pragma unroll
                    for (int i = 0; i < 4; ++i) { v0[i] = fast_gelu_tanh(v0[i]); v1[i] = fast_gelu_tanh(v1[i]); }
                    *(u32x4*)(YG + ((size_t)(b * cfg::T + c * 16 + tl)) * 512 + g * 16 + h) = pack8(v0, v1);
                }
                __builtin_amdgcn_sched_barrier(0);
            }
    }
};
struct EpiGLU {
    static constexpr bool PERM = true, AFTER_DRAIN = false, MIDK = false, HAS_INIT = false, HAS_PRE = false; struct Pre {};
    const bf16_t* YG; const float* bias; bf16_t* SSM; float* ssq;
    __device__ __forceinline__ void operator()(const f32x4 (&acc)[2][2][4][2], const Unit& u, int wr, int wc, int fr, int fq) const {
        const int row0 = u.pm * BM + wr * 64 + fr, colb = u.pn * BM + wc * 32 + 8 * fq;
#pragma unroll
        for (int ai = 0; ai < 2; ++ai)
#pragma unroll
            for (int m = 0; m < 4; ++m) {
                const int row = row0 + ai * HALF + m * 16; float sq = 0.f;
#pragma unroll
                for (int bj = 0; bj < 2; ++bj) {
                    const int col = colb + bj * HALF;
                    const f32x4 b0 = *(const f32x4*)(bias + col), b1 = *(const f32x4*)(bias + col + 4);
                    const u32x4 yw = *(const u32x4*)(YG + (size_t)row * 512 + col);
                    f32x4 y0, y1;
                    y0[0] = __uint_as_float(yw.x << 16); y0[1] = __uint_as_float(yw.x & 0xffff0000u); y0[2] = __uint_as_float(yw.y << 16); y0[3] = __uint_as_float(yw.y & 0xffff0000u);
                    y1[0] = __uint_as_float(yw.z << 16); y1[1] = __uint_as_float(yw.z & 0xffff0000u); y1[2] = __uint_as_float(yw.w << 16); y1[3] = __uint_as_float(yw.w & 0xffff0000u);
                    f32x4 v0, v1;
#pragma unroll
                    for (int i = 0; i < 4; ++i) { v0[i] = y0[i] * fast_sigmoid(acc[ai][bj][m][0][i] + b0[i]); v1[i] = y1[i] * fast_sigmoid(acc[ai][bj][m][1][i] + b1[i]); }
                    sq += dot4(v0) + dot4(v1);
                    *(u32x4*)(SSM + (size_t)row * cfg::MIXP + col) = pack8(v0, v1);
                }
                sq += __shfl_xor(sq, 16); sq += __shfl_xor(sq, 32);
                if (fq == 0) ssq[(size_t)row * 8 + u.pn * 4 + wc] = sq;
            }
    }
};
}
constexpr int NWAVES = 8;
constexpr int RING_BYTES = 131072;
constexpr int LDSCTL_OFF = RING_BYTES, MISC_OFF = LDSCTL_OFF + 320;
constexpr int BIAS_OFF = RING_BYTES + 1024;
constexpr int LDS_BYTES = 147456;
constexpr size_t WS_CBP = wsl::S5A + 64 * 1024;

struct Args { const float* in[34]; float* out; unsigned char* ws; int ph_lo, ph_hi; };

struct Frame { LAS unsigned char* lds; int wave, G, gw, NGW; __device__ __forceinline__ int tid() const { return wave * 64 + lane_id(); } };

__device__ __forceinline__ float wave_sum(float v) {
#pragma unroll
    for (int o = 1; o < 64; o <<= 1) v += __shfl_xor(v, o);
    return v;
}
__device__ __forceinline__ void tr_item(const float* __restrict__ W, int N, int Npad, const float* __restrict__ gain, bf16_t* WT, int ldt, int mode, LAS float* scr, int item, int lane) {
    const int nblk = Npad / 32, kb = item / nblk, nb = item % nblk, k0 = 64 * kb, n0 = 32 * nb;
    const int kk8 = lane >> 3, n4 = (lane & 7) * 4; const bool ok = (n0 + n4) < N;
    f32x4 v[8];
#pragma unroll
    for (int i = 0; i < 8; ++i) v[i] = ok ? *(const GAS f32x4*)(W + (size_t)(k0 + 8 * i + kk8) * N + n0 + n4) : (f32x4){0.f, 0.f, 0.f, 0.f};
#pragma unroll
    for (int i = 0; i < 8; ++i) { const int kk = 8 * i + kk8; const float gk = gain ? gain[k0 + kk] : 1.f; LAS float* d = scr + kk * 33 + n4;
        d[0] = v[i].x * gk; d[1] = v[i].y * gk; d[2] = v[i].z * gk; d[3] = v[i].w * gk; }
    LDS_WAIT(); asm volatile("" ::: "memory");
    const int c = lane & 7;
#pragma unroll
    for (int j = 0; j < 4; ++j) { const int nl = (lane >> 3) + 8 * j, n = n0 + nl; const LAS float* s = scr + (8 * c) * 33 + nl;
        const int row = mode == 0 ? n : ((n >> 7) * 256 + (mode == 2 ? 128 : 0) + (n & 127));
        v4u o; o.x = pk2(s[0 * 33], s[1 * 33]); o.y = pk2(s[2 * 33], s[3 * 33]); o.z = pk2(s[4 * 33], s[5 * 33]); o.w = pk2(s[6 * 33], s[7 * 33]);
        *(GAS v4u*)(WT + (size_t)row * ldt + k0 + 8 * c) = o; }
    LDS_WAIT(); asm volatile("" ::: "memory");
}
struct S5P { float xr, xi, fr, fi; };
__device__ __forceinline__ S5P s5_param(const float* const* in, int g, int p) {
    const float dt = expf(in[18][g]), lr = in[16][g * 64 + p], li = in[17][g * 64 + p];
    S5P q; q.xr = lr * dt; q.xi = li * dt;
    const float mag = expf(q.xr), ar = mag * cosf(q.xi), ai = mag * sinf(q.xi), nr = ar - 1.f, den = lr * lr + li * li;
    q.fr = (nr * lr + ai * li) / den; q.fi = (ai * lr - nr * li) / den; return q;
}
__device__ __forceinline__ void cpow(const S5P& q, int n, float& re, float& im) { const float mag = expf(n * q.xr), ang = n * q.xi; re = mag * cosf(ang); im = mag * sinf(ang); }

__device__ __forceinline__ void p0_prologue(Frame& F, const Args& a) {
    using namespace cfg;
    unsigned char* ws = a.ws; const float* const* in = a.in;
    LAS float* scr = (LAS float*)(F.lds + F.wave * 16384);
    const int lane = lane_id();
    bf16_t* BTS = (bf16_t*)(ws + wsl::BTS); bf16_t* BTY = (bf16_t*)(ws + wsl::BTY);
    constexpr int N_KT = SGRP * 31, N_V = SGRP * 16, N_S = SGRP * 16, N_Z = SGRP * 8, N_A = SGRP, N_CB = 2 * 4 * 16;
    constexpr int NS5 = N_KT + N_V + N_S + N_Z + N_A + N_CB;
    for (int it = F.gw; it < NS5; it += F.NGW) {
        int r = it;
        if (r < N_KT) {
            const int g = r / 31, tau = r % 31 - 15; bf16_t* Bg = BTY + (size_t)g * 256 * 384;
            if (tau < 0) {
                for (int t = 0; t <= 15 + tau; ++t) { const int s = t - tau;
#pragma unroll
                    for (int e = 0; e < 4; ++e) { const int idx = lane + 64 * e, h = idx >> 4, h2 = idx & 15; Bg[(size_t)(t * 16 + h) * 384 + s * 16 + h2] = 0; } }
                continue;
            }
            const int p = lane; const S5P q = s5_param(in, g, p); float pr, pi; cpow(q, tau, pr, pi);
            float car[16], cai[16];
#pragma unroll
            for (int h = 0; h < 16; ++h) { const float cr = in[21][(size_t)(g * 16 + h) * 64 + p], ci = in[22][(size_t)(g * 16 + h) * 64 + p]; car[h] = cr * pr - ci * pi; cai[h] = cr * pi + ci * pr; }
            float keep[4] = {0.f, 0.f, 0.f, 0.f};
#pragma unroll 1
            for (int h2 = 0; h2 < 16; ++h2) {
                const float br = in[19][(size_t)(g * 64 + p) * 16 + h2], bi = in[20][(size_t)(g * 64 + p) * 16 + h2];
                const float bbr = q.fr * br - q.fi * bi, bbi = q.fr * bi + q.fi * br;
#pragma unroll
                for (int h = 0; h < 16; ++h) { const float v = wave_sum(car[h] * bbr - cai[h] * bbi); if ((((h & 3) << 4) | h2) == lane) keep[h >> 2] = v; }
            }
#pragma unroll
            for (int e = 0; e < 4; ++e) { const int idx = lane + 64 * e, h = idx >> 4, h2 = idx & 15;
                const float v = keep[e] + ((tau == 0 && h == h2) ? in[23][g * 16 + h] : 0.f); const bf16_t w = f2bf(v);
                for (int t = tau; t < 16; ++t) Bg[(size_t)(t * 16 + h) * 384 + (t - tau) * 16 + h2] = w; }
            continue;
        } r -= N_KT;
        if (r < N_V) {
            const int g = r >> 4, t = r & 15, p = lane; const S5P q = s5_param(in, g, p); float pr, pi; cpow(q, t + 1, pr, pi);
            bf16_t* Bg = BTY + (size_t)g * 256 * 384;
#pragma unroll
            for (int h = 0; h < 16; ++h) { const float cr = in[21][(size_t)(g * 16 + h) * 64 + p], ci = in[22][(size_t)(g * 16 + h) * 64 + p];
                Bg[(size_t)(t * 16 + h) * 384 + 256 + p] = f2bf(cr * pr - ci * pi); Bg[(size_t)(t * 16 + h) * 384 + 320 + p] = f2bf(-(cr * pi + ci * pr)); }
            continue;
        } r -= N_V;
        if (r < N_S) {
            const int g = r >> 4, s = r & 15, p = lane; const S5P q = s5_param(in, g, p); float pr, pi; cpow(q, 15 - s, pr, pi);
            bf16_t* Bg = BTS + (size_t)g * 256 * 256;
#pragma unroll
            for (int h = 0; h < 16; ++h) { const float br = in[19][(size_t)(g * 64 + p) * 16 + h], bi = in[20][(size_t)(g * 64 + p) * 16 + h];
                const float bbr = q.fr * br - q.fi * bi, bbi = q.fr * bi + q.fi * br;
                Bg[(size_t)p * 256 + s * 16 + h] = f2bf(pr * bbr - pi * bbi); Bg[(size_t)(64 + p) * 256 + s * 16 + h] = f2bf(pr * bbi + pi * bbr); }
            continue;
        } r -= N_S;
        if (r < N_Z) {
            const int g = r >> 3, blk = r & 7; GAS v4u* z = (GAS v4u*)(BTS + (size_t)g * 256 * 256 + (size_t)(128 + 16 * blk) * 256);
            for (int i = lane; i < 16 * 256 * 2 / 16; i += 64) z[i] = (v4u){0u, 0u, 0u, 0u};
            continue;
        } r -= N_Z;
        if (r < N_A) { const int g = r, p = lane; const S5P q = s5_param(in, g, p); float pr, pi; cpow(q, LCH, pr, pi); float* A16 = (float*)(ws + wsl::S5A); A16[(g * 64 + p) * 2] = pr; A16[(g * 64 + p) * 2 + 1] = pi; continue; } r -= N_A;
        {
            const int ten = r >> 6, nb = (r >> 4) & 3, ks = r & 15, n = nb * 64 + lane; const float* pos = ten ? in[9] : in[8]; const float* w1 = ten ? in[13] : in[10];
            float acc = 0.f;
            for (int kk = ks * 128; kk < ks * 128 + 128; ++kk) acc += pos[kk] * w1[(size_t)kk * 256 + n];
            ((float*)(ws + WS_CBP))[(ten * 16 + ks) * 256 + n] = acc;
        }
    }
    constexpr int I_GU = 16 * 88, I_DN = 44 * 32, I_WIN = 16 * 64, I_WO = 8 * 32, I_C1 = 32 * 8, I_C2 = 4 * 2, I_GLU = 8 * 16;
    constexpr int NTR = 2 * (2 * I_GU + I_DN) + I_WIN + 2 * I_WO + 2 * I_C1 + 2 * I_C2 + I_GLU;
    for (int it = F.gw; it < NTR; it += F.NGW) {
        int r = it;
        if (r < I_GU) { tr_item(in[2], FF, FF, in[1], (bf16_t*)(ws + wsl::W1A), D, 1, scr, r, lane); continue; } r -= I_GU;
        if (r < I_GU) { tr_item(in[3], FF, FF, in[1], (bf16_t*)(ws + wsl::W1A), D, 2, scr, r, lane); continue; } r -= I_GU;
        if (r < I_DN) { tr_item(in[4], D, D, nullptr, (bf16_t*)(ws + wsl::W1D), FF, 0, scr, r, lane); continue; } r -= I_DN;
        if (r < I_GU) { tr_item(in[30], FF, FF, in[29], (bf16_t*)(ws + wsl::W2A), D, 1, scr, r, lane); continue; } r -= I_GU;
        if (r < I_GU) { tr_item(in[31], FF, FF, in[29], (bf16_t*)(ws + wsl::W2A), D, 2, scr, r, lane); continue; } r -= I_GU;
        if (r < I_DN) { tr_item(in[32], D, D, nullptr, (bf16_t*)(ws + wsl::W2D), FF, 0, scr, r, lane); continue; } r -= I_DN;
        if (r < I_WIN) { tr_item(in[6], INC, INC_PAD, in[5], (bf16_t*)(ws + wsl::WIN), D, 0, scr, r, lane); continue; } r -= I_WIN;
        if (r < I_WO) { tr_item(in[28], D, D, in[26], (bf16_t*)(ws + wsl::WOUT), D, 0, scr, r, lane); continue; } r -= I_WO;
        if (r < I_WO) { tr_item(in[28] + (size_t)512 * D, D, D, in[27], (bf16_t*)(ws + wsl::WOUT) + 512, D, 0, scr, r, lane); continue; } r -= I_WO;
        if (r < I_C1) { tr_item(in[10], 256, 256, nullptr, (bf16_t*)(ws + wsl::CW1K), 2048, 0, scr, r, lane); continue; } r -= I_C1;
        if (r < I_C1) { tr_item(in[13], 256, 256, nullptr, (bf16_t*)(ws + wsl::CW1V), 2048, 0, scr, r, lane); continue; } r -= I_C1;
        if (r < I_C2) { tr_item(in[12], 64, 64, nullptr, (bf16_t*)(ws + wsl::CW2K), 256, 0, scr, r, lane); continue; } r -= I_C2;
        if (r < I_C2) { tr_item(in[15], 64, 64, nullptr, (bf16_t*)(ws + wsl::CW2V), 256, 0, scr, r, lane); continue; } r -= I_C2;
        tr_item(in[24], 512, 512, nullptr, (bf16_t*)(ws + wsl::GLUW), 512, 0, scr, r, lane);
    }
    for (int m = F.gw; m < M; m += 2 * F.NGW) {
        const int m2 = m + F.NGW;
        const GAS f32x4* xr = (const GAS f32x4*)(in[0] + (size_t)m * D) + lane; const GAS f32x4* xr2 = (const GAS f32x4*)(in[0] + (size_t)(m2 < M ? m2 : m) * D) + lane;
        f32x4 v[4], w[4]; float s = 0.f, s2 = 0.f;
#pragma unroll
        for (int j = 0; j < 4; ++j) { v[j] = xr[64 * j]; w[j] = xr2[64 * j]; }
#pragma unroll
        for (int j = 0; j < 4; ++j) { s += (v[j].x * v[j].x + v[j].y * v[j].y) + (v[j].z * v[j].z + v[j].w * v[j].w); s2 += (w[j].x * w[j].x + w[j].y * w[j].y) + (w[j].z * w[j].z + w[j].w * w[j].w); }
        const float r = rsqrtf(wave_sum(s) * (1.f / D) + EPS), r2 = rsqrtf(wave_sum(s2) * (1.f / D) + EPS);
        GAS unsigned long long* o8 = (GAS unsigned long long*)((bf16_t*)(ws + wsl::XB) + (size_t)m * D) + lane;
#pragma unroll
        for (int j = 0; j < 4; ++j) o8[64 * j] = (unsigned long long)pk2(v[j].x * r, v[j].y * r) | ((unsigned long long)pk2(v[j].z * r, v[j].w * r) << 32);
        if (m2 < M) { GAS unsigned long long* p8 = (GAS unsigned long long*)((bf16_t*)(ws + wsl::XB) + (size_t)m2 * D) + lane;
#pragma unroll
            for (int j = 0; j < 4; ++j) p8[64 * j] = (unsigned long long)pk2(w[j].x * r2, w[j].y * r2) | ((unsigned long long)pk2(w[j].z * r2, w[j].w * r2) << 32); }
    }
}
__device__ __forceinline__ void s5_scan_task(const Args& a, int bg, int lane) {
    using namespace cfg;
    const int g = bg & 31, b = bg >> 5, p = lane;
    const float* A16 = (const float*)(a.ws + wsl::S5A); const float ar = A16[(g * 64 + p) * 2], ai = A16[(g * 64 + p) * 2 + 1];
    const float* S = (const float*)(a.ws + wsl::S) + ((size_t)(g * 2048 + b * 256)) * 128; bf16_t* UX = (bf16_t*)(a.ws + wsl::UX) + ((size_t)(g * 2048 + b * 256)) * 384 + 256;
    float xr = 0.f, xi = 0.f;
    for (int c0 = 0; c0 < NCHUNK; c0 += 16) {
        float sr[16], si[16];
#pragma unroll
        for (int j = 0; j < 16; ++j) { sr[j] = S[(size_t)(c0 + j) * 128 + p]; si[j] = S[(size_t)(c0 + j) * 128 + 64 + p]; }
#pragma unroll
        for (int j = 0; j < 16; ++j) {
            UX[(size_t)(c0 + j) * 384 + p] = f2bf(xr); UX[(size_t)(c0 + j) * 384 + 64 + p] = f2bf(xi);
            const float nr = ar * xr - ai * xi + sr[j], ni = ar * xi + ai * xr + si[j]; xr = nr; xi = ni;
        }
    }
}
__device__ __forceinline__ void cmp_out_task(const float* __restrict__ PART, const LAS float* bias, const bf16_t* __restrict__ W2t, bf16_t* OUT, int task, int lane) {
    const int row0 = task * 16, fr = lane & 15, fq = lane >> 4;
    f32x4 acc[4];
#pragma unroll
    for (int nb = 0; nb < 4; ++nb) acc[nb] = (f32x4){0.f, 0.f, 0.f, 0.f};
#pragma unroll 2
    for (int ks = 0; ks < 8; ++ks) {
        const int c0 = ks * 32 + 8 * fq; const float* pp = PART + (size_t)(row0 + fr) * 256 + c0;
        f32x4 h0 = (f32x4){bias[c0], bias[c0 + 1], bias[c0 + 2], bias[c0 + 3]}, h1 = (f32x4){bias[c0 + 4], bias[c0 + 5], bias[c0 + 6], bias[c0 + 7]};
#pragma unroll
        for (int sl = 0; sl < 4; ++sl) { h0 = h0 + *(const f32x4*)(pp + (size_t)sl * 4096 * 256); h1 = h1 + *(const f32x4*)(pp + (size_t)sl * 4096 * 256 + 4); }
#pragma unroll
        for (int i = 0; i < 4; ++i) { h0[i] = pg8::fast_gelu_tanh(h0[i]); h1[i] = pg8::fast_gelu_tanh(h1[i]); }
        const bf16x8 af = __builtin_bit_cast(bf16x8, pg8::pack8(h0, h1));
#pragma unroll
        for (int nb = 0; nb < 4; ++nb) { const bf16x8 bfr = *(const bf16x8*)(W2t + (size_t)(nb * 16 + fr) * 256 + ks * 32 + 8 * fq); acc[nb] = __builtin_amdgcn_mfma_f32_16x16x32_bf16(af, bfr, acc[nb], 0, 0, 0); }
    }
#pragma unroll
    for (int nb = 0; nb < 4; ++nb)
#pragma unroll
        for (int i = 0; i < 4; ++i) OUT[(size_t)(row0 + 4 * fq + i) * 64 + nb * 16 + fr] = f2bf(acc[nb][i]);
}
#define HAVE_FAST_ATTN 1
namespace att {
typedef float f32x16 __attribute__((ext_vector_type(16)));
typedef short v4i16 __attribute__((ext_vector_type(4)));
constexpr int KOFF = 0, VOFF = 16384, IMPP_OFF = 32768, SC_OFF = 98304, MASK_OFF = 114688, SSQP_OFF = 115200;
constexpr float THR = 8.f, MINIT = -1e30f;
__device__ __forceinline__ int crow(int r, int hi) { return (r & 3) + 8 * (r >> 2) + 4 * hi; }
__device__ __forceinline__ f32x16 zero16() { f32x16 z;
#pragma unroll
    for (int i = 0; i < 16; ++i) z[i] = 0.f; return z; }
__device__ __forceinline__ void qk_tile(const LAS unsigned char* Kb, const bf16x8 (&qr)[4], int r32, int hi, f32x16& p0, f32x16& p1) {
    p0 = zero16(); p1 = zero16();
    bf16x8 a0[4], a1[4];
#pragma unroll
    for (int d0 = 0; d0 < 4; ++d0) { const int off = r32 * 128 + (((2 * d0 + hi) ^ ((r32 >> 1) & 7)) << 4); a0[d0] = *(const LAS bf16x8*)(Kb + off); a1[d0] = *(const LAS bf16x8*)(Kb + 4096 + off); }
    __builtin_amdgcn_sched_barrier(0);
#pragma unroll
    for (int d0 = 0; d0 < 4; ++d0) {
        p0 = __builtin_amdgcn_mfma_f32_32x32x16_bf16(a0[d0], qr[d0], p0, 0, 0, 0);
        p1 = __builtin_amdgcn_mfma_f32_32x32x16_bf16(a1[d0], qr[d0], p1, 0, 0, 0);
    }
}
__device__ __forceinline__ bf16x8 pack_p(const f32x16& p, int s) {
    pg8::u32x4 w; w.x = pg8::cvt_pk_bf16(p[8 * s], p[8 * s + 1]); w.y = pg8::cvt_pk_bf16(p[8 * s + 2], p[8 * s + 3]); w.z = pg8::cvt_pk_bf16(p[8 * s + 4], p[8 * s + 5]); w.w = pg8::cvt_pk_bf16(p[8 * s + 6], p[8 * s + 7]);
    return __builtin_bit_cast(bf16x8, w);
}
__device__ __forceinline__ v4i16 vtr(const LAS unsigned char* p) { return __builtin_amdgcn_ds_read_tr16_b64_v4i16((LAS v4i16*)p); }
__device__ __forceinline__ void pv_tile(const LAS unsigned char* Vb, int vl0, const f32x16& p0, const f32x16& p1, f32x16 (&o)[2]) {
    bf16x8 pf[4];
#pragma unroll
    for (int i = 0; i < 4; ++i) pf[i] = pack_p((i >> 1) ? p1 : p0, i & 1);
#pragma unroll
    for (int db = 0; db < 2; ++db) {
        v4i16 lo[4], hi4[4];
#pragma unroll
        for (int i = 0; i < 4; ++i) { const LAS unsigned char* vp = Vb + (vl0 ^ (db * 64)) + (i >> 1) * 4096 + (i & 1) * 2048; lo[i] = vtr(vp); hi4[i] = vtr(vp + 1024); }
        __builtin_amdgcn_sched_barrier(0);
#pragma unroll
        for (int i = 0; i < 4; ++i) { const bf16x8 vf = (bf16x8){lo[i][0], lo[i][1], lo[i][2], lo[i][3], hi4[i][0], hi4[i][1], hi4[i][2], hi4[i][3]};
            o[db] = __builtin_amdgcn_mfma_f32_32x32x16_bf16(vf, pf[i], o[db], 0, 0, 0); }
    }
}
__device__ __forceinline__ float other32(float x, int hi) { const auto rr = __builtin_amdgcn_permlane32_swap(__float_as_uint(x), __float_as_uint(x), false, false); return __uint_as_float(hi ? rr[0] : rr[1]); }
__device__ __forceinline__ unsigned dpp_or8(unsigned x) {
    x |= (unsigned)__builtin_amdgcn_update_dpp(0, (int)x, 0xB1, 0xF, 0xF, true); x |= (unsigned)__builtin_amdgcn_update_dpp(0, (int)x, 0x4E, 0xF, 0xF, true); x |= (unsigned)__builtin_amdgcn_update_dpp(0, (int)x, 0x141, 0xF, 0xF, true); return x; }
__device__ __forceinline__ float max3f(float a, float b, float c) { float r; asm("v_max3_f32 %0, %1, %2, %3" : "=v"(r) : "v"(a), "v"(b), "v"(c)); return r; }
__device__ __forceinline__ float max2f(float a, float b) { float r; asm("v_max_f32_e32 %0, %1, %2" : "=v"(r) : "v"(a), "v"(b)); return r; }
__device__ __forceinline__ float max32(const f32x16& p, const f32x16& q) {
    float a = max3f(p[0], p[1], q[0]), b = max3f(p[2], p[3], q[1]); a = max3f(a, q[2], q[3]);
#pragma unroll
    for (int r = 4; r < 16; r += 4) { a = max3f(a, p[r], p[r + 1]); b = max3f(b, p[r + 2], p[r + 3]); a = max3f(a, q[r], q[r + 1]); b = max3f(b, q[r + 2], q[r + 3]); }
    return max2f(a, b);
}
__device__ __forceinline__ float max16(const f32x16& p) { float a = max3f(p[0], p[1], p[2]), b = max3f(p[3], p[4], p[5]); a = max3f(a, p[6], p[7]); b = max3f(b, p[8], p[9]); a = max3f(a, p[10], p[11]); b = max3f(b, p[12], p[13]); a = max3f(a, p[14], p[15]); return max2f(a, b); }
__device__ __forceinline__ float sum16v(const f32x16& p) { return (((p[0] + p[1]) + (p[2] + p[3])) + ((p[4] + p[5]) + (p[6] + p[7]))) + (((p[8] + p[9]) + (p[10] + p[11])) + ((p[12] + p[13]) + (p[14] + p[15]))); }
__device__ __forceinline__ void mask_range(f32x16& p, int sub, int hi, int lo, int hi_) {
    const int base = 32 * sub + 4 * hi;
#pragma unroll
    for (int r = 0; r < 16; ++r) { const int k = base + (r & 3) + 8 * (r >> 2); if (k < lo || k > hi_) p[r] = -INFINITY; }
}
__device__ __forceinline__ void softmax_pv(const LAS unsigned char* Vb, int vl0, f32x16& p0, f32x16& p1, float& m, float& l, f32x16 (&o)[2]) {
    float tmax = fmaxf(max16(p0), max16(p1)); tmax = fmaxf(tmax, __shfl_xor(tmax, 32));
    if (__any(tmax > m + THR)) { const float mn = fmaxf(m, tmax), f = __builtin_amdgcn_exp2f(m - mn); o[0] = o[0] * f; o[1] = o[1] * f; l *= f; m = mn; }
#pragma unroll
    for (int r = 0; r < 16; ++r) { p0[r] = __builtin_amdgcn_exp2f(p0[r] - m); p1[r] = __builtin_amdgcn_exp2f(p1[r] - m); }
    l += sum16v(p0) + sum16v(p1);
    pv_tile(Vb, vl0, p0, p1, o);
}

#define ATT_GLD(P, t) (*(const v4u*)((P) + (size_t)(t) * 4096 + tid * 8))
#define ATT_SEQ_LOAD(i_) do { const int i__ = (i_); if (i__ < te_) { if (!(VAR & 1024) || (i__ & 3) == 0) { gK = ATT_GLD(Kg_, i__); gV = ATT_GLD(Vg_, i__); } } \
        else if (NKg_ && ntb_ + (i__ - te_) < nte_) { gK = ATT_GLD(NKg_, ntb_ + (i__ - te_)); gV = ATT_GLD(NVg_, ntb_ + (i__ - te_)); } } while (0)
#define ATT_LOOP_BEGIN(Kg, Vg, tbeg, tend, NKg, NVg, ntb, nte) { const bf16_t* Kg_ = (Kg); const bf16_t* Vg_ = (Vg); const bf16_t* NKg_ = (NKg); const bf16_t* NVg_ = (NVg); const int tb_ = (tbeg), te_ = (tend), ntb_ = (ntb), nte_ = (nte); \
    *(LAS v4u*)(lds + KOFF + kst) = gK; *(LAS v4u*)(lds + VOFF + vst) = gV; \
    __syncthreads(); \
    for (int jt = tb_; jt < te_; ++jt) { const int bufo_ = ((jt - tb_) & 1) * 8192; const bool more_ = jt + 1 < te_; \
        ATT_SEQ_LOAD(jt + 1); \
        { const LAS unsigned char* Kb = lds + KOFF + bufo_; const LAS unsigned char* Vb = lds + VOFF + bufo_;
#define ATT_LOOP_END } \
        if (more_) { *(LAS v4u*)(lds + KOFF + (bufo_ ^ 8192) + kst) = gK; *(LAS v4u*)(lds + VOFF + (bufo_ ^ 8192) + vst) = gV; } \
        __syncthreads(); } }

template <int MODE, bool EDGE, int VAR> __device__ __forceinline__ void tile_body(const LAS unsigned char* Kb, const LAS unsigned char* Vb, int vl0, const bf16x8 (&qr)[4], int r32, int hi, int jt, int qb, int iq,
                                                                         unsigned long long selm, float& m, float& l, f32x16 (&o)[2]) {
    f32x16 p0, p1; if (VAR & 16) { p0 = zero16(); p1 = zero16(); asm volatile("" : "+v"(p0), "+v"(p1)); } else qk_tile(Kb, qr, r32, hi, p0, p1);
    asm volatile("s_nop 15\n\ts_nop 7" : "+v"(p0), "+v"(p1));
    const bool sel = MODE == 0 ? (bool)((selm >> jt) & 1ull) : true;
    if (EDGE) {
        if (jt == qb) { mask_range(p0, 0, hi, 0, iq); mask_range(p1, 1, hi, 0, iq); }
        else if (MODE == 1 && jt == qb - 8) { mask_range(p0, 0, hi, iq + 1, 63); mask_range(p1, 1, hi, iq + 1, 63); }
    }
    float tmax = (VAR & 4) ? 0.f : max32(p0, p1); if (!(VAR & 4)) tmax = max2f(tmax, other32(tmax, hi));
    if (MODE == 0) tmax = sel ? tmax : -INFINITY;
    if (!(VAR & 4) && __any(tmax > m + THR)) { const float mn = fmaxf(m, tmax), f = __builtin_amdgcn_exp2f(m - mn); o[0] = o[0] * f; o[1] = o[1] * f; l *= f; m = mn; }
    const float mref = (MODE == 0) ? (sel ? m : 1e30f) : m;
    if (!(VAR & 2)) {
#pragma unroll
    for (int r = 0; r < 16; ++r) { p0[r] = __builtin_amdgcn_exp2f(p0[r] - mref); p1[r] = __builtin_amdgcn_exp2f(p1[r] - mref); }
    l += sum16v(p0) + sum16v(p1);
    }
    if (!(VAR & 1)) pv_tile(Vb, vl0, p0, p1, o); else { asm volatile("" :: "v"(p0), "v"(p1)); }
}
template <int MODE, int VAR> __device__ __forceinline__ void run_branch(LAS unsigned char* lds, const bf16_t* Kg_, const bf16_t* Vg_, const int t0, const int te_, const bf16_t* NKg_, const bf16_t* NVg_, const int ntb_, const int nte_,
                                                               v4u& gK, v4u& gV, const int tid, const int kst, const int vst, const int vl0,
                                                               const bf16x8 (&qr)[4], const int r32, const int hi, const int qb, const int iq, const unsigned long long selm, float& m, float& l, f32x16 (&o)[2]) {
#define ATT_TILE(EDGE, jt_) do { const int j_ = (jt_); const int bo_ = ((j_ - t0) & 1) * 8192; const bool more_ = j_ + 1 < te_; \
        ATT_SEQ_LOAD(j_ + 1); \
        tile_body<MODE, EDGE, VAR>(lds + KOFF + bo_, lds + VOFF + bo_, vl0, qr, r32, hi, j_, qb, iq, selm, m, l, o); \
        if (more_) { *(LAS v4u*)(lds + KOFF + (bo_ ^ 8192) + kst) = gK; *(LAS v4u*)(lds + VOFF + (bo_ ^ 8192) + vst) = gV; } \
        if (!(VAR & 8)) __syncthreads(); } while (0)
    *(LAS v4u*)(lds + KOFF + kst) = gK; *(LAS v4u*)(lds + VOFF + vst) = gV;
    __syncthreads();
    ATT_TILE(true, t0);
#pragma unroll 1
    for (int jt = t0 + 1; jt < te_ - 1; ++jt) ATT_TILE(false, jt);
    if (te_ - 1 > t0) ATT_TILE(true, te_ - 1);
#undef ATT_TILE
}

template <int VAR> __device__ __forceinline__ void attn_unit(LAS unsigned char* lds, const Args& a, int b, int g, int qb, const int w) {
    using namespace cfg;
    int tid = w * 64 + lane_id(); asm volatile("" : "+v"(tid));
    const int lane = tid & 63, r32 = lane & 31, hi = lane >> 5, hr = w >> 1, qh = w & 1;
    const int head = g * 4 + hr, iq = 32 * qh + r32, tq = 64 * qb + iq, row = b * T + tq;
    unsigned char* ws = a.ws;
    const size_t bg = (size_t)(b * 2 + g);
    const bf16_t* KV = (const bf16_t*)(ws + wsl::KV);
    const bf16_t* kc = (const bf16_t*)(ws + wsl::KC) + bg * 256 * 64; const bf16_t* vc = (const bf16_t*)(ws + wsl::VC) + bg * 256 * 64;
    const bf16_t* ks = KV + 2 * KVPART + bg * T * 64; const bf16_t* vs = KV + 3 * KVPART + bg * T * 64;
    const bf16_t* kw = KV + 4 * KVPART + bg * T * 64; const bf16_t* vw = KV + 5 * KVPART + bg * T * 64;
    const int srow = tid >> 3, sch = tid & 7;
    const int kst = srow * 128 + ((sch ^ ((srow >> 1) & 7)) << 4), vst = srow * 128 + ((sch << 4) ^ (((srow >> 1) & 1) << 6));
    const int tq4 = (lane & 15) >> 2, tp = lane & 3, tblk = (lane >> 4) & 1;
    const int vl0 = hi * 512 + tq4 * 128 + ((tblk * 32 + tp * 8) ^ (((tq4 >> 1) & 1) << 6));
    bf16x8 qr[4];
    { const bf16_t* Qp = (const bf16_t*)(ws + wsl::Q) + (((size_t)(b * NH + head)) * T + tq) * 64 + 8 * hi;
#pragma unroll
      for (int d0 = 0; d0 < 4; ++d0) qr[d0] = *(const bf16x8*)(Qp + 16 * d0); }
#define ATT_COLD_ROW(rowv) int rowv; { int t2_ = w * 64 + lane_id(); asm volatile("" : "+v"(t2_)); rowv = b * T + 64 * qb + 32 * qh + (t2_ & 31); }
    LAS float* IMPP = (LAS float*)(lds + IMPP_OFF);
    LAS float* TOT = IMPP + tid;
    LAS float* SC = (LAS float*)(lds + SC_OFF);
    LAS unsigned* MASK = (LAS unsigned*)(lds + MASK_OFF);
    LAS float* SSQP = (LAS float*)(lds + SSQP_OFF);

    int ntc = (4 * qb + 3 + 63) >> 6; if (ntc > 4) ntc = 4;
    int nvq = tq >= 31 ? ((tq - 31) >> 4) + 1 : 0; if (nvq > NC) nvq = NC;
    float m = MINIT, l = 0.f;
    const int t0w = qb >= 8 ? qb - 8 : 0;
    v4u gK = ATT_GLD(kc, 0), gV = ATT_GLD(vc, 0);
    if (!(VAR & 32)) {
    ATT_LOOP_BEGIN(kc, vc, 0, ntc, kc, vc, 0, ntc)
        f32x16 p0, p1; qk_tile(Kb, qr, r32, hi, p0, p1);
        const int lim = nvq - 1 - 64 * jt;
        mask_range(p0, 0, hi, 0, lim); mask_range(p1, 1, hi, 0, lim);
        asm volatile("s_nop 15\n\ts_nop 7" : "+v"(p0), "+v"(p1));
        const float tmax = max32(p0, p1);
        if (tmax > m) { l *= __builtin_amdgcn_exp2f(m - tmax); m = tmax; }
        float s = 0.f;
#pragma unroll
        for (int r = 0; r < 16; ++r) s += __builtin_amdgcn_exp2f(p0[r] - m) + __builtin_amdgcn_exp2f(p1[r] - m);
        l += s;
    ATT_LOOP_END
    }
    { const float mo = other32(m, hi), lo_ = other32(l, hi), mt = fmaxf(m, mo);
      l = l * __builtin_amdgcn_exp2f(m - mt) + lo_ * __builtin_amdgcn_exp2f(mo - mt); m = mt; }
    const float inv_c = 1.f / fmaxf(l, 1e-30f);
    f32x16 oc[2]; oc[0] = zero16(); oc[1] = zero16();
    {
        float carry = 0.f;
        if (!(VAR & 128)) {
        ATT_LOOP_BEGIN(kc, vc, 0, ntc, ks, vs, 0, qb + 1)
            f32x16 p0, p1; qk_tile(Kb, qr, r32, hi, p0, p1);
            const int lim = nvq - 1 - 64 * jt;
            mask_range(p0, 0, hi, 0, lim); mask_range(p1, 1, hi, 0, lim);
#pragma unroll
            for (int r = 0; r < 16; ++r) { p0[r] = __builtin_amdgcn_exp2f(p0[r] - m) * inv_c; p1[r] = __builtin_amdgcn_exp2f(p1[r] - m) * inv_c; }
            int ib = IMPP_OFF + (((hr * 64 + iq) * 64 + hi + 16 * jt) << 2); asm volatile("" : "+v"(ib));
#pragma unroll
            for (int sub = 0; sub < 2; ++sub) {
                float gs[4], recv[4];
#pragma unroll
                for (int k = 0; k < 4; ++k) { const float x0 = sub ? p1[4 * k] : p0[4 * k], x1 = sub ? p1[4 * k + 1] : p0[4 * k + 1], x2 = sub ? p1[4 * k + 2] : p0[4 * k + 2], x3 = sub ? p1[4 * k + 3] : p0[4 * k + 3];
                    gs[k] = (x0 + x1) + (x2 + x3); recv[k] = other32(x3, hi); }
#pragma unroll
                for (int k = 0; k < 4; ++k) { const float add = hi ? recv[k] : (k > 0 ? recv[k - 1] : carry);
                    *(LAS float*)(lds + ib + (8 * sub + 2 * k) * 4) = gs[k] + add; }
                carry = recv[3];
            }
            pv_tile(Vb, vl0, p0, p1, oc);
        ATT_LOOP_END
        } else { gK = ATT_GLD(ks, 0); gV = ATT_GLD(vs, 0); }
    }
    if (qb < SEL_TOPK) {
        if (tid < 64) { MASK[tid * 2] = (2u << qb) - 1u; MASK[tid * 2 + 1] = 0u; }
        __syncthreads();
    } else
    {
        const int q = tid >> 3, jc = tid & 7;
        unsigned long long mine[8];
#pragma unroll
        for (int e = 0; e < 8; ++e) { const int j = 8 * jc + e; float sc;
            if (j == 0 || j == qb || j == qb - 1) sc = INFINITY;
            else if (j <= qb) sc = ((IMPP[(0 * 64 + q) * 64 + j] + IMPP[(1 * 64 + q) * 64 + j]) + IMPP[(2 * 64 + q) * 64 + j]) + IMPP[(3 * 64 + q) * 64 + j];
            else sc = 0.f;
            mine[e] = ((unsigned long long)__float_as_uint(sc) << 8) | (unsigned)(255 - j); }
        __syncthreads();
        LAS unsigned long long* KEY = (LAS unsigned long long*)IMPP;
#pragma unroll
        for (int e = 0; e < 8; ++e) KEY[q * 64 + 8 * jc + e] = mine[e];
        __syncthreads();
        int rank[8];
#pragma unroll
        for (int e = 0; e < 8; ++e) rank[e] = 0;
        const int nj = (VAR & 64) ? 1 : qb + 1;
#pragma unroll 2
        for (int j2 = 0; j2 < nj; ++j2) { const unsigned long long o = KEY[q * 64 + j2];
#pragma unroll
            for (int e = 0; e < 8; ++e) rank[e] += (o > mine[e]) ? 1 : 0; }
        unsigned bits = 0u;
#pragma unroll
        for (int e = 0; e < 8; ++e) if (rank[e] < SEL_TOPK && 8 * jc + e <= qb) bits |= 1u << e;
        unsigned lo32 = jc < 4 ? bits << (8 * jc) : 0u, hi32 = jc >= 4 ? bits << (8 * (jc - 4)) : 0u;
        lo32 = dpp_or8(lo32); hi32 = dpp_or8(hi32);
        if (jc == 0) { MASK[q * 2] = lo32; MASK[q * 2 + 1] = hi32; }
        __syncthreads();
    }
    {
        ATT_COLD_ROW(row_c) const float g_cmp = ((const float*)(ws + wsl::GATES))[(size_t)row_c * 24 + head * 3];
#pragma unroll
        for (int db = 0; db < 2; ++db)
#pragma unroll
            for (int r = 0; r < 16; ++r) TOT[(db * 16 + r) * 512] = oc[db][r] * g_cmp;
    }
    {
        const unsigned long long selm = (VAR & 2048) ? ~0ull : ((unsigned long long)MASK[iq * 2] | ((unsigned long long)MASK[iq * 2 + 1] << 32));
        f32x16 o[2]; o[0] = zero16(); o[1] = zero16(); m = MINIT; l = 0.f;
        if (VAR & 512) { gK = ATT_GLD(kw, t0w); gV = ATT_GLD(vw, t0w); } else
        run_branch<0, VAR>(lds, ks, vs, 0, qb + 1, kw, vw, t0w, qb + 1, gK, gV, tid, kst, vst, vl0, qr, r32, hi, qb, iq, selm, m, l, o);
        l += other32(l, hi);
        ATT_COLD_ROW(row_s) const float sc = ((const float*)(ws + wsl::GATES))[(size_t)row_s * 24 + head * 3 + 1] / fmaxf(l, 1e-30f);
#pragma unroll
        for (int db = 0; db < 2; ++db)
#pragma unroll
            for (int r = 0; r < 16; ++r) TOT[(db * 16 + r) * 512] += o[db][r] * sc;
    }
    {
        f32x16 o[2]; o[0] = zero16(); o[1] = zero16(); m = MINIT; l = 0.f;
        if (!(VAR & 256))
        run_branch<1, VAR>(lds, kw, vw, t0w, qb + 1, nullptr, nullptr, 0, 0, gK, gV, tid, kst, vst, vl0, qr, r32, hi, qb, iq, 0ull, m, l, o);
        l += other32(l, hi);
        ATT_COLD_ROW(row_w) const float sc = ((const float*)(ws + wsl::GATES))[(size_t)row_w * 24 + head * 3 + 2] / fmaxf(l, 1e-30f);
#pragma unroll
        for (int db = 0; db < 2; ++db)
#pragma unroll
            for (int r = 0; r < 16; ++r) o[db][r] = TOT[(db * 16 + r) * 512] + o[db][r] * sc;
        oc[0] = o[0]; oc[1] = o[1];
    }
    {
        ATT_COLD_ROW(row_o) bf16_t* orow = (bf16_t*)(ws + wsl::MIX) + (size_t)row_o * MIXP + head * 64;
        float sq = 0.f;
#pragma unroll
        for (int db = 0; db < 2; ++db)
#pragma unroll
            for (int k = 0; k < 4; ++k) { const float x0 = oc[db][4 * k], x1 = oc[db][4 * k + 1], x2 = oc[db][4 * k + 2], x3 = oc[db][4 * k + 3];
                sq += (x0 * x0 + x1 * x1) + (x2 * x2 + x3 * x3);
                pg8::u32x2 wv; wv.x = pg8::cvt_pk_bf16(x0, x1); wv.y = pg8::cvt_pk_bf16(x2, x3);
                *(pg8::u32x2*)(orow + 32 * db + 8 * k + 4 * hi) = wv; }
        sq += other32(sq, hi);
        if (hi == 0) SSQP[hr * 64 + iq] = sq;
        __syncthreads();
        if (tid < 64) ((float*)(ws + wsl::SSQA))[(size_t)(b * T + 64 * qb + tid) * 2 + g] = ((SSQP[tid] + SSQP[64 + tid]) + SSQP[128 + tid]) + SSQP[192 + tid];
        __syncthreads();
    }
}
}
template <int VAR> __device__ __forceinline__ void attn_phase(Frame& F, const Args& a, const int vcu) {
    const int G = F.G;
    for (int v0 = vcu; v0 < 256; v0 += G) {
        const int bgi = v0 >> 4, s = v0 & 15;
#pragma unroll 1
        for (int i = 0; i < 4; ++i) { const int qb = i == 0 ? 63 - s : (i == 1 ? 32 + s : (i == 2 ? 31 - s : s)); att::attn_unit<VAR>(F.lds, a, bgi >> 1, bgi & 1, qb, F.wave); }
    }
}
constexpr int CW_XRANK = 8192;
constexpr int CW_BAR = 4096;
enum Feat { F_FFN1 = 1, F_WIN = 2, F_CMP = 4, F_S5 = 8, F_GLU = 16, F_ATT = 32, F_WOUT = 64, F_FFN2 = 128, F_ALL = 255 };
constexpr int NPHASE = 12;

__global__ void __launch_bounds__(NWAVES * 64, 2) mk_fwd(Args args, int feat) {
    using namespace cfg;
    extern __shared__ __attribute__((aligned(16))) unsigned char lds_raw[];
    Frame F;
    F.lds = (LAS unsigned char*)lds_raw;
    F.wave = __builtin_amdgcn_readfirstlane(threadIdx.x >> 6);
    F.G = gridDim.x; F.gw = blockIdx.x * NWAVES + F.wave; F.NGW = F.G * NWAVES;
    volatile LAS unsigned* MISC = (volatile LAS unsigned*)(F.lds + MISC_OFF);
    for (int u = F.tid(); u < (LDS_BYTES - LDSCTL_OFF) / 4; u += NWAVES * 64) ((LAS unsigned*)(F.lds + LDSCTL_OFF))[u] = 0u;
    __syncthreads();
    unsigned char* ws = args.ws; const float* const* in = args.in;
    const int lo = args.ph_lo, hi = args.ph_hi; const bool multi = (hi - lo) > 1;
    XcdBarrier bar; bar.bar = (unsigned*)(ws + wsl::CTL) + CW_BAR; bar.x = 0; bar.st = nullptr; bar.w0 = 0;
    if (multi) bar = xcd_barrier_post((unsigned*)(ws + wsl::CTL) + CW_BAR, MISC + 8);
    if (multi && F.tid() == 0) { const unsigned x = xb_xcc_id(); MISC[13] = x; MISC[12] = xb_add((unsigned*)(ws + wsl::CTL) + CW_XRANK + 64 * x, 1u); }
#ifndef PH_MASK
#define PH_MASK 0xFFF
#endif
#define IN(k) (((PH_MASK >> (k)) & 1) && lo <= (k) && (k) < hi)
#ifndef REP_PH
#define REP_PH -1
#endif
#ifndef REP_N
#define REP_N 1
#endif
#ifndef REP_MASK
#define REP_MASK 0
#endif
#define REP(k) for (int rp_ = 0; rp_ < (((REP_PH) == (k) || (((REP_MASK) >> (k)) & 1)) ? (REP_N) : 1); ++rp_)
#ifdef PROBE_A
#define STAMP(i) do { if (blockIdx.x == 0 && F.tid() == 0) ((unsigned long long*)(ws + wsl::CTL + 65536))[i] = __builtin_amdgcn_s_memrealtime(); } while (0)
#else
#define STAMP(i) do {} while (0)
#endif
#define SEAM(k) do { if (IN(k) && IN((k) + 1)) { xcd_barrier(bar); STAMP((k) + 1); } } while (0)
    bf16_t* XB = (bf16_t*)(ws + wsl::XB); bf16_t* Hh = (bf16_t*)(ws + wsl::H);
    float* SSQ1 = (float*)(ws + wsl::SSQ1); float* SSQ2 = (float*)(ws + wsl::SSQ2); float* SSQ3 = (float*)(ws + wsl::SSQ3);
    float* SSQS = (float*)(ws + wsl::SSQS); float* SSQA = (float*)(ws + wsl::SSQA);
    bf16_t* MIX = (bf16_t*)(ws + wsl::MIX); bf16_t* YG = (bf16_t*)(ws + wsl::YG);
    MixBufs mb{(bf16_t*)(ws + wsl::Q), (bf16_t*)(ws + wsl::KV), (float*)(ws + wsl::GATES), (bf16_t*)(ws + wsl::UX), in[7]};

    STAMP(0);
    if (IN(0)) REP(0) { p0_prologue(F, args); }
    SEAM(0);
    int cu = (int)blockIdx.x, vcu = (F.G % 8 == 0) ? (cu % 8) * (F.G / 8) + cu / 8 : cu;
    if (multi && lo == 0) {
        if (F.tid() == 0) {
            const unsigned x = MISC[13], r = MISC[12]; unsigned pre = 0u, slot = 0u, npop = 0u; bool even = true;
            for (unsigned j = 0; j < 16; ++j) { const unsigned c = xb_ld((unsigned*)(ws + wsl::CTL) + CW_XRANK + 64 * j); if (j < x) { pre += c; slot += c ? 1u : 0u; } npop += c ? 1u : 0u; even = even && (c == 0u || c * 8u == (unsigned)F.G); }
            MISC[14] = pre + r; MISC[15] = (even && npop == 8u) ? r * 8u + slot : (unsigned)blockIdx.x;
        }
        __syncthreads();
        vcu = (int)MISC[14]; cu = (int)MISC[15];
    }
    if (IN(1) && (feat & F_FFN1)) REP(1) {
        pg8::Gemm g{XB, (const bf16_t*)(ws + wsl::W1A), M, 2 * FF, D, D, D, 0, 0}; pg8::StaticOrder S; S.init(M, 2 * FF, F.G, cu);
        pg8::EpiSwiGLU E{Hh, false, pg8::RowScaleTable{nullptr, -1, -1, nullptr}};
        pg8::gemm_phase<pg8::EpiSwiGLU, pg8::StaticOrder, true, true>(F.lds, g, S, E, F.wave);
    }
    SEAM(1);
    if (IN(2) && (feat & F_FFN1)) REP(2) {
        pg8::Gemm g{Hh, (const bf16_t*)(ws + wsl::W1D), M, D, FF, FF, FF, 0, 0}; pg8::StaticOrder S; S.init(M, D, F.G, cu);
        pg8::EpiResid<0> E{in[0], XB, SSQ1, nullptr, nullptr};
        pg8::gemm_phase<pg8::EpiResid<0>, pg8::StaticOrder, true, true>(F.lds, g, S, E, F.wave);
    }
    SEAM(2);
    if (IN(3) && (feat & F_WIN)) REP(3) {
        pg8::Gemm g{XB, (const bf16_t*)(ws + wsl::WIN), M, INC_PAD, D, D, D, 0, 0}; pg8::StaticOrder S; S.init(M, INC_PAD, F.G, cu);
        const pg8::RowScaleTable rt = pg8::make_row_scale_table((LAS float*)(F.lds + BIAS_OFF), SSQ1, S, F.tid());
        pg8::EpiWin E{mb, rt};
        pg8::gemm_phase<pg8::EpiWin, pg8::StaticOrder, true, true>(F.lds, g, S, E, F.wave);
    }
    SEAM(3);
    if (IN(4)) REP(4) {
        if (feat & F_CMP) {
            float* PART = (float*)(ws + wsl::YG);
            { pg8::Gemm g{mb.KV, (const bf16_t*)(ws + wsl::CW1K), 4096, 1024, 512, 1024, 2048, 0, 512}; pg8::StaticOrder S; S.init(4096, 1024, F.G, cu);
              pg8::EpiPart E{PART};
              pg8::gemm_phase<pg8::EpiPart, pg8::StaticOrder, true, true>(F.lds, g, S, E, F.wave); }
            { pg8::Gemm g{mb.KV + KVPART, (const bf16_t*)(ws + wsl::CW1V), 4096, 1024, 512, 1024, 2048, 0, 512}; pg8::StaticOrder S; S.init(4096, 1024, F.G, (cu + F.G - 64) % F.G);
              pg8::EpiPart E{PART + (size_t)4 * 4096 * 256};
              pg8::gemm_phase<pg8::EpiPart, pg8::StaticOrder, true, true>(F.lds, g, S, E, F.wave); }
        }
        if (feat & F_S5) {
            pg8::Gemm g{mb.UX, (const bf16_t*)(ws + wsl::BTS), SGRP * 2048, 256, 256, 384, 256, 8, 0}; pg8::StaticOrder S; S.init(SGRP * 2048, 256, F.G, (cu + F.G - 128) % F.G);
            pg8::EpiS5S E{(float*)(ws + wsl::S)};
            pg8::gemm_phase<pg8::EpiS5S, pg8::StaticOrder, true, true>(F.lds, g, S, E, F.wave);
        }
    }
    SEAM(4);
    if (IN(5)) REP(5) {
        LAS float* bias = (LAS float*)(F.lds + BIAS_OFF);
        if (feat & F_CMP) { const int t_ = F.tid(), ten = t_ >> 8, n = t_ & 255; const float* cbp = (const float*)(ws + WS_CBP) + ten * 16 * 256 + n; float s = (ten ? in[14] : in[11])[n];
#pragma unroll
            for (int k = 0; k < 16; ++k) s += cbp[k * 256];
            bias[ten * 256 + n] = s; }
        __syncthreads();
        if (F.wave == 0) { if (feat & F_S5) for (int bg = cu; bg < BATCH * SGRP; bg += F.G) s5_scan_task(args, bg, lane_id()); }
        else if (feat & F_CMP) {
            const float* PART = (const float*)(ws + wsl::YG);
            for (int tk = cu * (NWAVES - 1) + F.wave - 1; tk < 512; tk += F.G * (NWAVES - 1)) {
                if (tk < 256) cmp_out_task(PART, bias, (const bf16_t*)(ws + wsl::CW2K), (bf16_t*)(ws + wsl::KC), tk, lane_id());
                else cmp_out_task(PART + (size_t)4 * 4096 * 256, bias + 256, (const bf16_t*)(ws + wsl::CW2V), (bf16_t*)(ws + wsl::VC), tk - 256, lane_id());
            }
        }
    }
    SEAM(5);
    if (IN(6) && (feat & F_S5)) REP(6) {
        pg8::Gemm g{mb.UX, (const bf16_t*)(ws + wsl::BTY), SGRP * 2048, 256, 384, 384, 384, 8, 0}; pg8::StaticOrder S; S.init(SGRP * 2048, 256, F.G, cu);
        pg8::EpiS5Y E{YG};
        pg8::gemm_phase<pg8::EpiS5Y, pg8::StaticOrder, true, true>(F.lds, g, S, E, F.wave);
    }
    SEAM(6);
    if (IN(7)) {
#ifndef NO_GLU
        if (feat & F_GLU) REP(7) {
            pg8::Gemm g{YG, (const bf16_t*)(ws + wsl::GLUW), M, 512, 512, 512, 512, 0, 0}; pg8::StaticOrder S; S.init(M, 512, F.G, cu);
            pg8::EpiGLU E{YG, in[25], MIX + 512, SSQS};
            pg8::gemm_phase<pg8::EpiGLU, pg8::StaticOrder, true, true>(F.lds, g, S, E, F.wave);
        }
#endif
#ifdef HAVE_FAST_ATTN
#ifdef SHADOW_VAR
        if (feat & F_ATT) { attn_phase<SHADOW_VAR>(F, args, vcu); __syncthreads(); }
#endif
        if (feat & F_ATT) REP(12) attn_phase<0>(F, args, vcu);
#endif
    }
    SEAM(7);
    if (IN(8) && (feat & F_WOUT)) {
        pg8::Gemm g{MIX, (const bf16_t*)(ws + wsl::WOUT), M, D, D, D, D, 0, 0}; pg8::StaticOrder S; S.init(M, D, F.G, cu);
        pg8::EpiResid<1> E{nullptr, XB, SSQ2, SSQA, SSQS};
        pg8::gemm_phase<pg8::EpiResid<1>, pg8::StaticOrder, true, true>(F.lds, g, S, E, F.wave);
    }
    SEAM(8);
    if (IN(9) && (feat & F_FFN2)) REP(9) {
        pg8::Gemm g{XB, (const bf16_t*)(ws + wsl::W2A), M, 2 * FF, D, D, D, 0, 0}; pg8::StaticOrder S; S.init(M, 2 * FF, F.G, cu);
        const pg8::RowScaleTable rt = pg8::make_row_scale_table((LAS float*)(F.lds + BIAS_OFF), SSQ2, S, F.tid());
        pg8::EpiSwiGLU E{Hh, true, rt};
        pg8::gemm_phase<pg8::EpiSwiGLU, pg8::StaticOrder, true, true>(F.lds, g, S, E, F.wave);
    }
    SEAM(9);
    if (IN(10) && (feat & F_FFN2)) {
        pg8::Gemm g{Hh, (const bf16_t*)(ws + wsl::W2D), M, D, FF, FF, FF, 0, 0}; pg8::StaticOrder S; S.init(M, D, F.G, cu);
        pg8::EpiResid<2> E{nullptr, XB, SSQ3, nullptr, nullptr};
        pg8::gemm_phase<pg8::EpiResid<2>, pg8::StaticOrder, true, true>(F.lds, g, S, E, F.wave);
    }
    SEAM(10);
    if (IN(11) && (feat & F_FFN2)) {
        for (int m = F.gw; m < M; m += F.NGW) {
            const GAS unsigned long long* xr = (const GAS unsigned long long*)(XB + (size_t)m * D) + lane_id(); GAS f32x4* orow = (GAS f32x4*)(args.out + (size_t)m * D) + lane_id(); const GAS f32x4* gr = (const GAS f32x4*)in[33] + lane_id();
            float r = rsqrtf(pg8::sum16(SSQ3 + (size_t)m * 16) * (1.f / D) + EPS);
#ifdef PROBE_A
            { const unsigned long long* ts = (const unsigned long long*)(ws + wsl::CTL + 65536);
              const float ta = floorf((float)(ts[PROBE_A + 1] - ts[PROBE_A]) * 0.01f * 0.125f + 0.5f) * 8.f;
              r *= 1.f + sqrtf(ta * 2e-6f); }
#endif
#pragma unroll
            for (int j = 0; j < 4; ++j) { const unsigned long long w = xr[64 * j]; const f32x4 gq = gr[64 * j]; const unsigned lo = (unsigned)w, hi = (unsigned)(w >> 32);
                const f32x4 v = (f32x4){__uint_as_float(lo << 16), __uint_as_float(lo & 0xffff0000u), __uint_as_float(hi << 16), __uint_as_float(hi & 0xffff0000u)};
                orow[64 * j] = v * gq * r; }
        }
    }
#undef IN
#undef SEAM
}
extern "C" void kernel_launch(void* const* d_in, const int* in_sizes, int n_in, void* d_out, int out_size, void* d_ws, size_t ws_size, hipStream_t stream) {
    using namespace cfg;
    if (n_in != 34 || out_size != M * D || ws_size < wsl::END) { fprintf(stderr, "kernel_launch: built for 34 inputs, %d outputs, >= %zu bytes of workspace; got n_in %d out %d ws %zu; nothing launched\n", M * D, (size_t)wsl::END, n_in, out_size, ws_size); return; }
    static int grid = 0;
    if (grid == 0) {
        int dev = 0, cus = 0, per_cu = 0;
        if (hipGetDevice(&dev) != hipSuccess || hipDeviceGetAttribute(&cus, hipDeviceAttributeMultiprocessorCount, dev) != hipSuccess) { fprintf(stderr, "kernel_launch: device query failed; nothing launched\n"); grid = -1; return; }
        if (hipFuncSetAttribute((const void*)mk_fwd, hipFuncAttributeMaxDynamicSharedMemorySize, LDS_BYTES) != hipSuccess) { fprintf(stderr, "kernel_launch: hipFuncSetAttribute(%d B dynamic LDS) failed; nothing launched\n", LDS_BYTES); grid = -1; return; }
        if (hipOccupancyMaxActiveBlocksPerMultiprocessor(&per_cu, (const void*)mk_fwd, NWAVES * 64, LDS_BYTES) != hipSuccess || per_cu < 1) { fprintf(stderr, "kernel_launch: the occupancy query reports %d workgroups per CU for %d threads + %d B LDS; nothing launched\n", per_cu, NWAVES * 64, LDS_BYTES); (void)hipGetLastError(); grid = -1; return; }
        grid = cus;
    }
    if (grid < 0) return;
    (void)hipMemsetAsync((unsigned char*)d_ws + wsl::CTL, 0, wsl::CTL_BYTES, stream);
    Args a{};
    for (int i = 0; i < 34; ++i) a.in[i] = (const float*)d_in[i];
    a.out = (float*)d_out; a.ws = (unsigned char*)d_ws; a.ph_lo = 0; a.ph_hi = NPHASE;
    int feat = F_ALL; void* kargs[] = {&a, &feat};
    const hipError_t e = hipLaunchCooperativeKernel((const void*)mk_fwd, dim3(grid), dim3(NWAVES * 64), kargs, LDS_BYTES, stream);
    if (e != hipSuccess) fprintf(stderr, "kernel_launch: cooperative launch failed: %s (grid %d x %d threads, %d B LDS)\n", hipGetErrorString(e), grid, NWAVES * 64, LDS_BYTES);
}
```
